# Optimizing an MI355X kernel written in HIP

```python
import jax, jax.numpy as jnp
from jax import lax
import numpy as np

D_MODEL = 1024
BATCH = 1
SEQ = 16384
DEPTH = 2
DEC_BATCH = 4
DEC_SEQ = 4096
PAST_LEN = 128

N_META = 16
CHUNK = 64
A_HEADS = 8
A_DK = 128
A_DV = D_MODEL // A_HEADS
A_K = A_HEADS * A_DK
A_V = A_HEADS * A_DV
B_HEADS = 4
B_DK = D_MODEL // 2 // B_HEADS
B_DV = D_MODEL // B_HEADS
B_K = B_HEADS * B_DK
B_V = B_HEADS * B_DV
B_RANK = 16
GATE_TEMP = 16.0
D_FF = 4 * D_MODEL
EPS = 1e-6
LB_FLOOR = 1e-30
SPLITS = (A_K, A_K, A_K, A_V, A_V, B_K, B_K, B_V, 2 * B_RANK, B_V, D_MODEL, D_MODEL)
PROJ_DIM = 3 * A_K + 2 * A_V + 2 * B_K + 2 * B_V + 2 * B_RANK + 2 * D_MODEL

kernel_name = "hgrn2_gla_gated_parallel_encoder"


def rms_norm(x, gain):
    xf = x.astype(jnp.float32)
    y = xf * lax.rsqrt(jnp.mean(xf * xf, axis=-1, keepdims=True) + EPS)
    return (y * gain.astype(jnp.float32)).astype(x.dtype)


def split_heads(t, n_heads):
    b, l, _ = t.shape
    return t.reshape(b, l, n_heads, -1).transpose(0, 2, 1, 3)


def merge_heads(t):
    b, h, l, d = t.shape
    return t.transpose(0, 2, 1, 3).reshape(b, l, h * d)


def chunk_gla(q, k, v, logg):
    out_dtype = v.dtype
    b, h, l, dk = q.shape
    dv = v.shape[-1]
    pad = (-l) % CHUNK
    padw = ((0, 0), (0, 0), (pad, 0), (0, 0))
    q, k, v, logg = [jnp.pad(t.astype(jnp.float32), padw) for t in (q, k, v, logg)]
    n = (l + pad) // CHUNK

    def to_chunks(t):
        return t.reshape(b, h, n, CHUNK, t.shape[-1]).transpose(2, 0, 1, 3, 4)

    qc, kc, vc = to_chunks(q), to_chunks(k), to_chunks(v)
    bc = jnp.cumsum(to_chunks(logg), axis=-2)
    causal = jnp.tril(jnp.ones((CHUNK, CHUNK), dtype=bool))[:, :, None]

    def step(state, inp):
        qi, ki, vi, bi = inp
        o = jnp.einsum('bhik,bhkv->bhiv', qi * jnp.exp(bi), state)
        diff = bi[:, :, :, None, :] - bi[:, :, None, :, :]
        dec = jnp.where(causal, jnp.exp(jnp.where(causal, diff, 0.0)), 0.0)
        scores = jnp.einsum('bhik,bhjk,bhijk->bhij', qi, ki, dec)
        o = o + jnp.einsum('bhij,bhjv->bhiv', scores, vi)
        b_last = bi[:, :, -1, :]
        state = jnp.exp(b_last)[..., None] * state + jnp.einsum(
            'bhjk,bhjv->bhkv', ki * jnp.exp(b_last[:, :, None, :] - bi), vi)
        return state, o

    s0 = jnp.zeros((b, h, dk, dv), jnp.float32)
    _, o = lax.scan(step, s0, (qc, kc, vc, bc))
    o = o.transpose(1, 2, 0, 3, 4).reshape(b, h, n * CHUNK, dv)[:, :, pad:]
    return o.astype(out_dtype)


def bidir_gla(q, k_fwd, k_bwd, v, lg_fwd, lg_bwd):
    rev = lambda t: jnp.flip(t, axis=2)
    fwd = chunk_gla(q, k_fwd, v, lg_fwd)
    bwd = rev(chunk_gla(rev(q), rev(k_bwd), rev(v), rev(lg_bwd)))
    return fwd + bwd


def gated_head_norm(o, gain, gate):
    of = o.astype(jnp.float32)
    of = of * lax.rsqrt(jnp.mean(of * of, axis=-1, keepdims=True) + EPS)
    y = merge_heads(of) * gain.astype(jnp.float32) * jax.nn.silu(gate.astype(jnp.float32))
    return y.astype(gate.dtype)


def hgrn2_log_forget(z, lb):
    return jnp.logaddexp(jnp.log(jnp.maximum(lb, LB_FLOOR)),
                         jnp.log1p(-lb) + jax.nn.log_sigmoid(z.astype(jnp.float32)))


def layer_lower_bounds(lb_logits):
    p = jax.nn.softmax(lb_logits.astype(jnp.float32), axis=0)
    return jnp.cumsum(p, axis=0) - p[0:1]


def mixer(xn, w_in, lb, w_gate, b_gate, norm_a, norm_b, w_out):
    p = jnp.einsum('bld,dp->blp', xn, w_in)
    cuts = [int(c) for c in np.cumsum(SPLITS)[:-1]]
    (q_a, zf_fwd, zf_bwd, i_a, g_a,
     q_g, k_g, v_g, r_g, g_g, m_a, m_b) = jnp.split(p, cuts, axis=-1)

    lf_fwd = hgrn2_log_forget(zf_fwd, lb[0])
    lf_bwd = hgrn2_log_forget(zf_bwd, lb[1])
    k_fwd = -jnp.expm1(lf_fwd)
    k_bwd = -jnp.expm1(lf_bwd)
    o_a = bidir_gla(split_heads(q_a, A_HEADS), split_heads(k_fwd, A_HEADS), split_heads(k_bwd, A_HEADS),
                    split_heads(i_a, A_HEADS), split_heads(lf_fwd, A_HEADS), split_heads(lf_bwd, A_HEADS))
    y_a = gated_head_norm(o_a, norm_a, g_a)

    r_fwd, r_bwd = jnp.split(r_g, 2, axis=-1)
    lg_fwd = jax.nn.log_sigmoid((r_fwd @ w_gate[0] + b_gate[0]).astype(jnp.float32)) / GATE_TEMP
    lg_bwd = jax.nn.log_sigmoid((r_bwd @ w_gate[1] + b_gate[1]).astype(jnp.float32)) / GATE_TEMP
    qh = split_heads(q_g, B_HEADS) * (B_DK ** -0.5)
    kh = split_heads(k_g, B_HEADS)
    o_b = bidir_gla(qh, kh, kh, split_heads(v_g, B_HEADS),
                    split_heads(lg_fwd, B_HEADS), split_heads(lg_bwd, B_HEADS))
    y_b = gated_head_norm(o_b, norm_b, g_g)

    u = jax.nn.sigmoid(m_a) * y_a + jax.nn.sigmoid(m_b) * y_b
    return jnp.einsum('bld,de->ble', u, w_out)


def trunk(x, meta_tokens, attn_norm, w_in, lb_logits, w_gate, b_gate, norm_a, norm_b,
          w_out, mlp_norm, w_up, w_down, final_norm):
    b = x.shape[0]
    meta = jnp.broadcast_to(meta_tokens[None].astype(x.dtype), (b, N_META, x.shape[-1]))
    h = jnp.concatenate([meta, x], axis=1)
    lbs = layer_lower_bounds(lb_logits)
    for l in range(DEPTH):
        h = h + mixer(rms_norm(h, attn_norm[l]), w_in[l], lbs[l], w_gate[l], b_gate[l],
                      norm_a[l], norm_b[l], w_out[l])
        hn = rms_norm(h, mlp_norm[l])
        h = h + jnp.einsum('blf,fd->bld', jnp.square(jax.nn.relu(jnp.einsum('bld,df->blf', hn, w_up[l]))), w_down[l])
    h = rms_norm(h, final_norm)
    return h[:, N_META:]


def setup_inputs(seed: int = 0) -> dict:
    key = jax.random.key(seed)
    ks = jax.random.split(key, 16)
    f32 = jnp.float32
    nrm = lambda k, s: jax.random.normal(k, s, f32)
    return {
        "x_prompt": nrm(ks[0], (BATCH, SEQ, D_MODEL)),
        "x_sample": nrm(ks[1], (DEC_BATCH, DEC_SEQ, D_MODEL)),
        "meta_tokens": nrm(ks[2], (N_META, D_MODEL)),
        "attn_norm": 1.0 + 0.02 * nrm(ks[3], (DEPTH, D_MODEL)),
        "w_in": nrm(ks[4], (DEPTH, D_MODEL, PROJ_DIM)) * D_MODEL ** -0.5,
        "lb_logits": 0.5 * nrm(ks[5], (DEPTH, 2, A_K)),
        "w_gate": nrm(ks[6], (DEPTH, 2, B_RANK, B_K)) * B_RANK ** -0.5,
        "b_gate": 0.1 * nrm(ks[7], (DEPTH, 2, B_K)),
        "norm_a": 1.0 + 0.02 * nrm(ks[8], (DEPTH, A_V)),
        "norm_b": 1.0 + 0.02 * nrm(ks[9], (DEPTH, B_V)),
        "w_out": nrm(ks[10], (DEPTH, D_MODEL, D_MODEL)) * D_MODEL ** -0.5,
        "mlp_norm": 1.0 + 0.02 * nrm(ks[11], (DEPTH, D_MODEL)),
        "w_up": nrm(ks[12], (DEPTH, D_MODEL, D_FF)) * D_MODEL ** -0.5,
        "w_down": nrm(ks[13], (DEPTH, D_FF, D_MODEL)) * D_FF ** -0.5,
        "final_norm": 1.0 + 0.02 * nrm(ks[14], (D_MODEL,)),
    }


def reference(x_prompt, x_sample, meta_tokens, attn_norm, w_in, lb_logits, w_gate, b_gate,
              norm_a, norm_b, w_out, mlp_norm, w_up, w_down, final_norm):
    y_prompt = trunk(x_prompt, meta_tokens, attn_norm, w_in, lb_logits, w_gate, b_gate,
                     norm_a, norm_b, w_out, mlp_norm, w_up, w_down, final_norm)
    y_sample = trunk(x_sample, meta_tokens, attn_norm, w_in, lb_logits, w_gate, b_gate,
                     norm_a, norm_b, w_out, mlp_norm, w_up, w_down, final_norm)
    return (y_prompt, y_sample)
```

```cpp
#define MULTI_LAUNCH 1
#include <hip/hip_runtime.h>
#include <hip/hip_cooperative_groups.h>
#include <stdint.h>
#include <stdio.h>
namespace cg = cooperative_groups;

typedef __attribute__((ext_vector_type(8))) short bf16x8;
typedef __attribute__((ext_vector_type(4))) float f32x4;
typedef unsigned short bf16_t;
typedef uint32_t u32x4 __attribute__((ext_vector_type(4)));
typedef uint32_t u32x2 __attribute__((ext_vector_type(2)));
typedef float fl4 __attribute__((ext_vector_type(4)));
#define MK4(a,b,c,d) ((u32x4){(uint32_t)(a),(uint32_t)(b),(uint32_t)(c),(uint32_t)(d)})
#define MK2(a,b) ((u32x2){(uint32_t)(a),(uint32_t)(b)})
#define MKF4(a,b,c,d) ((fl4){(a),(b),(c),(d)})

#define NTOKG 16384
#define MROWS 16512
#define MTILES 129
#define LSTRIDE 20054016
#define WOFF_A 0
#define WOFF_B (4096 * 1024)
#define WOFF_G (6272 * 1024)
#define WOFF_O (10368 * 1024)
#define WOFF_U (11392 * 1024)
#define WOFF_D (15488 * 1024)
#define LDS_BYTES 80896
#define NPHASES 46

struct Params {
  const float* x[2];
  const float* meta;
  const float* attn_norm;
  const float* w_in;
  const float* lb_logits;
  const float* w_gate;
  const float* b_gate;
  const float* norm_a;
  const float* norm_b;
  const float* w_out;
  const float* mlp_norm;
  const float* w_up;
  const float* w_down;
  const float* final_norm;
  float* out;
  bf16_t* W;
  bf16_t* X;
  bf16_t* R;
  bf16_t* O;
  float* ST;
  float* GD;
  float* hmeta;
};

__device__ __forceinline__ bf16_t f2bf(float f) {
  uint32_t u = __float_as_uint(f);
  u += 0x7fffu + ((u >> 16) & 1u);
  return (bf16_t)(u >> 16);
}
__device__ __forceinline__ int opaque_tid() { int t = threadIdx.x; asm volatile("" : "+v"(t)); return t; }
__device__ __forceinline__ int opaque_bid() { int b = blockIdx.x; asm volatile("" : "+s"(b)); return b; }
__device__ __forceinline__ float bf2f(bf16_t b) { return __uint_as_float(((uint32_t)b) << 16); }
__device__ __forceinline__ uint32_t pack2(float a, float b) { return (uint32_t)f2bf(a) | ((uint32_t)f2bf(b) << 16); }
__device__ __forceinline__ float sigmoidf_(float x) { return 1.f / (1.f + __expf(-x)); }

__device__ __forceinline__ int w_in_col(int R, float& scale) {
  scale = 1.f;
  if (R < 4096) return R;
  if (R < 6272) {
    int n = R - 4096;
    if (n >= 2080) return -1;
    if (n < 512) scale = 0.08838834764831845f;
    return 5120 + n;
  }
  int n = R - 6272;
  int tt = n >> 7, wv = n & 127;
  int wn = wv >> 6, seg = (wv & 63) >> 4, j = wv & 15;
  int ucol = tt * 32 + wn * 16 + j;
  int base = seg == 0 ? 4096 : seg == 1 ? 8224 : seg == 2 ? 7200 : 9248;
  return base + ucol;
}

__device__ void phase_init(const Params& p, char* smem) {
  const int t = opaque_tid();
  const int bid_ = opaque_bid();
  for (int idx = bid_ * 256 + t; idx < 2 * 128 * 256; idx += gridDim.x * 256) {
    int g = idx / (128 * 256), r = (idx / 256) % 128, c4 = idx % 256;
    int nvalid = g == 0 ? 16 : 64;
    fl4 v = MKF4(0.f, 0.f, 0.f, 0.f);
    if (r < nvalid) v = *(const fl4*)(p.meta + (size_t)(r & 15) * 1024 + c4 * 4);
    *(fl4*)(p.hmeta + ((size_t)g * 128 + r) * 1024 + c4 * 4) = v;
  }
  float* tile = (float*)smem;
  const int per_layer = 3872 + 1024;
  for (int id = bid_; id < 2 * per_layer; id += gridDim.x) {
    int l = id / per_layer, r = id % per_layer;
    const float* src; int ld; const float* gain = nullptr; int K, n0, k0;
    bf16_t* dst;
    int kind;
    int cbase = 0;
    if (r < 3872) {
      int rt = r >> 4, kt = r & 15;
      n0 = rt * 64; k0 = kt * 64; K = 1024;
      dst = p.W + (size_t)l * LSTRIDE;
      if (n0 < 10368) { kind = 0; src = p.w_in + (size_t)l * 1024 * 10272; ld = 10272; gain = p.attn_norm + l * 1024; }
      else if (n0 < 11392) { kind = 1; src = p.w_out + (size_t)l * 1024 * 1024; ld = 1024; cbase = n0 - 10368; }
      else { kind = 1; src = p.w_up + (size_t)l * 1024 * 4096; ld = 4096; cbase = n0 - 11392; gain = p.mlp_norm + l * 1024; }
    } else {
      int r2 = r - 3872;
      int rt = r2 >> 6, kt = r2 & 63;
      n0 = rt * 64; k0 = kt * 64; K = 4096;
      dst = p.W + (size_t)l * LSTRIDE + WOFF_D;
      kind = 1; src = p.w_down + (size_t)l * 4096 * 1024; ld = 1024; cbase = n0;
    }
    {
      int n = t & 63;
      float scale = 1.f; int col;
      if (kind == 0) col = w_in_col(n0 + n, scale); else col = cbase + n;
#pragma unroll 4
      for (int i = 0; i < 16; ++i) {
        int kk = (t >> 6) + 4 * i;
        float v = 0.f;
        if (col >= 0) {
          v = src[(size_t)(k0 + kk) * ld + col] * scale;
          if (gain) v *= gain[k0 + kk];
        }
        tile[kk * 65 + n] = v;
      }
    }
    __syncthreads();
    {
      int n = t >> 2, piece = t & 3;
      uint32_t pk[8];
#pragma unroll
      for (int e = 0; e < 8; ++e) {
        float a = tile[(piece * 16 + 2 * e) * 65 + n];
        float b = tile[(piece * 16 + 2 * e + 1) * 65 + n];
        pk[e] = pack2(a, b);
      }
      u32x4* d = (u32x4*)(dst + (size_t)(n0 + n) * K + k0 + piece * 16);
      d[0] = MK4(pk[0], pk[1], pk[2], pk[3]);
      d[1] = MK4(pk[4], pk[5], pk[6], pk[7]);
    }
    __syncthreads();
  }
}

enum { EPI_G1A = 0, EPI_G1B, EPI_GATES, EPI_WOUT, EPI_UP, EPI_DOWN };

template <int EPI>
__device__ void gemm_phase(const Params& p, int l, int g, char* smem) {
  constexpr bool AF32 = (EPI == EPI_G1A || EPI == EPI_G1B || EPI == EPI_GATES || EPI == EPI_UP);
  constexpr int K = (EPI == EPI_DOWN) ? 4096 : 1024;
  constexpr int NT = EPI == EPI_G1A ? 32 : EPI == EPI_G1B ? 17 : EPI == EPI_GATES ? 32 : EPI == EPI_WOUT ? 8 : EPI == EPI_UP ? 32 : 8;
  constexpr int WOFF = EPI == EPI_G1A ? WOFF_A : EPI == EPI_G1B ? WOFF_B : EPI == EPI_GATES ? WOFF_G : EPI == EPI_WOUT ? WOFF_O : EPI == EPI_UP ? WOFF_U : WOFF_D;
  constexpr int NK = K / 64;
  const bf16_t* Wl = p.W + (size_t)l * LSTRIDE + WOFF;
  bf16_t* As = (bf16_t*)smem;
  bf16_t* Bs = As + 2 * 128 * 72;
  float* rss = (float*)(Bs + 2 * 128 * 72);
  const int bid_ = opaque_bid();
  const int t = opaque_tid(), lane = t & 63, w = t >> 6, wm = w >> 1, wn = w & 1;
  const int quad = lane >> 4, l15 = lane & 15;
  const int nvalid_meta = g == 0 ? 16 : 64;

  for (int tile = bid_; tile < MTILES * NT; tile += gridDim.x) {
    const int mt = tile / NT, nt = tile % NT;
    const float* Af = nullptr; const bf16_t* Ab = nullptr;
    if (AF32) {
      if (mt == 128) Af = p.hmeta + (size_t)g * 128 * 1024;
      else if (EPI != EPI_UP && l == 0) Af = p.x[g] + (size_t)mt * 128 * 1024;
      else Af = p.out + ((size_t)g * NTOKG + (size_t)mt * 128) * 1024;
    } else {
      Ab = p.X + (size_t)mt * 128 * K;
    }
    const bf16_t* Bg = Wl + (size_t)nt * 128 * K;

    f32x4 acc[4][4];
#pragma unroll
    for (int a = 0; a < 4; ++a)
#pragma unroll
      for (int b = 0; b < 4; ++b) acc[a][b] = (f32x4){0.f, 0.f, 0.f, 0.f};
    float ss[8];
#pragma unroll
    for (int i = 0; i < 8; ++i) ss[i] = 0.f;
    fl4 ar[8]; u32x4 abr[4]; u32x4 br[4];

    if (AF32) {
#pragma unroll
      for (int i = 0; i < 8; ++i) ar[i] = *(const fl4*)(Af + (size_t)((t >> 4) + 16 * i) * 1024 + (t & 15) * 4);
    } else {
#pragma unroll
      for (int i = 0; i < 4; ++i) abr[i] = *(const u32x4*)(Ab + (size_t)((t >> 3) + 32 * i) * K + (t & 7) * 8);
    }
#pragma unroll
    for (int i = 0; i < 4; ++i) br[i] = *(const u32x4*)(Bg + (size_t)((t >> 3) + 32 * i) * K + (t & 7) * 8);

#pragma unroll 1
    for (int kt = 0; kt < NK; ++kt) {
      const int buf = kt & 1;
      bf16_t* Aw = As + buf * 9216;
      bf16_t* Bw = Bs + buf * 9216;
      if (AF32) {
#pragma unroll
        for (int i = 0; i < 8; ++i) {
          fl4 v = ar[i];
          ss[i] += v.x * v.x + v.y * v.y + v.z * v.z + v.w * v.w;
          u32x2 pk = MK2(pack2(v.x, v.y), pack2(v.z, v.w));
          *(u32x2*)(Aw + ((t >> 4) + 16 * i) * 72 + (t & 15) * 4) = pk;
        }
      } else {
#pragma unroll
        for (int i = 0; i < 4; ++i) *(u32x4*)(Aw + ((t >> 3) + 32 * i) * 72 + (t & 7) * 8) = abr[i];
      }
#pragma unroll
      for (int i = 0; i < 4; ++i) *(u32x4*)(Bw + ((t >> 3) + 32 * i) * 72 + (t & 7) * 8) = br[i];
      if (kt + 1 < NK) {
        const int ko = (kt + 1) * 64;
        if (AF32) {
#pragma unroll
          for (int i = 0; i < 8; ++i) ar[i] = *(const fl4*)(Af + (size_t)((t >> 4) + 16 * i) * 1024 + ko + (t & 15) * 4);
        } else {
#pragma unroll
          for (int i = 0; i < 4; ++i) abr[i] = *(const u32x4*)(Ab + (size_t)((t >> 3) + 32 * i) * K + ko + (t & 7) * 8);
        }
#pragma unroll
        for (int i = 0; i < 4; ++i) br[i] = *(const u32x4*)(Bg + (size_t)((t >> 3) + 32 * i) * K + ko + (t & 7) * 8);
      }
      __syncthreads();
#pragma unroll
      for (int kh = 0; kh < 2; ++kh) {
        bf16x8 af[4], bfr[4];
#pragma unroll
        for (int mi = 0; mi < 4; ++mi) af[mi] = *(const bf16x8*)(Aw + (wm * 64 + mi * 16 + l15) * 72 + kh * 32 + quad * 8);
#pragma unroll
        for (int ni = 0; ni < 4; ++ni) bfr[ni] = *(const bf16x8*)(Bw + (wn * 64 + ni * 16 + l15) * 72 + kh * 32 + quad * 8);
#pragma unroll
        for (int mi = 0; mi < 4; ++mi)
#pragma unroll
          for (int ni = 0; ni < 4; ++ni)
            acc[mi][ni] = __builtin_amdgcn_mfma_f32_16x16x32_bf16(af[mi], bfr[ni], acc[mi][ni], 0, 0, 0);
      }
    }
    __syncthreads();

    if (AF32) {
#pragma unroll
      for (int i = 0; i < 8; ++i) {
        float s = ss[i];
        s += __shfl_xor(s, 1); s += __shfl_xor(s, 2); s += __shfl_xor(s, 4); s += __shfl_xor(s, 8);
        if ((t & 15) == 0) rss[(t >> 4) + 16 * i] = rsqrtf(s * (1.f / 1024.f) + 1e-6f);
      }
      __syncthreads();
    }
    float lbv[4] = {0.f, 0.f, 0.f, 0.f};
    if (EPI == EPI_G1A) {
      const int region = nt >> 3;
      if (l == 1 && (region == 1 || region == 2)) {
#pragma unroll
        for (int ni = 0; ni < 4; ++ni) {
          const int ch = (nt * 128 + wn * 64 + ni * 16 + l15) & 1023;
          const float l0 = p.lb_logits[(region - 1) * 1024 + ch], l1 = p.lb_logits[2048 + (region - 1) * 1024 + ch];
          lbv[ni] = 1.f / (1.f + __expf(l0 - l1));
        }
      }
    }
#pragma unroll
    for (int mi = 0; mi < 4; ++mi) {
      __builtin_amdgcn_sched_barrier(0);
#pragma unroll
      for (int r = 0; r < 4; ++r) {
        const int rl = wm * 64 + mi * 16 + quad * 4 + r;
        const size_t grow = (size_t)mt * 128 + rl;
        float rs = 1.f;
        if (AF32) rs = rss[rl];
        if (EPI == EPI_G1A) {
          const int region = nt >> 3;
#pragma unroll
          for (int ni = 0; ni < 4; ++ni) {
            const int col = nt * 128 + wn * 64 + ni * 16 + l15;
            float v = acc[mi][ni][r] * rs;
            if (region == 1 || region == 2) {
              const float lb = lbv[ni];
              float f = fmaxf(lb, 1e-30f) + (1.f - lb) * sigmoidf_(v);
              v = __logf(f);
            }
            p.X[grow * 4096 + col] = f2bf(v);
          }
        } else if (EPI == EPI_G1B) {
#pragma unroll
          for (int ni = 0; ni < 4; ++ni) {
            const int cl = wn * 64 + ni * 16 + l15;
            float v = acc[mi][ni][r] * rs;
            if (nt < 16) p.X[grow * 2048 + nt * 128 + cl] = f2bf(v);
            else if (cl < 32) p.R[grow * 32 + cl] = f2bf(v);
          }
        } else if (EPI == EPI_GATES) {
          const int ucol = nt * 32 + wn * 16 + l15;
          float ga = acc[mi][0][r] * rs, ma = acc[mi][1][r] * rs, gb = acc[mi][2][r] * rs, mb = acc[mi][3][r] * rs;
          float ona = bf2f(p.O[grow * 2048 + ucol]);
          float onb = bf2f(p.O[grow * 2048 + 1024 + ucol]);
          float u = sigmoidf_(ma) * (ga * sigmoidf_(ga)) * ona + sigmoidf_(mb) * (gb * sigmoidf_(gb)) * onb;
          p.X[grow * 1024 + ucol] = f2bf(u);
        } else if (EPI == EPI_WOUT || EPI == EPI_DOWN) {
          if (mt == 128) {
            if (rl < nvalid_meta) {
              float* hp = p.hmeta + ((size_t)g * 128 + rl) * 1024;
#pragma unroll
              for (int ni = 0; ni < 4; ++ni) {
                const int col = nt * 128 + wn * 64 + ni * 16 + l15;
                hp[col] = hp[col] + acc[mi][ni][r];
              }
            }
          } else {
            const size_t trow = (size_t)mt * 128 + rl;
            const float* hin = (EPI == EPI_WOUT && l == 0) ? p.x[g] + trow * 1024 : p.out + ((size_t)g * NTOKG + trow) * 1024;
            float* hout = p.out + ((size_t)g * NTOKG + trow) * 1024;
#pragma unroll
            for (int ni = 0; ni < 4; ++ni) {
              const int col = nt * 128 + wn * 64 + ni * 16 + l15;
              hout[col] = hin[col] + acc[mi][ni][r];
            }
          }
        } else if (EPI == EPI_UP) {
#pragma unroll
          for (int ni = 0; ni < 4; ++ni) {
            const int col = nt * 128 + wn * 64 + ni * 16 + l15;
            float v = fmaxf(acc[mi][ni][r] * rs, 0.f);
            p.X[grow * 4096 + col] = f2bf(v * v);
          }
        }
      }
    }
  }
}

template <int MIX, int PASS>
__device__ void scan_phase(const Params& p, int l, int g, char* smem) {
  constexpr int NH = MIX ? 4 : 8;
  constexpr int NDV = MIX ? 8 : 4;
  constexpr int XLD = MIX ? 2048 : 4096;
  bf16_t* QS = (bf16_t*)smem;
  bf16_t* KS = QS + 64 * 136;
  bf16_t* LG = KS + 64 * 136;
  bf16_t* Pm = LG;
  bf16_t* SmT = LG + 64 * 72;
  bf16_t* KT = LG + 8960;
  bf16_t* VT = KT + 128 * 72;
  bf16_t* RS = VT + 32 * 72;
  float* em = (float*)(RS + 64 * 24);
  float* el = em + 128;
  float* tot = el + 128;
  const int bid_ = opaque_bid();
  const int t = opaque_tid(), lane = t & 63, w = t >> 6, quad = lane >> 4, l15 = lane & 15;
  const int sps = g == 0 ? 16 : 4;
  constexpr bool do_out = (PASS == 3);
  const bf16_t* Xg = p.X;

  for (int item = bid_; item < 1024; item += gridDim.x) {
    const int dir = item & 1;
    const int dvb = (item >> 1) % NDV;
    const int head = ((item >> 1) / NDV) % NH;
    const int seg = item >> 6;
    const int seq = seg / sps;
    const bool first = (seg % sps) == 0;
    const int nsteps = 16 + (first ? 1 : 0);
    int qcol, kcol, vcol;
    bf16_t* Og; int OLD;
    if (MIX == 0) {
      qcol = head * 128; kcol = 1024 + dir * 1024 + head * 128; vcol = 3072 + head * 128 + dvb * 32;
      Og = p.O + dir * 1024 + head * 128 + dvb * 32; OLD = 2048;
    } else {
      qcol = head * 128; kcol = 512 + head * 128; vcol = 1024 + head * 256 + dvb * 32;
      Og = p.X + (size_t)MROWS * 2048 + (size_t)dir * MROWS * 1024 + head * 256 + dvb * 32; OLD = 1024;
    }
    bf16x8 wgf[2]; float bgv[2];
    if (MIX == 1) {
#pragma unroll
      for (int ct = 0; ct < 2; ++ct) {
        const int cc = 16 * (2 * w + ct) + l15;
        bf16x8 v = (bf16x8){0, 0, 0, 0, 0, 0, 0, 0};
        if (quad < 2) {
#pragma unroll
          for (int e = 0; e < 8; ++e)
            v[e] = (short)f2bf(p.w_gate[((size_t)(l * 2 + dir) * 16 + quad * 8 + e) * 512 + head * 128 + cc]);
        }
        wgf[ct] = v;
        bgv[ct] = p.b_gate[(l * 2 + dir) * 512 + head * 128 + cc];
      }
    }
    f32x4 S[4];
#pragma unroll
    for (int a = 0; a < 4; ++a) S[a] = (f32x4){0.f, 0.f, 0.f, 0.f};
    if (do_out) {
      int s2 = dir == 0 ? seq * sps : seq * sps + sps - 1;
      const int stp = dir == 0 ? 1 : -1;
      for (; s2 != seg; s2 += stp) {
        const int item2 = ((s2 * NH + head) * NDV + dvb) * 2 + dir;
        const float* L = p.ST + (size_t)item2 * 4096;
        const float* G = p.GD + ((s2 * 8 + head) * 2 + dir) * 128;
#pragma unroll
        for (int a = 0; a < 4; ++a)
#pragma unroll
          for (int r = 0; r < 4; ++r) {
            const int k = 16 * (2 * w + (a >> 1)) + quad * 4 + r;
            S[a][r] = __expf(G[k]) * S[a][r] + L[(a * 4 + r) * 256 + t];
          }
      }
    }
    float gacc = 0.f;

    u32x4 qr[4], kr[4], vr, rr;
    auto step_rows = [&](int s, int& rowbase, int& nv) {
      bool meta;
      if (dir == 0) { meta = first && s == 0; rowbase = (seg * 16 + s - (first ? 1 : 0)) * 64; }
      else { meta = (s == 16); rowbase = (seg * 16 + 15 - s) * 64; }
      if (meta) { rowbase = NTOKG + seq * 16; nv = 16; } else nv = 64;
    };
    auto gload = [&](int s) {
      int rowbase, nv; step_rows(s, rowbase, nv);
#pragma unroll
      for (int j = 0; j < 4; ++j) {
        const int i = (t >> 4) + 16 * j;
        const int mr = dir ? rowbase + nv - 1 - i : rowbase + i;
        u32x4 z = MK4(0, 0, 0, 0);
        if (i < nv) {
          const bf16_t* rp = Xg + (size_t)mr * XLD + (t & 15) * 8;
          qr[j] = do_out ? *(const u32x4*)(rp + qcol) : z;
          kr[j] = *(const u32x4*)(rp + kcol);
        } else { qr[j] = z; kr[j] = z; }
      }
      {
        const int i = t >> 2;
        const int mr = dir ? rowbase + nv - 1 - i : rowbase + i;
        vr = MK4(0, 0, 0, 0);
        if (i < nv) vr = *(const u32x4*)(Xg + (size_t)mr * XLD + vcol + (t & 3) * 8);
      }
      if (MIX == 1) {
        rr = MK4(0, 0, 0, 0);
        if (t < 128) {
          const int i = t >> 1;
          const int mr = dir ? rowbase + nv - 1 - i : rowbase + i;
          if (i < nv) rr = *(const u32x4*)(p.R + (size_t)mr * 32 + dir * 16 + (t & 1) * 8);
        }
      }
    };
    gload(0);

    for (int s = 0; s < nsteps; ++s) {
      int rowbase, nv; step_rows(s, rowbase, nv);
#pragma unroll
      for (int j = 0; j < 4; ++j) {
        const int i = (t >> 4) + 16 * j;
        *(u32x4*)(QS + i * 136 + (t & 15) * 8) = qr[j];
        *(u32x4*)(KS + i * 136 + (t & 15) * 8) = kr[j];
      }
      {
        const int i = t >> 2, piece = t & 3;
        uint32_t vv[4] = {vr.x, vr.y, vr.z, vr.w};
        bf16_t* vtw = VT + piece * 8 * 72 + i;
#pragma unroll
        for (int e = 0; e < 8; ++e) vtw[e * 72] = (bf16_t)((vv[e >> 1] >> ((e & 1) * 16)) & 0xffffu);
      }
      if (MIX == 1 && t < 128) *(u32x4*)(RS + (t >> 1) * 24 + (t & 1) * 8) = rr;
      if (s + 1 < nsteps) gload(s + 1);
      __syncthreads();
      if (MIX == 1) {
        bf16_t* lgw = LG + quad * 4 * 128 + 32 * w + l15;
        bf16x8 af[4];
#pragma unroll
        for (int it = 0; it < 4; ++it) {
          af[it] = (bf16x8){0, 0, 0, 0, 0, 0, 0, 0};
          if (quad < 2) af[it] = *(const bf16x8*)(RS + (16 * it + l15) * 24 + quad * 8);
        }
#pragma unroll
        for (int ct = 0; ct < 2; ++ct)
#pragma unroll
          for (int it = 0; it < 4; ++it) {
            f32x4 z = __builtin_amdgcn_mfma_f32_16x16x32_bf16(af[it], wgf[ct], (f32x4){0.f, 0.f, 0.f, 0.f}, 0, 0, 0);
#pragma unroll
            for (int r = 0; r < 4; ++r) {
              float zz = z[r] + bgv[ct];
              float ls = fminf(zz, 0.f) - __logf(1.f + __expf(-fabsf(zz)));
              lgw[(16 * it + r) * 128 + 16 * ct] = f2bf(ls * 0.0625f);
            }
          }
        __syncthreads();
      }
      const int c = t & 127, half = t >> 7, i0 = half * 32;
      const int nvl = nv - i0;
      float pf[32];
      {
        float run = 0.f;
        const bf16_t* lfp = (MIX == 0) ? (KS + i0 * 136 + c) : (LG + i0 * 128 + c);
        constexpr int LFS = (MIX == 0) ? 136 : 128;
#pragma unroll
        for (int ii = 0; ii < 32; ++ii) {
          if ((ii & 7) == 0) __builtin_amdgcn_sched_barrier(0);
          float lf = bf2f(lfp[ii * LFS]);
          if (ii >= nvl) lf = 0.f;
          run += lf;
          pf[ii] = run;
        }
        tot[half * 128 + c] = run;
      }
      __syncthreads();
      {
        const float t0 = tot[c], t1 = tot[128 + c];
        const float m = t0;
        const float base = half ? t0 : 0.f;
        float prev = 0.f;
        u32x4* kd = (u32x4*)(KT + c * 72 + i0);
        bf16_t* qp = QS + i0 * 136 + c;
        bf16_t* kp = KS + i0 * 136 + c;
#pragma unroll
        for (int grp = 0; grp < 4; ++grp) {
        __builtin_amdgcn_sched_barrier(0);
        uint32_t ktp[4];
#pragma unroll
        for (int i8 = 0; i8 < 8; ++i8) {
          const int ii = grp * 8 + i8;
          const float b = base + pf[ii];
          const float eq = fminf(fmaxf(b - m, -80.f), 80.f);
          const float sq = __expf(eq), sk = __expf(-eq);
          if (do_out) {
            const float q = bf2f(qp[ii * 136]);
            qp[ii * 136] = f2bf(q * sq);
          }
          float k;
          if (MIX == 0) { k = (ii < nvl) ? 1.f - __expf(pf[ii] - prev) : 0.f; }
          else k = bf2f(kp[ii * 136]);
          prev = pf[ii];
          const bf16_t kb = f2bf(k * sk);
          if (do_out) kp[ii * 136] = kb;
          if (i8 & 1) ktp[i8 >> 1] |= ((uint32_t)kb) << 16; else ktp[i8 >> 1] = kb;
        }
        kd[grp] = MK4(ktp[0], ktp[1], ktp[2], ktp[3]);
        }
        if (half == 0) { em[c] = __expf(m); el[c] = __expf(t1); }
        gacc += t0 + t1;
      }
      __syncthreads();
      bf16x8 vf[2][2];
#pragma unroll
      for (int vt = 0; vt < 2; ++vt)
#pragma unroll
        for (int js = 0; js < 2; ++js) vf[vt][js] = *(const bf16x8*)(VT + (16 * vt + l15) * 72 + js * 32 + quad * 8);
      if (do_out) {
        bf16_t* pw = Pm + (16 * w + quad * 4) * 72 + l15;
        bf16x8 qf[4];
#pragma unroll
        for (int ks = 0; ks < 4; ++ks) qf[ks] = *(const bf16x8*)(QS + (16 * w + l15) * 136 + ks * 32 + quad * 8);
#pragma unroll
        for (int jt = 0; jt < 4; ++jt) {
          f32x4 pa = (f32x4){0.f, 0.f, 0.f, 0.f};
          if (jt <= w) {
#pragma unroll
            for (int ks = 0; ks < 4; ++ks) {
              bf16x8 kf = *(const bf16x8*)(KS + (16 * jt + l15) * 136 + ks * 32 + quad * 8);
              pa = __builtin_amdgcn_mfma_f32_16x16x32_bf16(qf[ks], kf, pa, 0, 0, 0);
            }
          }
#pragma unroll
          for (int r = 0; r < 4; ++r) {
            const int i = 16 * w + quad * 4 + r, j = 16 * jt + l15;
            const float val = (jt <= w && j <= i) ? pa[r] : 0.f;
            pw[r * 72 + 16 * jt] = f2bf(val);
          }
        }
#pragma unroll
        for (int a = 0; a < 4; ++a) {
          const int k0 = 16 * (2 * w + (a >> 1)) + quad * 4;
          const int v = 16 * (a & 1) + l15;
          const fl4 e = *(const fl4*)(em + k0);
          S[a][0] *= e.x; S[a][1] *= e.y; S[a][2] *= e.z; S[a][3] *= e.w;
          *(u32x2*)(SmT + v * 136 + k0) = MK2(pack2(S[a][0], S[a][1]), pack2(S[a][2], S[a][3]));
        }
        __syncthreads();
        f32x4 oa[2];
        oa[0] = (f32x4){0.f, 0.f, 0.f, 0.f}; oa[1] = oa[0];
#pragma unroll
        for (int vt = 0; vt < 2; ++vt)
#pragma unroll
          for (int ks = 0; ks < 4; ++ks) {
            bf16x8 sf = *(const bf16x8*)(SmT + (16 * vt + l15) * 136 + ks * 32 + quad * 8);
            oa[vt] = __builtin_amdgcn_mfma_f32_16x16x32_bf16(qf[ks], sf, oa[vt], 0, 0, 0);
          }
#pragma unroll
        for (int js = 0; js < 2; ++js) {
          bf16x8 pfr = *(const bf16x8*)(Pm + (16 * w + l15) * 72 + js * 32 + quad * 8);
#pragma unroll
          for (int vt = 0; vt < 2; ++vt) oa[vt] = __builtin_amdgcn_mfma_f32_16x16x32_bf16(pfr, vf[vt][js], oa[vt], 0, 0, 0);
        }
#pragma unroll
        for (int vt = 0; vt < 2; ++vt)
#pragma unroll
          for (int r = 0; r < 4; ++r) {
            const int i = 16 * w + quad * 4 + r;
            if (i < nv) {
              const int mr = dir ? rowbase + nv - 1 - i : rowbase + i;
              Og[(size_t)mr * OLD + 16 * vt + l15] = f2bf(oa[vt][r]);
            }
          }
      } else {
#pragma unroll
        for (int a = 0; a < 4; ++a) {
          const int k0 = 16 * (2 * w + (a >> 1)) + quad * 4;
          const fl4 e = *(const fl4*)(em + k0);
          S[a][0] *= e.x; S[a][1] *= e.y; S[a][2] *= e.z; S[a][3] *= e.w;
        }
      }
#pragma unroll
      for (int ktl = 0; ktl < 2; ++ktl)
#pragma unroll
        for (int js = 0; js < 2; ++js) {
          bf16x8 kf = *(const bf16x8*)(KT + (16 * (2 * w + ktl) + l15) * 72 + js * 32 + quad * 8);
#pragma unroll
          for (int vt = 0; vt < 2; ++vt)
            S[ktl * 2 + vt] = __builtin_amdgcn_mfma_f32_16x16x32_bf16(kf, vf[vt][js], S[ktl * 2 + vt], 0, 0, 0);
        }
#pragma unroll
      for (int a = 0; a < 4; ++a) {
        const int k0 = 16 * (2 * w + (a >> 1)) + quad * 4;
        const fl4 e = *(const fl4*)(el + k0);
        S[a][0] *= e.x; S[a][1] *= e.y; S[a][2] *= e.z; S[a][3] *= e.w;
      }
      __syncthreads();
    }
    if (!do_out) {
      float* L = p.ST + (size_t)item * 4096;
#pragma unroll
      for (int a = 0; a < 4; ++a)
#pragma unroll
        for (int r = 0; r < 4; ++r) L[(a * 4 + r) * 256 + t] = S[a][r];
      if (dvb == 0 && t < 128) p.GD[((seg * 8 + head) * 2 + dir) * 128 + t] = gacc;
    }
  }
}

__device__ void phase_hn(const Params& p, int l) {
  const int bid_ = opaque_bid();
  const int t = opaque_tid(), lane = t & 63, w = t >> 6;
  const bf16_t* Y1 = p.X + (size_t)MROWS * 2048;
  const bf16_t* Y2 = Y1 + (size_t)MROWS * 1024;
  for (int row = bid_ * 4 + w; row < MROWS; row += gridDim.x * 4) {
    bf16_t* oa = p.O + (size_t)row * 2048 + lane * 16;
    float xa[16], xb[16];
    {
      u32x4 a0 = *(const u32x4*)(oa), a1 = *(const u32x4*)(oa + 8);
      u32x4 b0 = *(const u32x4*)(oa + 1024), b1 = *(const u32x4*)(oa + 1032);
      uint32_t ua[8] = {a0.x, a0.y, a0.z, a0.w, a1.x, a1.y, a1.z, a1.w};
      uint32_t ub[8] = {b0.x, b0.y, b0.z, b0.w, b1.x, b1.y, b1.z, b1.w};
#pragma unroll
      for (int e = 0; e < 8; ++e) {
        xa[2 * e] = __uint_as_float(ua[e] << 16) + __uint_as_float(ub[e] << 16);
        xa[2 * e + 1] = __uint_as_float(ua[e] & 0xffff0000u) + __uint_as_float(ub[e] & 0xffff0000u);
      }
      const bf16_t* y1 = Y1 + (size_t)row * 1024 + lane * 16;
      const bf16_t* y2 = Y2 + (size_t)row * 1024 + lane * 16;
      u32x4 c0 = *(const u32x4*)(y1), c1 = *(const u32x4*)(y1 + 8);
      u32x4 d0 = *(const u32x4*)(y2), d1 = *(const u32x4*)(y2 + 8);
      uint32_t uc[8] = {c0.x, c0.y, c0.z, c0.w, c1.x, c1.y, c1.z, c1.w};
      uint32_t ud[8] = {d0.x, d0.y, d0.z, d0.w, d1.x, d1.y, d1.z, d1.w};
#pragma unroll
      for (int e = 0; e < 8; ++e) {
        xb[2 * e] = __uint_as_float(uc[e] << 16) + __uint_as_float(ud[e] << 16);
        xb[2 * e + 1] = __uint_as_float(uc[e] & 0xffff0000u) + __uint_as_float(ud[e] & 0xffff0000u);
      }
    }
    float sa = 0.f, sb = 0.f;
#pragma unroll
    for (int e = 0; e < 16; ++e) { sa += xa[e] * xa[e]; sb += xb[e] * xb[e]; }
    sa += __shfl_xor(sa, 1); sa += __shfl_xor(sa, 2); sa += __shfl_xor(sa, 4);
    sb += __shfl_xor(sb, 1); sb += __shfl_xor(sb, 2); sb += __shfl_xor(sb, 4); sb += __shfl_xor(sb, 8);
    const float ra = rsqrtf(sa * (1.f / 128.f) + 1e-6f);
    const float rb = rsqrtf(sb * (1.f / 256.f) + 1e-6f);
    const float* na = p.norm_a + l * 1024 + lane * 16;
    const float* nb = p.norm_b + l * 1024 + lane * 16;
    uint32_t pa[8], pb[8];
#pragma unroll
    for (int e = 0; e < 8; ++e) {
      pa[e] = pack2(xa[2 * e] * ra * na[2 * e], xa[2 * e + 1] * ra * na[2 * e + 1]);
      pb[e] = pack2(xb[2 * e] * rb * nb[2 * e], xb[2 * e + 1] * rb * nb[2 * e + 1]);
    }
    *(u32x4*)(oa) = MK4(pa[0], pa[1], pa[2], pa[3]);
    *(u32x4*)(oa + 8) = MK4(pa[4], pa[5], pa[6], pa[7]);
    *(u32x4*)(oa + 1024) = MK4(pb[0], pb[1], pb[2], pb[3]);
    *(u32x4*)(oa + 1032) = MK4(pb[4], pb[5], pb[6], pb[7]);
  }
}

__device__ void phase_final(const Params& p) {
  const int bid_ = opaque_bid();
  const int t = opaque_tid(), lane = t & 63, w = t >> 6;
  for (int row = bid_ * 4 + w; row < 2 * NTOKG; row += gridDim.x * 4) {
    float* hp = p.out + (size_t)row * 1024;
    fl4 v[4];
    float s = 0.f;
#pragma unroll
    for (int j = 0; j < 4; ++j) {
      v[j] = *(const fl4*)(hp + j * 256 + lane * 4);
      s += v[j].x * v[j].x + v[j].y * v[j].y + v[j].z * v[j].z + v[j].w * v[j].w;
    }
    s += __shfl_xor(s, 1); s += __shfl_xor(s, 2); s += __shfl_xor(s, 4);
    s += __shfl_xor(s, 8); s += __shfl_xor(s, 16); s += __shfl_xor(s, 32);
    const float rs = rsqrtf(s * (1.f / 1024.f) + 1e-6f);
#pragma unroll
    for (int j = 0; j < 4; ++j) {
      const fl4 gn = *(const fl4*)(p.final_norm + j * 256 + lane * 4);
      fl4 o = MKF4(v[j].x * rs * gn.x, v[j].y * rs * gn.y, v[j].z * rs * gn.z, v[j].w * rs * gn.w);
      *(fl4*)(hp + j * 256 + lane * 4) = o;
    }
  }
}

__device__ void run_phase(const Params& p, int ph, char* smem) {
  if (ph == 0) { phase_init(p, smem); return; }
  if (ph == NPHASES - 1) { phase_final(p); return; }
  const int q = ph - 1;
  const int lg = q / 11, st = q % 11;
  const int l = lg >> 1, g = lg & 1;
  switch (st) {
    case 0: gemm_phase<EPI_G1A>(p, l, g, smem); break;
    case 1: scan_phase<0, 1>(p, l, g, smem); break;
    case 2: scan_phase<0, 3>(p, l, g, smem); break;
    case 3: gemm_phase<EPI_G1B>(p, l, g, smem); break;
    case 4: scan_phase<1, 1>(p, l, g, smem); break;
    case 5: scan_phase<1, 3>(p, l, g, smem); break;
    case 6: phase_hn(p, l); break;
    case 7: gemm_phase<EPI_GATES>(p, l, g, smem); break;
    case 8: gemm_phase<EPI_WOUT>(p, l, g, smem); break;
    case 9: gemm_phase<EPI_UP>(p, l, g, smem); break;
    default: gemm_phase<EPI_DOWN>(p, l, g, smem); break;
  }
}

template <int ST>
__global__ void __launch_bounds__(256, 2) pk(Params p, int l, int g) {
  extern __shared__ __attribute__((aligned(16))) char smem[];
  if (ST == 100) phase_init(p, smem);
  else if (ST == 101) phase_final(p);
  else if (ST == 0) gemm_phase<EPI_G1A>(p, l, g, smem);
  else if (ST == 1) scan_phase<0, 1>(p, l, g, smem);
  else if (ST == 2) scan_phase<0, 3>(p, l, g, smem);
  else if (ST == 3) gemm_phase<EPI_G1B>(p, l, g, smem);
  else if (ST == 4) scan_phase<1, 1>(p, l, g, smem);
  else if (ST == 5) scan_phase<1, 3>(p, l, g, smem);
  else if (ST == 6) phase_hn(p, l);
  else if (ST == 7) gemm_phase<EPI_GATES>(p, l, g, smem);
  else if (ST == 8) gemm_phase<EPI_WOUT>(p, l, g, smem);
  else if (ST == 9) gemm_phase<EPI_UP>(p, l, g, smem);
  else gemm_phase<EPI_DOWN>(p, l, g, smem);
}

#ifndef MULTI_LAUNCH
__global__ void __launch_bounds__(256, 2) mega(Params p, int plo, int phi, int coop) {
  extern __shared__ __attribute__((aligned(16))) char smem[];
  for (int ph = plo; ph < phi; ++ph) {
    run_phase(p, ph, smem);
    if (coop && ph + 1 < phi) cg::this_grid().sync();
  }
}

#endif

static inline size_t align_up(size_t x) { return (x + 255) & ~(size_t)255; }

extern "C" void kernel_launch(void* const* d_in, const int* in_sizes, int n_in,
                              void* d_out, int out_size, void* d_ws, size_t ws_size,
                              hipStream_t stream) {
  Params p{};
  p.x[0] = (const float*)d_in[0];
  p.x[1] = (const float*)d_in[1];
  p.meta = (const float*)d_in[2];
  p.attn_norm = (const float*)d_in[3];
  p.w_in = (const float*)d_in[4];
  p.lb_logits = (const float*)d_in[5];
  p.w_gate = (const float*)d_in[6];
  p.b_gate = (const float*)d_in[7];
  p.norm_a = (const float*)d_in[8];
  p.norm_b = (const float*)d_in[9];
  p.w_out = (const float*)d_in[10];
  p.mlp_norm = (const float*)d_in[11];
  p.w_up = (const float*)d_in[12];
  p.w_down = (const float*)d_in[13];
  p.final_norm = (const float*)d_in[14];
  p.out = (float*)d_out;
  char* ws = (char*)d_ws;
  size_t off = 0;
  p.W = (bf16_t*)(ws + off); off = align_up(off + (size_t)2 * LSTRIDE * 2);
  p.X = (bf16_t*)(ws + off); off = align_up(off + (size_t)MROWS * 4096 * 2);
  p.R = (bf16_t*)(ws + off); off = align_up(off + (size_t)MROWS * 32 * 2);
  p.O = (bf16_t*)(ws + off); off = align_up(off + (size_t)MROWS * 2048 * 2);
  p.ST = (float*)(ws + off); off = align_up(off + (size_t)1024 * 4096 * 4);
  p.GD = (float*)(ws + off); off = align_up(off + (size_t)16 * 8 * 2 * 128 * 4);
  p.hmeta = (float*)(ws + off); off = align_up(off + (size_t)2 * 128 * 1024 * 4);
  if (off > ws_size) { fprintf(stderr, "workspace too small: need %zu have %zu\n", off, ws_size); return; }

#ifdef MULTI_LAUNCH
#define LAUNCH_PK(ST, l, g) do { \
    static bool attr_set_##ST = false; \
    if (!attr_set_##ST) { (void)hipFuncSetAttribute((const void*)pk<ST>, hipFuncAttributeMaxDynamicSharedMemorySize, LDS_BYTES); attr_set_##ST = true; } \
    hipLaunchKernelGGL(pk<ST>, dim3(512), dim3(256), LDS_BYTES, stream, p, l, g); } while (0)
  LAUNCH_PK(100, 0, 0);
  for (int l = 0; l < 2; ++l)
    for (int g = 0; g < 2; ++g) {
      LAUNCH_PK(0, l, g); LAUNCH_PK(1, l, g); LAUNCH_PK(2, l, g); LAUNCH_PK(3, l, g); LAUNCH_PK(4, l, g); LAUNCH_PK(5, l, g);
      LAUNCH_PK(6, l, g); LAUNCH_PK(7, l, g); LAUNCH_PK(8, l, g); LAUNCH_PK(9, l, g); LAUNCH_PK(10, l, g);
    }
  LAUNCH_PK(101, 0, 0);
#else
  static int grid_blocks = 0;
  if (!grid_blocks) {
    (void)hipFuncSetAttribute((const void*)mega, hipFuncAttributeMaxDynamicSharedMemorySize, LDS_BYTES);
    int dev = 0, cus = 0, per_cu = 0;
    (void)hipGetDevice(&dev);
    (void)hipDeviceGetAttribute(&cus, hipDeviceAttributeMultiprocessorCount, dev);
    (void)hipOccupancyMaxActiveBlocksPerMultiprocessor(&per_cu, (const void*)mega, 256, LDS_BYTES);
    if (per_cu < 1) per_cu = 1;
    if (per_cu > 2) per_cu = 2;
    grid_blocks = cus * per_cu;
  }
  int plo = 0, phi = NPHASES, coop = 1;
  void* args[] = {&p, &plo, &phi, &coop};
  hipError_t e = hipLaunchCooperativeKernel((const void*)mega, dim3(grid_blocks), dim3(256), args, LDS_BYTES, stream);
  if (e != hipSuccess) fprintf(stderr, "cooperative launch failed: %s (grid %d)\n", hipGetErrorString(e), grid_blocks);
#endif
}
```

```cpp
#include <hip/hip_runtime.h>
#include <hip/hip_cooperative_groups.h>
#include <stdint.h>
#include <stdio.h>
namespace cg = cooperative_groups;

typedef __attribute__((ext_vector_type(8))) short bf16x8;
typedef __attribute__((ext_vector_type(4))) float f32x4;
typedef unsigned short bf16_t;
typedef uint32_t u32x4 __attribute__((ext_vector_type(4)));
typedef uint32_t u32x2 __attribute__((ext_vector_type(2)));
typedef float fl4 __attribute__((ext_vector_type(4)));
#define MK4(a,b,c,d) ((u32x4){(uint32_t)(a),(uint32_t)(b),(uint32_t)(c),(uint32_t)(d)})
#define MK2(a,b) ((u32x2){(uint32_t)(a),(uint32_t)(b)})
#define MKF4(a,b,c,d) ((fl4){(a),(b),(c),(d)})

#define NTOKG 16384
#define MROWS 16512
#define MTILES 129
#define LSTRIDE 20185088
#define WOFF_A 0
#define WOFF_B (4096 * 1024)
#define WOFF_G (6400 * 1024)
#define WOFF_O (10496 * 1024)
#define WOFF_U (11520 * 1024)
#define WOFF_D (15616 * 1024)
#define LDS_BYTES 80896
#define NPHASES 48

struct Params {
  const float* x[2];
  const float* meta;
  const float* attn_norm;
  const float* w_in;
  const float* lb_logits;
  const float* w_gate;
  const float* b_gate;
  const float* norm_a;
  const float* norm_b;
  const float* w_out;
  const float* mlp_norm;
  const float* w_up;
  const float* w_down;
  const float* final_norm;
  float* out;
  bf16_t* W;
  bf16_t* X;
  bf16_t* R;
  bf16_t* O;
  bf16_t* HB;
  bf16_t* ST;
  float* GD;
  float* hmeta;
  unsigned* bar;
};

__device__ __forceinline__ uint32_t pack2(float a, float b) {
  uint32_t r;
  asm("v_cvt_pk_bf16_f32 %0, %1, %2" : "=v"(r) : "v"(a), "v"(b));
  return r;
}
__device__ __forceinline__ bf16_t f2bf(float f) { return (bf16_t)(pack2(f, f) & 0xffffu); }
__device__ __forceinline__ int opaque_tid(char* smem) {
  int lane;
  asm volatile("v_mbcnt_lo_u32_b32 %0, -1, 0\n\tv_mbcnt_hi_u32_b32 %0, -1, %0" : "=v"(lane));
  int* cnt = (int*)(smem + LDS_BYTES);
  int w = 0;
  if (lane == 0) w = atomicAdd(cnt, 1);
  w = __builtin_amdgcn_readfirstlane(w) & 3;
  __syncthreads();
  return w * 64 + lane;
}
__device__ __forceinline__ int opaque_bid() { int b = blockIdx.x; asm volatile("" : "+s"(b)); return b; }
template <int M>
__device__ __forceinline__ float shx(float v, int lane) {
  if (M < 32) return __builtin_bit_cast(float, __builtin_amdgcn_ds_swizzle(__builtin_bit_cast(int, v), 0x1f | (M << 10)));
  return __builtin_bit_cast(float, __builtin_amdgcn_ds_bpermute((lane ^ M) << 2, __builtin_bit_cast(int, v)));
}
__device__ __forceinline__ float bf2f(bf16_t b) { return __uint_as_float(((uint32_t)b) << 16); }
__device__ __forceinline__ float sigmoidf_(float x) { return 1.f / (1.f + __expf(-x)); }

__device__ __forceinline__ int w_in_col(int R, float& scale) {
  scale = 1.f;
  if (R < 4096) return R;
  if (R < 6400) {
    int n = R - 4096;
    if (n >= 2080) return -1;
    if (n < 512) scale = 0.08838834764831845f;
    return 5120 + n;
  }
  int n = R - 6400;
  int tt = n >> 8, wv = n & 255;
  int wn = wv >> 7, nl = wv & 127;
  int qd = nl >> 5, ni = (nl >> 2) & 7, r = nl & 3;
  int grp = ni >> 2, seg = ni & 3;
  int ucol = tt * 64 + wn * 32 + qd * 8 + grp * 4 + r;
  int base = seg == 0 ? 4096 : seg == 1 ? 8224 : seg == 2 ? 7200 : 9248;
  return base + ucol;
}

__device__ __forceinline__ void phase_init(const Params& p, char* smem) {
  const int t = opaque_tid(smem);
  const int bid_ = opaque_bid();
  for (int idx = bid_ * 256 + t; idx < 2 * 128 * 256; idx += gridDim.x * 256) {
    int g = idx / (128 * 256), r = (idx / 256) % 128, c4 = idx % 256;
    int nvalid = g == 0 ? 16 : 64;
    fl4 v = MKF4(0.f, 0.f, 0.f, 0.f);
    if (r < nvalid) v = *(const fl4*)(p.meta + (size_t)(r & 15) * 1024 + c4 * 4);
    *(fl4*)(p.hmeta + ((size_t)g * 128 + r) * 1024 + c4 * 4) = v;
  }
  float* tile = (float*)smem;
  const int per_layer = 3904 + 1024;
  for (int id = bid_; id < 2 * per_layer; id += gridDim.x) {
    int l = id / per_layer, r = id % per_layer;
    const float* src; int ld; const float* gain = nullptr; int K, n0, k0;
    bf16_t* dst;
    int kind;
    int cbase = 0;
    if (r < 3904) {
      int rt = r >> 4, kt = r & 15;
      n0 = rt * 64; k0 = kt * 64; K = 1024;
      dst = p.W + (size_t)l * LSTRIDE;
      if (n0 < 10496) { kind = 0; src = p.w_in + (size_t)l * 1024 * 10272; ld = 10272; gain = p.attn_norm + l * 1024; }
      else if (n0 < 11520) { kind = 1; src = p.w_out + (size_t)l * 1024 * 1024; ld = 1024; cbase = n0 - 10496; }
      else { kind = 1; src = p.w_up + (size_t)l * 1024 * 4096; ld = 4096; cbase = n0 - 11520; gain = p.mlp_norm + l * 1024; }
    } else {
      int r2 = r - 3904;
      int rt = r2 >> 6, kt = r2 & 63;
      n0 = rt * 64; k0 = kt * 64; K = 4096;
      dst = p.W + (size_t)l * LSTRIDE + WOFF_D;
      kind = 1; src = p.w_down + (size_t)l * 4096 * 1024; ld = 1024; cbase = n0;
    }
    {
      int n = t & 63;
      float scale = 1.f; int col;
      if (kind == 0) col = w_in_col(n0 + n, scale); else col = cbase + n;
#pragma unroll 4
      for (int i = 0; i < 16; ++i) {
        int kk = (t >> 6) + 4 * i;
        float v = 0.f;
        if (col >= 0) {
          v = src[(size_t)(k0 + kk) * ld + col] * scale;
          if (gain) v *= gain[k0 + kk];
        }
        tile[kk * 65 + n] = v;
      }
    }
    __syncthreads();
    {
      int n = t >> 2, piece = t & 3;
      uint32_t pk[8];
#pragma unroll
      for (int e = 0; e < 8; ++e) {
        float a = tile[(piece * 16 + 2 * e) * 65 + n];
        float b = tile[(piece * 16 + 2 * e + 1) * 65 + n];
        pk[e] = pack2(a, b);
      }
      const int Rr = n0 + n, kk = k0 + piece * 16;
      u32x4* d = (u32x4*)(dst + ((size_t)((Rr >> 8) * (K >> 5) + (kk >> 5)) * 256 + (Rr & 255)) * 32 + (kk & 31));
      d[0] = MK4(pk[0], pk[1], pk[2], pk[3]);
      d[1] = MK4(pk[4], pk[5], pk[6], pk[7]);
    }
    __syncthreads();
  }
}

enum { EPI_G1A = 0, EPI_G1B, EPI_GATES, EPI_WOUT, EPI_UP, EPI_DOWN };

template <int EPI>
__device__ __forceinline__ void gemm_phase(const Params& p, int l, int g, char* smem) {
  constexpr bool NORM = (EPI == EPI_G1A || EPI == EPI_G1B || EPI == EPI_GATES || EPI == EPI_UP);
  constexpr int K = (EPI == EPI_DOWN) ? 4096 : 1024;
  constexpr int NT = EPI == EPI_G1A ? 16 : EPI == EPI_G1B ? 9 : EPI == EPI_GATES ? 16 : EPI == EPI_WOUT ? 4 : EPI == EPI_UP ? 16 : 4;
  constexpr int WOFF = EPI == EPI_G1A ? WOFF_A : EPI == EPI_G1B ? WOFF_B : EPI == EPI_GATES ? WOFF_G : EPI == EPI_WOUT ? WOFF_O : EPI == EPI_UP ? WOFF_U : WOFF_D;
  constexpr int NK = K / 32;
  const bf16_t* Wl = p.W + (size_t)l * LSTRIDE + WOFF;
  bf16_t* As = (bf16_t*)smem;
  bf16_t* Bs = As + 2 * 128 * 32;
  float* rss = (float*)(Bs + 2 * 256 * 32);
  const int bid_ = opaque_bid();
  const int t = opaque_tid(smem), lane = t & 63, w = t >> 6, wm = w >> 1, wn = w & 1;
  const int quad = lane >> 4, l15 = lane & 15;
  const int nvalid_meta = g == 0 ? 16 : 64;

  for (int tile = bid_; tile < MTILES * NT; tile += gridDim.x) {
    const int mt = tile / NT, nt = tile % NT;
    const bf16_t* Ab = NORM ? p.HB + (size_t)mt * 128 * 1024 : p.X + (size_t)mt * 128 * K;
    const bf16_t* Bg = Wl + (size_t)nt * 256 * K;
    const bool do_mma = !(mt == 128 && wm == 1) && !(EPI == EPI_G1B && nt == 8 && wn == 1);

    f32x4 acc[4][8];
#pragma unroll
    for (int a = 0; a < 4; ++a)
#pragma unroll
      for (int b = 0; b < 8; ++b) acc[a][b] = (f32x4){0.f, 0.f, 0.f, 0.f};
    float ss[2] = {0.f, 0.f};
    int t_l = t;
    asm volatile("" : "+v"(t_l));
    const uint32_t voffA = (uint32_t)((t_l >> 2) * (K * 2) + (((t_l & 3) ^ (((t_l >> 5) & 1) << 1)) * 16));
    const uint32_t voffB0 = (uint32_t)((t_l >> 2) * 64 + ((t_l & 3) * 16));
    const uint32_t voffB1 = (uint32_t)((t_l >> 2) * 64 + (((t_l & 3) ^ 2) * 16));
    const char* Abase = (const char*)Ab;
    const char* Bbase = (const char*)Bg;
    const int rpiece = quad ^ (((l15 >> 3) & 1) << 1);
#define GLDS(gp, lp) __builtin_amdgcn_global_load_lds((const __attribute__((address_space(1))) void*)(gp), (__attribute__((address_space(3))) void*)(lp), 16, 0, 0)
#define G_DMA(KT, BUF) do { \
      _Pragma("unroll") for (int i = 0; i < 2; ++i) \
        GLDS(Abase + (size_t)i * (64 * K * 2) + (size_t)(KT) * 64 + voffA, (char*)(As + (BUF) * 4096) + (i * 256 + t) * 16); \
      _Pragma("unroll") for (int i = 0; i < 4; ++i) \
        GLDS(Bbase + (size_t)(KT) * 16384 + (size_t)i * 4096 + ((i & 1) ? voffB1 : voffB0), (char*)(Bs + (BUF) * 8192) + (i * 256 + t) * 16); } while (0)
#define G_COMPUTE(BUF) do { \
      if (NORM) { \
        _Pragma("unroll") for (int i = 0; i < 2; ++i) { \
          const u32x4 av = *(const u32x4*)((const char*)(As + (BUF) * 4096) + (i * 256 + t) * 16); \
          const uint32_t uu[4] = {av.x, av.y, av.z, av.w}; \
          _Pragma("unroll") for (int e = 0; e < 4; ++e) { \
            const float lo = __uint_as_float(uu[e] << 16), hi = __uint_as_float(uu[e] & 0xffff0000u); \
            ss[i] += lo * lo + hi * hi; } } } \
      if (do_mma) { \
      const bf16_t* Aw = As + (BUF) * 4096; const bf16_t* Bw = Bs + (BUF) * 8192; \
      bf16x8 af[4], bfr[8]; \
      _Pragma("unroll") for (int mi = 0; mi < 4; ++mi) af[mi] = *(const bf16x8*)(Aw + (wm * 64 + mi * 16 + l15) * 32 + rpiece * 8); \
      _Pragma("unroll") for (int ni = 0; ni < 8; ++ni) bfr[ni] = *(const bf16x8*)(Bw + (wn * 128 + (l15 >> 2) * 32 + ni * 4 + (l15 & 3)) * 32 + rpiece * 8); \
      __builtin_amdgcn_s_setprio(1); \
      _Pragma("unroll") for (int ni = 0; ni < 8; ++ni) \
        _Pragma("unroll") for (int mi = 0; mi < 4; ++mi) \
          acc[mi][ni] = __builtin_amdgcn_mfma_f32_16x16x32_bf16(bfr[ni], af[mi], acc[mi][ni], 0, 0, 0); \
      __builtin_amdgcn_s_setprio(0); } } while (0)

    G_DMA(0, 0);
#pragma unroll 1
    for (int kt = 0; kt < NK; kt += 2) {
      asm volatile("s_waitcnt vmcnt(0)" ::: "memory");
      __syncthreads();
      G_DMA(kt + 1, 1);
      G_COMPUTE(0);
      asm volatile("s_waitcnt vmcnt(0)" ::: "memory");
      __syncthreads();
      { const int kn = (kt + 2 < NK) ? kt + 2 : NK - 1; G_DMA(kn, 0); }
      G_COMPUTE(1);
    }
    asm volatile("s_waitcnt vmcnt(0)" ::: "memory");
    __syncthreads();
#undef GLDS
#undef G_DMA
#undef G_COMPUTE

    int quad_e = quad, l15_e = l15, t_e = t;
    asm volatile("" : "+v"(quad_e), "+v"(l15_e), "+v"(t_e));
    if (NORM) {
#pragma unroll
      for (int i = 0; i < 2; ++i) {
        float s = ss[i];
        s += shx<1>(s, lane); s += shx<2>(s, lane);
        if ((t_e & 3) == 0) rss[(t_e >> 2) + 64 * i] = rsqrtf(s * (1.f / 1024.f) + 1e-6f);
      }
      __syncthreads();
    }
    if (do_mma) {
#pragma unroll
    for (int mi = 0; mi < 4; ++mi) {
      __builtin_amdgcn_sched_barrier(0);
      const int rl = wm * 64 + mi * 16 + l15_e;
      const size_t grow = (size_t)mt * 128 + rl;
      const float rs = NORM ? rss[rl] : 1.f;
      const int cw = wn * 128 + quad_e * 32;
      if (EPI == EPI_G1A) {
        const int region = nt >> 2;
        bf16_t* xp = p.X + grow * 4096 + nt * 256 + cw;
#pragma unroll
        for (int c = 0; c < 4; ++c) {
          float v[8];
#pragma unroll
          for (int e = 0; e < 8; ++e) v[e] = acc[mi][2 * c + (e >> 2)][e & 3] * rs;
          if (region == 1 || region == 2) {
            float lb[8] = {0.f, 0.f, 0.f, 0.f, 0.f, 0.f, 0.f, 0.f};
            if (l == 1) {
              const float* l0p = p.lb_logits + (region - 1) * 1024 + ((nt * 256 + cw + c * 8) & 1023);
              const fl4 a0 = *(const fl4*)l0p, a1 = *(const fl4*)(l0p + 4);
              const fl4 b0 = *(const fl4*)(l0p + 2048), b1 = *(const fl4*)(l0p + 2052);
              lb[0] = 1.f / (1.f + __expf(a0.x - b0.x)); lb[1] = 1.f / (1.f + __expf(a0.y - b0.y));
              lb[2] = 1.f / (1.f + __expf(a0.z - b0.z)); lb[3] = 1.f / (1.f + __expf(a0.w - b0.w));
              lb[4] = 1.f / (1.f + __expf(a1.x - b1.x)); lb[5] = 1.f / (1.f + __expf(a1.y - b1.y));
              lb[6] = 1.f / (1.f + __expf(a1.z - b1.z)); lb[7] = 1.f / (1.f + __expf(a1.w - b1.w));
            }
#pragma unroll
            for (int e = 0; e < 8; ++e) {
              const float f = fmaxf(lb[e], 1e-30f) + (1.f - lb[e]) * sigmoidf_(v[e]);
              v[e] = __builtin_amdgcn_logf(f);
            }
          }
          *(u32x4*)(xp + c * 8) = MK4(pack2(v[0], v[1]), pack2(v[2], v[3]), pack2(v[4], v[5]), pack2(v[6], v[7]));
        }
      } else if (EPI == EPI_G1B) {
        if (nt < 8) {
          bf16_t* xp = p.X + grow * 2048 + nt * 256 + cw;
#pragma unroll
          for (int c = 0; c < 4; ++c)
            *(u32x4*)(xp + c * 8) = MK4(pack2(acc[mi][2 * c][0] * rs, acc[mi][2 * c][1] * rs), pack2(acc[mi][2 * c][2] * rs, acc[mi][2 * c][3] * rs),
                                        pack2(acc[mi][2 * c + 1][0] * rs, acc[mi][2 * c + 1][1] * rs), pack2(acc[mi][2 * c + 1][2] * rs, acc[mi][2 * c + 1][3] * rs));
        } else if (cw == 0) {
          bf16_t* rp = p.R + grow * 32;
#pragma unroll
          for (int c = 0; c < 4; ++c)
            *(u32x4*)(rp + c * 8) = MK4(pack2(acc[mi][2 * c][0] * rs, acc[mi][2 * c][1] * rs), pack2(acc[mi][2 * c][2] * rs, acc[mi][2 * c][3] * rs),
                                        pack2(acc[mi][2 * c + 1][0] * rs, acc[mi][2 * c + 1][1] * rs), pack2(acc[mi][2 * c + 1][2] * rs, acc[mi][2 * c + 1][3] * rs));
        }
      } else if (EPI == EPI_GATES) {
        const int uc = nt * 64 + wn * 32 + quad_e * 8;
        const u32x4 oa = *(const u32x4*)(p.O + grow * 2048 + uc);
        const u32x4 ob = *(const u32x4*)(p.O + grow * 2048 + 1024 + uc);
        const uint32_t oau[4] = {oa.x, oa.y, oa.z, oa.w}, obu[4] = {ob.x, ob.y, ob.z, ob.w};
        float u[8];
#pragma unroll
        for (int grp = 0; grp < 2; ++grp)
#pragma unroll
          for (int r = 0; r < 4; ++r) {
            const int idx = grp * 4 + r;
            const float ga = acc[mi][grp * 4 + 0][r] * rs, ma = acc[mi][grp * 4 + 1][r] * rs;
            const float gb = acc[mi][grp * 4 + 2][r] * rs, mb = acc[mi][grp * 4 + 3][r] * rs;
            const float ona = (idx & 1) ? __uint_as_float(oau[idx >> 1] & 0xffff0000u) : __uint_as_float(oau[idx >> 1] << 16);
            const float onb = (idx & 1) ? __uint_as_float(obu[idx >> 1] & 0xffff0000u) : __uint_as_float(obu[idx >> 1] << 16);
            u[idx] = sigmoidf_(ma) * (ga * sigmoidf_(ga)) * ona + sigmoidf_(mb) * (gb * sigmoidf_(gb)) * onb;
          }
        *(u32x4*)(p.X + grow * 1024 + uc) = MK4(pack2(u[0], u[1]), pack2(u[2], u[3]), pack2(u[4], u[5]), pack2(u[6], u[7]));
      } else if (EPI == EPI_WOUT || EPI == EPI_DOWN) {
        const bool meta = (mt == 128);
        if (!meta || rl < nvalid_meta) {
          const float* hin; float* hout;
          if (meta) { hout = p.hmeta + ((size_t)g * 128 + rl) * 1024; hin = hout; }
          else {
            const size_t trow = (size_t)mt * 128 + rl;
            hout = p.out + ((size_t)g * NTOKG + trow) * 1024;
            hin = (EPI == EPI_WOUT && l == 0) ? p.x[g] + trow * 1024 : hout;
          }
          const int col0 = nt * 256 + cw;
          bf16_t* hb = p.HB + grow * 1024 + col0;
#pragma unroll
          for (int c = 0; c < 4; ++c) {
            const fl4 h0 = *(const fl4*)(hin + col0 + c * 8), h1 = *(const fl4*)(hin + col0 + c * 8 + 4);
            const fl4 o0 = MKF4(h0.x + acc[mi][2 * c][0], h0.y + acc[mi][2 * c][1], h0.z + acc[mi][2 * c][2], h0.w + acc[mi][2 * c][3]);
            const fl4 o1 = MKF4(h1.x + acc[mi][2 * c + 1][0], h1.y + acc[mi][2 * c + 1][1], h1.z + acc[mi][2 * c + 1][2], h1.w + acc[mi][2 * c + 1][3]);
            *(fl4*)(hout + col0 + c * 8) = o0;
            *(fl4*)(hout + col0 + c * 8 + 4) = o1;
            *(u32x4*)(hb + c * 8) = MK4(pack2(o0.x, o0.y), pack2(o0.z, o0.w), pack2(o1.x, o1.y), pack2(o1.z, o1.w));
          }
        }
      } else if (EPI == EPI_UP) {
        bf16_t* xp = p.X + grow * 4096 + nt * 256 + cw;
#pragma unroll
        for (int c = 0; c < 4; ++c) {
          float v[8];
#pragma unroll
          for (int e = 0; e < 8; ++e) { const float a = fmaxf(acc[mi][2 * c + (e >> 2)][e & 3] * rs, 0.f); v[e] = a * a; }
          *(u32x4*)(xp + c * 8) = MK4(pack2(v[0], v[1]), pack2(v[2], v[3]), pack2(v[4], v[5]), pack2(v[6], v[7]));
        }
      }
    }
    }
  }
}

template <int MIX, int PASS>
__device__ __forceinline__ void scan_phase(const Params& p, int l, int g, char* smem) {
  constexpr int NH = MIX ? 4 : 8;
  constexpr int NDV = MIX ? 4 : 2;
  constexpr int XLD = MIX ? 2048 : 4096;
  bf16_t* QS = (bf16_t*)smem;
  bf16_t* KS = QS + 64 * 136;
  bf16_t* KT = KS + 64 * 136;
  bf16_t* LG = KT;
  bf16_t* Pm = QS;
  bf16_t* SmT = KS;
  bf16_t* VT = KT + 128 * 72;
  bf16_t* RS = VT + 64 * 72;
  float* em = (float*)(RS + 64 * 24);
  float* el = em + 128;
  float* tot = el + 128;
  const int bid_ = opaque_bid();
  const int t_outer = opaque_tid(smem);
  const int sps = g == 0 ? 16 : 4;
  constexpr bool do_out = (PASS == 3);
  const bf16_t* Xg = p.X;

  for (int item = bid_; item < 512; item += gridDim.x) {
    int t = t_outer;
    asm volatile("" : "+v"(t));
    const int lane = t & 63, w = t >> 6, quad = lane >> 4, l15 = lane & 15;
    const int dir = item & 1;
    const int dvb = (item >> 1) % NDV;
    const int head = ((item >> 1) / NDV) % NH;
    const int seg = item >> 5;
    const int seq = seg / sps;
    const bool first = (seg % sps) == 0;
    const int nsteps = 16 + (first ? 1 : 0);
    int qcol, kcol, vcol;
    bf16_t* Og; int OLD;
    if (MIX == 0) {
      qcol = head * 128; kcol = 1024 + dir * 1024 + head * 128; vcol = 3072 + head * 128 + dvb * 64;
      Og = p.O + dir * 1024 + head * 128 + dvb * 64; OLD = 2048;
    } else {
      qcol = head * 128; kcol = 512 + head * 128; vcol = 1024 + head * 256 + dvb * 64;
      Og = p.X + (size_t)MROWS * 2048 + (size_t)dir * MROWS * 1024 + head * 256 + dvb * 64; OLD = 1024;
    }
    bf16x8 wgf[2]; float bgv[2][4];
    if (MIX == 1) {
#pragma unroll
      for (int ct = 0; ct < 2; ++ct) {
        const int cc = 16 * (2 * w + ct) + l15;
        bf16x8 v = (bf16x8){0, 0, 0, 0, 0, 0, 0, 0};
        if (quad < 2) {
#pragma unroll
          for (int e = 0; e < 8; ++e)
            v[e] = (short)f2bf(p.w_gate[((size_t)(l * 2 + dir) * 16 + quad * 8 + e) * 512 + head * 128 + cc]);
        }
        wgf[ct] = v;
#pragma unroll
        for (int r = 0; r < 4; ++r) bgv[ct][r] = p.b_gate[(l * 2 + dir) * 512 + head * 128 + 16 * (2 * w + ct) + quad * 4 + r];
      }
    }
    f32x4 S[8];
#pragma unroll
    for (int a = 0; a < 8; ++a) S[a] = (f32x4){0.f, 0.f, 0.f, 0.f};
    if (do_out) {
      int s2 = dir == 0 ? seq * sps : seq * sps + sps - 1;
      const int stp = dir == 0 ? 1 : -1;
      for (; s2 != seg; s2 += stp) {
        const int item2 = ((s2 * NH + head) * NDV + dvb) * 2 + dir;
        const bf16_t* L = p.ST + (size_t)item2 * 8192;
        const float* G = p.GD + ((s2 * 8 + head) * 2 + dir) * 128;
#pragma unroll
        for (int a = 0; a < 8; ++a)
#pragma unroll
          for (int r = 0; r < 4; ++r) {
            const int k = 16 * (2 * w + (a >> 2)) + quad * 4 + r;
            S[a][r] = __builtin_amdgcn_exp2f(G[k]) * S[a][r] + bf2f(L[(a * 4 + r) * 256 + t]);
          }
      }
    }
    float gacc0 = 0.f, gacc1 = 0.f;

    u32x4 qr[4], kr[4], vr[2], rr;
    auto step_rows = [&](int s, int& rowbase, int& nv) {
      bool meta;
      if (dir == 0) { meta = first && s == 0; rowbase = (seg * 16 + s - (first ? 1 : 0)) * 64; }
      else { meta = (s == 16); rowbase = (seg * 16 + 15 - s) * 64; }
      if (meta) { rowbase = NTOKG + seq * 16; nv = 16; } else nv = 64;
    };
    const char* Xq = (const char*)(Xg + qcol);
    const char* Xk = (const char*)(Xg + kcol);
    const char* Xv = (const char*)(Xg + vcol);
    const char* Rb = (const char*)(p.R + dir * 16);
    auto gload = [&](int s) {
      int rowbase, nv; step_rows(s, rowbase, nv);
#pragma unroll
      for (int j = 0; j < 4; ++j) {
        const int i = (t >> 4) + 16 * j;
        const int mr = dir ? rowbase + nv - 1 - i : rowbase + i;
        u32x4 z = MK4(0, 0, 0, 0);
        if (i < nv) {
          const uint32_t vo = (uint32_t)(mr * XLD + (t & 15) * 8) * 2u;
          qr[j] = do_out ? *(const u32x4*)(Xq + vo) : z;
          kr[j] = *(const u32x4*)(Xk + vo);
        } else { qr[j] = z; kr[j] = z; }
      }
      {
        const int i = t >> 2;
        const int mr = dir ? rowbase + nv - 1 - i : rowbase + i;
        vr[0] = MK4(0, 0, 0, 0); vr[1] = vr[0];
        if (i < nv) {
          const uint32_t vo = (uint32_t)(mr * XLD + (t & 3) * 16) * 2u;
          vr[0] = *(const u32x4*)(Xv + vo); vr[1] = *(const u32x4*)(Xv + vo + 16);
        }
      }
      if (MIX == 1) {
        rr = MK4(0, 0, 0, 0);
        if (t < 128) {
          const int i = t >> 1;
          const int mr = dir ? rowbase + nv - 1 - i : rowbase + i;
          if (i < nv) rr = *(const u32x4*)(Rb + (uint32_t)(mr * 32 + (t & 1) * 8) * 2u);
        }
      }
    };
    gload(0);

    for (int s = 0; s < nsteps; ++s) {
      int rowbase, nv; step_rows(s, rowbase, nv);
#pragma unroll
      for (int j = 0; j < 4; ++j) {
        const int i = (t >> 4) + 16 * j;
        if (do_out) *(u32x4*)(QS + i * 136 + (t & 15) * 8) = qr[j];
        *(u32x4*)(KS + i * 136 + (t & 15) * 8) = kr[j];
      }
      {
        const int i = t >> 2, piece = t & 3;
        uint32_t vv[8] = {vr[0].x, vr[0].y, vr[0].z, vr[0].w, vr[1].x, vr[1].y, vr[1].z, vr[1].w};
        bf16_t* vtw = VT + piece * 16 * 72 + i;
#pragma unroll
        for (int e = 0; e < 16; ++e) vtw[e * 72] = (bf16_t)((vv[e >> 1] >> ((e & 1) * 16)) & 0xffffu);
      }
      if (MIX == 1 && t < 128) *(u32x4*)(RS + (t >> 1) * 24 + (t & 1) * 8) = rr;
      if (s + 1 < nsteps) gload(s + 1);
      __syncthreads();
      if (MIX == 1) {
        bf16x8 af[4];
#pragma unroll
        for (int it = 0; it < 4; ++it) {
          af[it] = (bf16x8){0, 0, 0, 0, 0, 0, 0, 0};
          if (quad < 2) af[it] = *(const bf16x8*)(RS + (16 * it + l15) * 24 + quad * 8);
        }
#pragma unroll
        for (int ct = 0; ct < 2; ++ct)
#pragma unroll
          for (int it = 0; it < 4; ++it) {
            f32x4 z = __builtin_amdgcn_mfma_f32_16x16x32_bf16(wgf[ct], af[it], (f32x4){0.f, 0.f, 0.f, 0.f}, 0, 0, 0);
            float ls[4];
#pragma unroll
            for (int r = 0; r < 4; ++r) {
              const float zz = fmaxf(z[r] + bgv[ct][r], -80.f);
              ls[r] = __builtin_amdgcn_logf(1.f + __builtin_amdgcn_exp2f(zz * -1.4426950408889634f)) * -0.0625f;
            }
            *(u32x2*)(LG + (16 * it + l15) * 128 + 16 * (2 * w + ct) + quad * 4) = MK2(pack2(ls[0], ls[1]), pack2(ls[2], ls[3]));
          }
        __syncthreads();
      }
      const int cp = t & 63, rg = t >> 6;
      const int nvl = nv - 16 * rg;
      float p0[16], p1[16];
      {
        float run0 = 0.f, run1 = 0.f;
        constexpr int LFS32 = (MIX == 0) ? 68 : 64;
        const uint32_t* lfp = (const uint32_t*)((MIX == 0) ? (KS + 16 * rg * 136) : (LG + 16 * rg * 128)) + cp;
#pragma unroll
        for (int ii = 0; ii < 16; ++ii) {
          if ((ii & 7) == 0) __builtin_amdgcn_sched_barrier(0);
          const uint32_t u = lfp[ii * LFS32];
          float l0 = __uint_as_float(u << 16), l1 = __uint_as_float(u & 0xffff0000u);
          if (ii >= nvl) { l0 = 0.f; l1 = 0.f; }
          run0 += l0; run1 += l1;
          p0[ii] = run0; p1[ii] = run1;
        }
        *(float2*)(tot + rg * 128 + 2 * cp) = make_float2(run0, run1);
      }
      __syncthreads();
      {
        const float2 ta = *(const float2*)(tot + 2 * cp), tb = *(const float2*)(tot + 128 + 2 * cp);
        const float2 tc = *(const float2*)(tot + 256 + 2 * cp), td = *(const float2*)(tot + 384 + 2 * cp);
        const float m0 = ta.x + tb.x, m1 = ta.y + tb.y;
        const float base0 = (rg > 0 ? ta.x : 0.f) + (rg > 1 ? tb.x : 0.f) + (rg > 2 ? tc.x : 0.f);
        const float base1 = (rg > 0 ? ta.y : 0.f) + (rg > 1 ? tb.y : 0.f) + (rg > 2 ? tc.y : 0.f);
        uint32_t* qp = (uint32_t*)(QS + 16 * rg * 136) + cp;
        uint32_t* kp = (uint32_t*)(KS + 16 * rg * 136) + cp;
        float skp0 = __builtin_amdgcn_exp2f(-fminf(fmaxf(base0 - m0, -115.f), 115.f));
        float skp1 = __builtin_amdgcn_exp2f(-fminf(fmaxf(base1 - m1, -115.f), 115.f));
        uint32_t kt0[8], kt1[8], kkprev = 0;
#pragma unroll
        for (int ii = 0; ii < 16; ++ii) {
          if ((ii & 3) == 0) __builtin_amdgcn_sched_barrier(0);
          const float e0 = fminf(fmaxf(base0 + p0[ii] - m0, -115.f), 115.f);
          const float e1 = fminf(fmaxf(base1 + p1[ii] - m1, -115.f), 115.f);
          const float sq0 = __builtin_amdgcn_exp2f(e0), sq1 = __builtin_amdgcn_exp2f(e1);
          const float sk0 = __builtin_amdgcn_rcpf(sq0), sk1 = __builtin_amdgcn_rcpf(sq1);
          if (do_out) {
            const uint32_t uq = qp[ii * 68];
            qp[ii * 68] = pack2(__uint_as_float(uq << 16) * sq0, __uint_as_float(uq & 0xffff0000u) * sq1);
          }
          float k0, k1;
          if (MIX == 0) { k0 = 1.f - sq0 * skp0; k1 = 1.f - sq1 * skp1; skp0 = sk0; skp1 = sk1; }
          else { const uint32_t uk = kp[ii * 68]; k0 = __uint_as_float(uk << 16); k1 = __uint_as_float(uk & 0xffff0000u); }
          const uint32_t kk = pack2(k0 * sk0, k1 * sk1);
          if (do_out) kp[ii * 68] = kk;
          if (ii & 1) {
            kt0[ii >> 1] = __builtin_amdgcn_perm(kk, kkprev, 0x05040100u);
            kt1[ii >> 1] = __builtin_amdgcn_perm(kk, kkprev, 0x07060302u);
          } else kkprev = kk;
        }
        u32x4* kd0 = (u32x4*)(KT + (2 * cp) * 72 + 16 * rg);
        u32x4* kd1 = (u32x4*)(KT + (2 * cp + 1) * 72 + 16 * rg);
        kd0[0] = MK4(kt0[0], kt0[1], kt0[2], kt0[3]); kd0[1] = MK4(kt0[4], kt0[5], kt0[6], kt0[7]);
        kd1[0] = MK4(kt1[0], kt1[1], kt1[2], kt1[3]); kd1[1] = MK4(kt1[4], kt1[5], kt1[6], kt1[7]);
        if (rg == 0) {
          *(float2*)(em + 2 * cp) = make_float2(__builtin_amdgcn_exp2f(m0), __builtin_amdgcn_exp2f(m1));
          *(float2*)(el + 2 * cp) = make_float2(__builtin_amdgcn_exp2f(tc.x + td.x), __builtin_amdgcn_exp2f(tc.y + td.y));
        }
        gacc0 += m0 + tc.x + td.x; gacc1 += m1 + tc.y + td.y;
      }
      __syncthreads();
      if (do_out) {
        bf16x8 qf[4];
#pragma unroll
        for (int ks = 0; ks < 4; ++ks) qf[ks] = *(const bf16x8*)(QS + (16 * w + l15) * 136 + ks * 32 + quad * 8);
        f32x4 pa[4];
#pragma unroll
        for (int jt = 0; jt < 4; ++jt) {
          pa[jt] = (f32x4){0.f, 0.f, 0.f, 0.f};
          if (jt <= w) {
#pragma unroll
            for (int ks = 0; ks < 4; ++ks) {
              bf16x8 kf = *(const bf16x8*)(KS + (16 * jt + l15) * 136 + ks * 32 + quad * 8);
              pa[jt] = __builtin_amdgcn_mfma_f32_16x16x32_bf16(kf, qf[ks], pa[jt], 0, 0, 0);
            }
          }
        }
        __syncthreads();
        {
          const int i = 16 * w + l15;
          bf16_t* pw = Pm + i * 72 + quad * 4;
#pragma unroll
          for (int jt = 0; jt < 4; ++jt) {
            const int j0 = 16 * jt + quad * 4;
            float pv[4];
#pragma unroll
            for (int r = 0; r < 4; ++r) pv[r] = (jt <= w && j0 + r <= i) ? pa[jt][r] : 0.f;
            *(u32x2*)(pw + 16 * jt) = MK2(pack2(pv[0], pv[1]), pack2(pv[2], pv[3]));
          }
        }
#pragma unroll
        for (int a = 0; a < 8; ++a) {
          const int k0 = 16 * (2 * w + (a >> 2)) + quad * 4;
          const int v = 16 * (a & 3) + l15;
          const fl4 e = *(const fl4*)(em + k0);
          S[a][0] *= e.x; S[a][1] *= e.y; S[a][2] *= e.z; S[a][3] *= e.w;
          *(u32x2*)(SmT + v * 136 + k0) = MK2(pack2(S[a][0], S[a][1]), pack2(S[a][2], S[a][3]));
        }
        __syncthreads();
        f32x4 oa[4];
#pragma unroll
        for (int vt = 0; vt < 4; ++vt) {
          oa[vt] = (f32x4){0.f, 0.f, 0.f, 0.f};
#pragma unroll
          for (int ks = 0; ks < 4; ++ks) {
            bf16x8 sf = *(const bf16x8*)(SmT + (16 * vt + l15) * 136 + ks * 32 + quad * 8);
            oa[vt] = __builtin_amdgcn_mfma_f32_16x16x32_bf16(sf, qf[ks], oa[vt], 0, 0, 0);
          }
        }
#pragma unroll
        for (int js = 0; js < 2; ++js) {
          bf16x8 pfr = *(const bf16x8*)(Pm + (16 * w + l15) * 72 + js * 32 + quad * 8);
#pragma unroll
          for (int vt = 0; vt < 4; ++vt) {
            bf16x8 vf = *(const bf16x8*)(VT + (16 * vt + l15) * 72 + js * 32 + quad * 8);
            oa[vt] = __builtin_amdgcn_mfma_f32_16x16x32_bf16(vf, pfr, oa[vt], 0, 0, 0);
          }
        }
        {
          const int i = 16 * w + l15;
          if (i < nv) {
            const int mr = dir ? rowbase + nv - 1 - i : rowbase + i;
            bf16_t* op = (bf16_t*)((char*)Og + (uint32_t)(mr * OLD + quad * 4) * 2u);
#pragma unroll
            for (int vt = 0; vt < 4; ++vt) *(u32x2*)(op + 16 * vt) = MK2(pack2(oa[vt][0], oa[vt][1]), pack2(oa[vt][2], oa[vt][3]));
          }
        }
      } else {
#pragma unroll
        for (int a = 0; a < 8; ++a) {
          const int k0 = 16 * (2 * w + (a >> 2)) + quad * 4;
          const fl4 e = *(const fl4*)(em + k0);
          S[a][0] *= e.x; S[a][1] *= e.y; S[a][2] *= e.z; S[a][3] *= e.w;
        }
      }
#pragma unroll
      for (int js = 0; js < 2; ++js) {
        bf16x8 kf[2];
#pragma unroll
        for (int ktl = 0; ktl < 2; ++ktl) kf[ktl] = *(const bf16x8*)(KT + (16 * (2 * w + ktl) + l15) * 72 + js * 32 + quad * 8);
#pragma unroll
        for (int vt = 0; vt < 4; ++vt) {
          bf16x8 vf = *(const bf16x8*)(VT + (16 * vt + l15) * 72 + js * 32 + quad * 8);
#pragma unroll
          for (int ktl = 0; ktl < 2; ++ktl)
            S[ktl * 4 + vt] = __builtin_amdgcn_mfma_f32_16x16x32_bf16(kf[ktl], vf, S[ktl * 4 + vt], 0, 0, 0);
        }
      }
#pragma unroll
      for (int a = 0; a < 8; ++a) {
        const int k0 = 16 * (2 * w + (a >> 2)) + quad * 4;
        const fl4 e = *(const fl4*)(el + k0);
        S[a][0] *= e.x; S[a][1] *= e.y; S[a][2] *= e.z; S[a][3] *= e.w;
      }
      __syncthreads();
    }
    if (!do_out) {
      bf16_t* L = p.ST + (size_t)item * 8192;
#pragma unroll
      for (int a = 0; a < 8; ++a)
#pragma unroll
        for (int r = 0; r < 4; ++r) L[(a * 4 + r) * 256 + t] = f2bf(S[a][r]);
      if (dvb == 0 && t < 64) *(float2*)(p.GD + ((seg * 8 + head) * 2 + dir) * 128 + 2 * t) = make_float2(gacc0, gacc1);
    }
  }
}

__device__ __forceinline__ void phase_hn(const Params& p, int l, char* smem) {
  const int bid_ = opaque_bid();
  const int t = opaque_tid(smem), lane = t & 63, w = t >> 6;
  const bf16_t* Y1 = p.X + (size_t)MROWS * 2048;
  const bf16_t* Y2 = Y1 + (size_t)MROWS * 1024;
  for (int row = bid_ * 4 + w; row < MROWS; row += gridDim.x * 4) {
    bf16_t* oa = p.O + (size_t)row * 2048 + lane * 16;
    float xa[16], xb[16];
    {
      u32x4 a0 = *(const u32x4*)(oa), a1 = *(const u32x4*)(oa + 8);
      u32x4 b0 = *(const u32x4*)(oa + 1024), b1 = *(const u32x4*)(oa + 1032);
      uint32_t ua[8] = {a0.x, a0.y, a0.z, a0.w, a1.x, a1.y, a1.z, a1.w};
      uint32_t ub[8] = {b0.x, b0.y, b0.z, b0.w, b1.x, b1.y, b1.z, b1.w};
#pragma unroll
      for (int e = 0; e < 8; ++e) {
        xa[2 * e] = __uint_as_float(ua[e] << 16) + __uint_as_float(ub[e] << 16);
        xa[2 * e + 1] = __uint_as_float(ua[e] & 0xffff0000u) + __uint_as_float(ub[e] & 0xffff0000u);
      }
      const bf16_t* y1 = Y1 + (size_t)row * 1024 + lane * 16;
      const bf16_t* y2 = Y2 + (size_t)row * 1024 + lane * 16;
      u32x4 c0 = *(const u32x4*)(y1), c1 = *(const u32x4*)(y1 + 8);
      u32x4 d0 = *(const u32x4*)(y2), d1 = *(const u32x4*)(y2 + 8);
      uint32_t uc[8] = {c0.x, c0.y, c0.z, c0.w, c1.x, c1.y, c1.z, c1.w};
      uint32_t ud[8] = {d0.x, d0.y, d0.z, d0.w, d1.x, d1.y, d1.z, d1.w};
#pragma unroll
      for (int e = 0; e < 8; ++e) {
        xb[2 * e] = __uint_as_float(uc[e] << 16) + __uint_as_float(ud[e] << 16);
        xb[2 * e + 1] = __uint_as_float(uc[e] & 0xffff0000u) + __uint_as_float(ud[e] & 0xffff0000u);
      }
    }
    float sa = 0.f, sb = 0.f;
#pragma unroll
    for (int e = 0; e < 16; ++e) { sa += xa[e] * xa[e]; sb += xb[e] * xb[e]; }
    sa += shx<1>(sa, lane); sa += shx<2>(sa, lane); sa += shx<4>(sa, lane);
    sb += shx<1>(sb, lane); sb += shx<2>(sb, lane); sb += shx<4>(sb, lane); sb += shx<8>(sb, lane);
    const float ra = rsqrtf(sa * (1.f / 128.f) + 1e-6f);
    const float rb = rsqrtf(sb * (1.f / 256.f) + 1e-6f);
    const float* na = p.norm_a + l * 1024 + lane * 16;
    const float* nb = p.norm_b + l * 1024 + lane * 16;
    uint32_t pa[8], pb[8];
#pragma unroll
    for (int e = 0; e < 8; ++e) {
      pa[e] = pack2(xa[2 * e] * ra * na[2 * e], xa[2 * e + 1] * ra * na[2 * e + 1]);
      pb[e] = pack2(xb[2 * e] * rb * nb[2 * e], xb[2 * e + 1] * rb * nb[2 * e + 1]);
    }
    *(u32x4*)(oa) = MK4(pa[0], pa[1], pa[2], pa[3]);
    *(u32x4*)(oa + 8) = MK4(pa[4], pa[5], pa[6], pa[7]);
    *(u32x4*)(oa + 1024) = MK4(pb[0], pb[1], pb[2], pb[3]);
    *(u32x4*)(oa + 1032) = MK4(pb[4], pb[5], pb[6], pb[7]);
  }
}

__device__ __forceinline__ void phase_final(const Params& p, char* smem) {
  const int bid_ = opaque_bid();
  const int t = opaque_tid(smem), lane = t & 63, w = t >> 6;
  for (int row = bid_ * 4 + w; row < 2 * NTOKG; row += gridDim.x * 4) {
    float* hp = p.out + (size_t)row * 1024;
    fl4 v[4];
    float s = 0.f;
#pragma unroll
    for (int j = 0; j < 4; ++j) {
      v[j] = *(const fl4*)(hp + j * 256 + lane * 4);
      s += v[j].x * v[j].x + v[j].y * v[j].y + v[j].z * v[j].z + v[j].w * v[j].w;
    }
    s += shx<1>(s, lane); s += shx<2>(s, lane); s += shx<4>(s, lane);
    s += shx<8>(s, lane); s += shx<16>(s, lane); s += shx<32>(s, lane);
    const float rs = rsqrtf(s * (1.f / 1024.f) + 1e-6f);
#pragma unroll
    for (int j = 0; j < 4; ++j) {
      const fl4 gn = *(const fl4*)(p.final_norm + j * 256 + lane * 4);
      fl4 o = MKF4(v[j].x * rs * gn.x, v[j].y * rs * gn.y, v[j].z * rs * gn.z, v[j].w * rs * gn.w);
      *(fl4*)(hp + j * 256 + lane * 4) = o;
    }
  }
}

__device__ __forceinline__ void phase_xcvt(const Params& p, int g, char* smem) {
  const int bid_ = opaque_bid();
  const int t = opaque_tid(smem);
  for (int idx = bid_ * 256 + t; idx < MROWS * 128; idx += gridDim.x * 256) {
    const int row = idx >> 7, c8 = idx & 127;
    const float* src = row < NTOKG ? p.x[g] + (size_t)row * 1024 + c8 * 8 : p.hmeta + ((size_t)g * 128 + (row - NTOKG)) * 1024 + c8 * 8;
    const fl4 a = *(const fl4*)src, b = *(const fl4*)(src + 4);
    *(u32x4*)(p.HB + (size_t)row * 1024 + c8 * 8) = MK4(pack2(a.x, a.y), pack2(a.z, a.w), pack2(b.x, b.y), pack2(b.z, b.w));
  }
}

__device__ __forceinline__ void run_phase(const Params& p, int ph, char* smem) {
  if (ph == 0) { phase_init(p, smem); return; }
  if (ph == NPHASES - 1) { phase_final(p, smem); return; }
  const int q = ph - 1;
  const int g = q / 23, r = q % 23;
  if (r == 0) { phase_xcvt(p, g, smem); return; }
  const int l = (r - 1) / 11, st = (r - 1) % 11;
  switch (st) {
    case 0: gemm_phase<EPI_G1A>(p, l, g, smem); break;
    case 1: scan_phase<0, 1>(p, l, g, smem); break;
    case 2: scan_phase<0, 3>(p, l, g, smem); break;
    case 3: gemm_phase<EPI_G1B>(p, l, g, smem); break;
    case 4: scan_phase<1, 1>(p, l, g, smem); break;
    case 5: scan_phase<1, 3>(p, l, g, smem); break;
    case 6: phase_hn(p, l, smem); break;
    case 7: gemm_phase<EPI_GATES>(p, l, g, smem); break;
    case 8: gemm_phase<EPI_WOUT>(p, l, g, smem); break;
    case 9: gemm_phase<EPI_UP>(p, l, g, smem); break;
    default: gemm_phase<EPI_DOWN>(p, l, g, smem); break;
  }
}

template <int ST>
__global__ void __launch_bounds__(256, 2) pk(Params p, int l, int g) {
  extern __shared__ __attribute__((aligned(16))) char smem[];
  if (ST == 100) phase_init(p, smem);
  else if (ST == 101) phase_final(p, smem);
  else if (ST == 102) phase_xcvt(p, g, smem);
  else if (ST == 0) gemm_phase<EPI_G1A>(p, l, g, smem);
  else if (ST == 1) scan_phase<0, 1>(p, l, g, smem);
  else if (ST == 2) scan_phase<0, 3>(p, l, g, smem);
  else if (ST == 3) gemm_phase<EPI_G1B>(p, l, g, smem);
  else if (ST == 4) scan_phase<1, 1>(p, l, g, smem);
  else if (ST == 5) scan_phase<1, 3>(p, l, g, smem);
  else if (ST == 6) phase_hn(p, l, smem);
  else if (ST == 7) gemm_phase<EPI_GATES>(p, l, g, smem);
  else if (ST == 8) gemm_phase<EPI_WOUT>(p, l, g, smem);
  else if (ST == 9) gemm_phase<EPI_UP>(p, l, g, smem);
  else gemm_phase<EPI_DOWN>(p, l, g, smem);
}


#define XB_TMO      128
#define XB_XCNT(j)  (256  + 64 * (j))
#define XB_XSUB(j)  (1280 + 64 * (j))
#define XB_XGEN(j)  (2304 + 64 * (j))
#define XB_TOP      3328
#define XB_TOPGEN   3392
#define XCD_BAR_WORDS 3456
#define XB_SPIN_CAP (1u << 22)
#define LAS __attribute__((address_space(3)))
__device__ __forceinline__ unsigned xb_ld(unsigned* p)              { return __hip_atomic_load(p, __ATOMIC_RELAXED, __HIP_MEMORY_SCOPE_AGENT); }
__device__ __forceinline__ unsigned xb_add(unsigned* p, unsigned v) { return __hip_atomic_fetch_add(p, v, __ATOMIC_RELAXED, __HIP_MEMORY_SCOPE_AGENT); }
__device__ __forceinline__ unsigned xb_xcc_id() { return (unsigned)__builtin_amdgcn_s_getreg((3 << 11) | 20) & 0xFu; }
#define XB_SPIN(cond, bar) do { unsigned _sp = 0; while (cond) { __builtin_amdgcn_s_sleep(1); \
    if ((++_sp & 255u) == 0u) { if (xb_ld(&(bar)[XB_TMO])) break; if (_sp > XB_SPIN_CAP) { atomicAdd(&(bar)[XB_TMO], 1u); break; } } } } while (0)

__device__ __forceinline__ void xcd_barrier_complete(unsigned* bar, unsigned x, unsigned& nloc, unsigned& nx) {
  const unsigned G = gridDim.x * gridDim.y * gridDim.z;
  unsigned sum, cnt, mine, sp = 0u;
  for (;;) {
    sum = 0u; cnt = 0u; mine = 0u;
#pragma unroll
    for (unsigned j = 0; j < 16; ++j) { const unsigned c = xb_ld(&bar[XB_XCNT(j)]); sum += c; cnt += (c > 0u) ? 1u : 0u; mine = (j == x) ? c : mine; }
    if (sum == G) break;
    __builtin_amdgcn_s_sleep(1);
    if ((++sp & 255u) == 0u) { if (xb_ld(&bar[XB_TMO])) break; if (sp > XB_SPIN_CAP) { atomicAdd(&bar[XB_TMO], 1u); break; } }
  }
  nloc = mine > 0u ? mine : 1u; nx = cnt > 0u ? cnt : 1u;
}

__device__ __forceinline__ void xcd_barrier(unsigned* bar, volatile LAS unsigned* st, bool leader_thread) {
  asm volatile("s_waitcnt vmcnt(0)" ::: "memory");
  __syncthreads();
  if (leader_thread) {
    const unsigned x = xb_xcc_id();
    __builtin_amdgcn_s_waitcnt(0);
    unsigned nloc = st[0], nx = st[1];
    if (nloc == 0u) { xcd_barrier_complete(bar, x, nloc, nx); st[0] = nloc; st[1] = nx; }
    const unsigned old = xb_add(&bar[XB_XSUB(x)], 1u);
    const unsigned gen = old / nloc;
    if (old + 1u == (gen + 1u) * nloc) {
      __builtin_amdgcn_fence(__ATOMIC_RELEASE, "agent");
      asm volatile("s_waitcnt vmcnt(0)" ::: "memory");
      const unsigned og = xb_add(&bar[XB_TOP], 1u);
      const unsigned tg = og / nx;
      if (og + 1u == (tg + 1u) * nx) xb_add(&bar[XB_TOPGEN], 1u);
      else XB_SPIN(xb_ld(&bar[XB_TOPGEN]) == tg, bar);
      __builtin_amdgcn_fence(__ATOMIC_ACQUIRE, "agent");
      xb_add(&bar[XB_XGEN(x)], 1u);
      asm volatile("s_waitcnt vmcnt(0)" ::: "memory");
    } else {
      XB_SPIN(xb_ld(&bar[XB_XGEN(x)]) == gen, bar);
      __builtin_amdgcn_fence(__ATOMIC_ACQUIRE, "agent");
      asm volatile("s_waitcnt vmcnt(0)" ::: "memory");
    }
  }
  __syncthreads();
}

#ifndef MULTI_LAUNCH
__global__ void __launch_bounds__(256, 2) mega(Params p, int plo, int phi, int coop) {
  extern __shared__ __attribute__((aligned(16))) char smem[];
  volatile LAS unsigned* st = (volatile LAS unsigned*)(smem + LDS_BYTES + 16);
  {
    const int t0 = opaque_tid(smem);
    if (t0 == 0) { st[0] = 0u; st[1] = 0u; (void)xb_add(&p.bar[XB_XCNT(xb_xcc_id())], 1u); }
    __syncthreads();
  }
  for (int ph = plo; ph < phi; ++ph) {
    run_phase(p, ph, smem);
    if (coop && ph + 1 < phi) {
      if (ph == 0) cg::this_grid().sync();
      else { const int tb = opaque_tid(smem); xcd_barrier(p.bar, st, tb == 0); }
    }
  }
}

#endif

static inline size_t align_up(size_t x) { return (x + 255) & ~(size_t)255; }

extern "C" void kernel_launch(void* const* d_in, const int* in_sizes, int n_in,
                              void* d_out, int out_size, void* d_ws, size_t ws_size,
                              hipStream_t stream) {
  Params p{};
  p.x[0] = (const float*)d_in[0];
  p.x[1] = (const float*)d_in[1];
  p.meta = (const float*)d_in[2];
  p.attn_norm = (const float*)d_in[3];
  p.w_in = (const float*)d_in[4];
  p.lb_logits = (const float*)d_in[5];
  p.w_gate = (const float*)d_in[6];
  p.b_gate = (const float*)d_in[7];
  p.norm_a = (const float*)d_in[8];
  p.norm_b = (const float*)d_in[9];
  p.w_out = (const float*)d_in[10];
  p.mlp_norm = (const float*)d_in[11];
  p.w_up = (const float*)d_in[12];
  p.w_down = (const float*)d_in[13];
  p.final_norm = (const float*)d_in[14];
  p.out = (float*)d_out;
  char* ws = (char*)d_ws;
  size_t off = 0;
  p.W = (bf16_t*)(ws + off); off = align_up(off + (size_t)2 * LSTRIDE * 2);
  p.X = (bf16_t*)(ws + off); off = align_up(off + (size_t)MROWS * 4096 * 2);
  p.R = (bf16_t*)(ws + off); off = align_up(off + (size_t)MROWS * 32 * 2);
  p.O = (bf16_t*)(ws + off); off = align_up(off + (size_t)MROWS * 2048 * 2);
  p.HB = (bf16_t*)(ws + off); off = align_up(off + (size_t)MROWS * 1024 * 2);
  p.ST = (bf16_t*)(ws + off); off = align_up(off + (size_t)512 * 8192 * 2);
  p.GD = (float*)(ws + off); off = align_up(off + (size_t)16 * 8 * 2 * 128 * 4);
  p.hmeta = (float*)(ws + off); off = align_up(off + (size_t)2 * 128 * 1024 * 4);
  p.bar = (unsigned*)(ws + off); off = align_up(off + (size_t)XCD_BAR_WORDS * 4);
  if (off > ws_size) { fprintf(stderr, "workspace too small: need %zu have %zu\n", off, ws_size); return; }

#ifdef MULTI_LAUNCH
#define LAUNCH_PK(ST, l, g) do { \
    static bool attr_set_##ST = false; \
    if (!attr_set_##ST) { (void)hipFuncSetAttribute((const void*)pk<ST>, hipFuncAttributeMaxDynamicSharedMemorySize, LDS_BYTES + 32); attr_set_##ST = true; } \
    hipLaunchKernelGGL(pk<ST>, dim3(512), dim3(256), LDS_BYTES + 32, stream, p, l, g); } while (0)
  LAUNCH_PK(100, 0, 0);
  for (int g = 0; g < 2; ++g)
    for (int l = 0; l < 2; ++l) {
      if (l == 0) LAUNCH_PK(102, l, g);
      LAUNCH_PK(0, l, g); LAUNCH_PK(1, l, g); LAUNCH_PK(2, l, g); LAUNCH_PK(3, l, g); LAUNCH_PK(4, l, g); LAUNCH_PK(5, l, g);
      LAUNCH_PK(6, l, g); LAUNCH_PK(7, l, g); LAUNCH_PK(8, l, g); LAUNCH_PK(9, l, g); LAUNCH_PK(10, l, g);
    }
  LAUNCH_PK(101, 0, 0);
#else
  static int grid_blocks = 0;
  if (!grid_blocks) {
    (void)hipFuncSetAttribute((const void*)mega, hipFuncAttributeMaxDynamicSharedMemorySize, LDS_BYTES + 32);
    int dev = 0, cus = 0, per_cu = 0;
    (void)hipGetDevice(&dev);
    (void)hipDeviceGetAttribute(&cus, hipDeviceAttributeMultiprocessorCount, dev);
    (void)hipOccupancyMaxActiveBlocksPerMultiprocessor(&per_cu, (const void*)mega, 256, LDS_BYTES + 32);
    if (per_cu < 1) per_cu = 1;
    if (per_cu > 2) per_cu = 2;
    grid_blocks = cus * per_cu;
  }
  (void)hipMemsetAsync(p.bar, 0, (size_t)XCD_BAR_WORDS * 4, stream);
  int plo = 0, phi = NPHASES, coop = 1;
  void* args[] = {&p, &plo, &phi, &coop};
  hipError_t e = hipLaunchCooperativeKernel((const void*)mega, dim3(grid_blocks), dim3(256), args, LDS_BYTES + 32, stream);
  if (e != hipSuccess) fprintf(stderr, "cooperative launch failed: %s (grid %d)\n", hipGetErrorString(e), grid_blocks);
#endif
}
```

```cpp
#include <hip/hip_runtime.h>
#include <hip/hip_cooperative_groups.h>
#include <stdint.h>
#include <stdio.h>
namespace cg = cooperative_groups;

typedef __attribute__((ext_vector_type(8))) short bf16x8;
typedef __attribute__((ext_vector_type(4))) float f32x4;
typedef unsigned short bf16_t;
typedef uint32_t u32x4 __attribute__((ext_vector_type(4)));
typedef uint32_t u32x2 __attribute__((ext_vector_type(2)));
typedef float fl4 __attribute__((ext_vector_type(4)));
#define MK4(a,b,c,d) ((u32x4){(uint32_t)(a),(uint32_t)(b),(uint32_t)(c),(uint32_t)(d)})
#define MK2(a,b) ((u32x2){(uint32_t)(a),(uint32_t)(b)})
#define MKF4(a,b,c,d) ((fl4){(a),(b),(c),(d)})

#define NTOKG 16384
#define MROWS 16512
#define MTILES 129
#define LSTRIDE 20185088
#define WOFF_A 0
#define WOFF_B (4096 * 1024)
#define WOFF_G (6400 * 1024)
#define WOFF_O (10496 * 1024)
#define WOFF_U (11520 * 1024)
#define WOFF_D (15616 * 1024)
#define LDS_BYTES 80896
#define NPHASES 48

struct Params {
  const float* x[2];
  const float* meta;
  const float* attn_norm;
  const float* w_in;
  const float* lb_logits;
  const float* w_gate;
  const float* b_gate;
  const float* norm_a;
  const float* norm_b;
  const float* w_out;
  const float* mlp_norm;
  const float* w_up;
  const float* w_down;
  const float* final_norm;
  float* out;
  bf16_t* W;
  bf16_t* X;
  bf16_t* R;
  bf16_t* O;
  bf16_t* HB;
  bf16_t* ST;
  float* GD;
  float* hmeta;
  unsigned* bar;
};

__device__ __forceinline__ uint32_t pack2(float a, float b) {
  uint32_t r;
  asm("v_cvt_pk_bf16_f32 %0, %1, %2" : "=v"(r) : "v"(a), "v"(b));
  return r;
}
__device__ __forceinline__ bf16_t f2bf(float f) { return (bf16_t)(pack2(f, f) & 0xffffu); }
__device__ __forceinline__ int opaque_tid(char* smem) {
  int lane;
  asm volatile("v_mbcnt_lo_u32_b32 %0, -1, 0\n\tv_mbcnt_hi_u32_b32 %0, -1, %0" : "=v"(lane));
  int* cnt = (int*)(smem + LDS_BYTES);
  int w = 0;
  if (lane == 0) w = atomicAdd(cnt, 1);
  w = __builtin_amdgcn_readfirstlane(w) & 3;
  __syncthreads();
  return w * 64 + lane;
}
__device__ __forceinline__ int opaque_bid() { int b = blockIdx.x; asm volatile("" : "+s"(b)); return b; }
template <int M>
__device__ __forceinline__ float shx(float v, int lane) {
  if (M < 32) return __builtin_bit_cast(float, __builtin_amdgcn_ds_swizzle(__builtin_bit_cast(int, v), 0x1f | (M << 10)));
  return __builtin_bit_cast(float, __builtin_amdgcn_ds_bpermute((lane ^ M) << 2, __builtin_bit_cast(int, v)));
}
__device__ __forceinline__ float bf2f(bf16_t b) { return __uint_as_float(((uint32_t)b) << 16); }
__device__ __forceinline__ size_t tiled_off(size_t row, int col, int K) {
  return (((row >> 7) * (size_t)(K >> 5) + (size_t)(col >> 5)) * 128 + (row & 127)) * 32 + (size_t)(col & 31);
}
__device__ __forceinline__ float sigmoidf_(float x) { return 1.f / (1.f + __expf(-x)); }

__device__ __forceinline__ int w_in_col(int R, float& scale) {
  scale = 1.f;
  if (R < 4096) return R;
  if (R < 6400) {
    int n = R - 4096;
    if (n >= 2080) return -1;
    if (n < 512) scale = 0.08838834764831845f;
    return 5120 + n;
  }
  int n = R - 6400;
  int tt = n >> 8, wv = n & 255;
  int wn = wv >> 7, nl = wv & 127;
  int qd = nl >> 5, ni = (nl >> 2) & 7, r = nl & 3;
  int grp = ni >> 2, seg = ni & 3;
  int ucol = tt * 64 + wn * 32 + qd * 8 + grp * 4 + r;
  int base = seg == 0 ? 4096 : seg == 1 ? 8224 : seg == 2 ? 7200 : 9248;
  return base + ucol;
}

__device__ __forceinline__ void phase_init(const Params& p, char* smem) {
  const int t = opaque_tid(smem);
  const int bid_ = opaque_bid();
  for (int idx = bid_ * 256 + t; idx < 2 * 128 * 256; idx += gridDim.x * 256) {
    int g = idx / (128 * 256), r = (idx / 256) % 128, c4 = idx % 256;
    int nvalid = g == 0 ? 16 : 64;
    fl4 v = MKF4(0.f, 0.f, 0.f, 0.f);
    if (r < nvalid) v = *(const fl4*)(p.meta + (size_t)(r & 15) * 1024 + c4 * 4);
    *(fl4*)(p.hmeta + ((size_t)g * 128 + r) * 1024 + c4 * 4) = v;
  }
  float* tile = (float*)smem;
  const int per_layer = 3904 + 1024;
  for (int id = bid_; id < 2 * per_layer; id += gridDim.x) {
    int l = id / per_layer, r = id % per_layer;
    const float* src; int ld; const float* gain = nullptr; int K, n0, k0;
    bf16_t* dst;
    int kind;
    int cbase = 0;
    if (r < 3904) {
      int rt = r >> 4, kt = r & 15;
      n0 = rt * 64; k0 = kt * 64; K = 1024;
      dst = p.W + (size_t)l * LSTRIDE;
      if (n0 < 10496) { kind = 0; src = p.w_in + (size_t)l * 1024 * 10272; ld = 10272; gain = p.attn_norm + l * 1024; }
      else if (n0 < 11520) { kind = 1; src = p.w_out + (size_t)l * 1024 * 1024; ld = 1024; cbase = n0 - 10496; }
      else { kind = 1; src = p.w_up + (size_t)l * 1024 * 4096; ld = 4096; cbase = n0 - 11520; gain = p.mlp_norm + l * 1024; }
    } else {
      int r2 = r - 3904;
      int rt = r2 >> 6, kt = r2 & 63;
      n0 = rt * 64; k0 = kt * 64; K = 4096;
      dst = p.W + (size_t)l * LSTRIDE + WOFF_D;
      kind = 1; src = p.w_down + (size_t)l * 4096 * 1024; ld = 1024; cbase = n0;
    }
    {
      int n = t & 63;
      float scale = 1.f; int col;
      if (kind == 0) col = w_in_col(n0 + n, scale); else col = cbase + n;
#pragma unroll 4
      for (int i = 0; i < 16; ++i) {
        int kk = (t >> 6) + 4 * i;
        float v = 0.f;
        if (col >= 0) {
          v = src[(size_t)(k0 + kk) * ld + col] * scale;
          if (gain) v *= gain[k0 + kk];
        }
        tile[kk * 65 + n] = v;
      }
    }
    __syncthreads();
    {
      int n = t >> 2, piece = t & 3;
      uint32_t pk[8];
#pragma unroll
      for (int e = 0; e < 8; ++e) {
        float a = tile[(piece * 16 + 2 * e) * 65 + n];
        float b = tile[(piece * 16 + 2 * e + 1) * 65 + n];
        pk[e] = pack2(a, b);
      }
      const int Rr = n0 + n, kk = k0 + piece * 16;
      u32x4* d = (u32x4*)(dst + ((size_t)((Rr >> 8) * (K >> 5) + (kk >> 5)) * 256 + (Rr & 255)) * 32 + (kk & 31));
      d[0] = MK4(pk[0], pk[1], pk[2], pk[3]);
      d[1] = MK4(pk[4], pk[5], pk[6], pk[7]);
    }
    __syncthreads();
  }
}

enum { EPI_G1A = 0, EPI_G1B, EPI_GATES, EPI_WOUT, EPI_UP, EPI_DOWN };

template <int EPI>
__device__ __forceinline__ void gemm_phase(const Params& p, int l, int g, char* smem) {
  constexpr bool NORM = (EPI == EPI_G1A || EPI == EPI_G1B || EPI == EPI_GATES || EPI == EPI_UP);
  constexpr int K = (EPI == EPI_DOWN) ? 4096 : 1024;
  constexpr int NT = EPI == EPI_G1A ? 16 : EPI == EPI_G1B ? 9 : EPI == EPI_GATES ? 16 : EPI == EPI_WOUT ? 4 : EPI == EPI_UP ? 16 : 4;
  constexpr int WOFF = EPI == EPI_G1A ? WOFF_A : EPI == EPI_G1B ? WOFF_B : EPI == EPI_GATES ? WOFF_G : EPI == EPI_WOUT ? WOFF_O : EPI == EPI_UP ? WOFF_U : WOFF_D;
  constexpr int NK = K / 32;
  const bf16_t* Wl = p.W + (size_t)l * LSTRIDE + WOFF;
  bf16_t* As = (bf16_t*)smem;
  bf16_t* Bs = As + 2 * 128 * 32;
  float* rss = (float*)(Bs + 2 * 256 * 32);
  const int bid_ = opaque_bid();
  const int t = opaque_tid(smem), lane = t & 63, w = t >> 6, wm = w >> 1, wn = w & 1;
  const int quad = lane >> 4, l15 = lane & 15;
  const int nvalid_meta = g == 0 ? 16 : 64;

  for (int tile = bid_; tile < MTILES * NT; tile += gridDim.x) {
    const int mt = tile / NT, nt = tile % NT;
    const bf16_t* Ab = NORM ? p.HB + (size_t)mt * 128 * 1024 : p.X + (size_t)mt * 128 * K;
    const bf16_t* Bg = Wl + (size_t)nt * 256 * K;
    const bool do_mma = !(mt == 128 && wm == 1) && !(EPI == EPI_G1B && nt == 8 && wn == 1);

    f32x4 acc[4][8];
#pragma unroll
    for (int a = 0; a < 4; ++a)
#pragma unroll
      for (int b = 0; b < 8; ++b) acc[a][b] = (f32x4){0.f, 0.f, 0.f, 0.f};
    float ss[2] = {0.f, 0.f};
    int t_l = t;
    asm volatile("" : "+v"(t_l));
    const uint32_t voffA = (uint32_t)((t_l >> 2) * 64 + (((t_l & 3) ^ (((t_l >> 5) & 1) << 1)) * 16));
    const uint32_t voffB0 = (uint32_t)((t_l >> 2) * 64 + ((t_l & 3) * 16));
    const uint32_t voffB1 = (uint32_t)((t_l >> 2) * 64 + (((t_l & 3) ^ 2) * 16));
    const char* Abase = (const char*)Ab;
    const char* Bbase = (const char*)Bg;
    const int rpiece = quad ^ (((l15 >> 3) & 1) << 1);
#define GLDS(gp, lp) __builtin_amdgcn_global_load_lds((const __attribute__((address_space(1))) void*)(gp), (__attribute__((address_space(3))) void*)(lp), 16, 0, 0)
#define G_DMA(KT, BUF) do { \
      _Pragma("unroll") for (int i = 0; i < 2; ++i) \
        GLDS(Abase + (size_t)(KT) * 8192 + (size_t)i * 4096 + voffA, (char*)(As + (BUF) * 4096) + (i * 256 + t) * 16); \
      _Pragma("unroll") for (int i = 0; i < 4; ++i) \
        GLDS(Bbase + (size_t)(KT) * 16384 + (size_t)i * 4096 + ((i & 1) ? voffB1 : voffB0), (char*)(Bs + (BUF) * 8192) + (i * 256 + t) * 16); } while (0)
#define G_COMPUTE(BUF) do { \
      if (NORM) { \
        _Pragma("unroll") for (int i = 0; i < 2; ++i) { \
          const u32x4 av = *(const u32x4*)((const char*)(As + (BUF) * 4096) + (i * 256 + t) * 16); \
          const uint32_t uu[4] = {av.x, av.y, av.z, av.w}; \
          _Pragma("unroll") for (int e = 0; e < 4; ++e) { \
            const float lo = __uint_as_float(uu[e] << 16), hi = __uint_as_float(uu[e] & 0xffff0000u); \
            ss[i] += lo * lo + hi * hi; } } } \
      if (do_mma) { \
      const bf16_t* Aw = As + (BUF) * 4096; const bf16_t* Bw = Bs + (BUF) * 8192; \
      bf16x8 af[4], bfr[8]; \
      _Pragma("unroll") for (int mi = 0; mi < 4; ++mi) af[mi] = *(const bf16x8*)(Aw + (wm * 64 + mi * 16 + l15) * 32 + rpiece * 8); \
      _Pragma("unroll") for (int ni = 0; ni < 8; ++ni) bfr[ni] = *(const bf16x8*)(Bw + (wn * 128 + (l15 >> 2) * 32 + ni * 4 + (l15 & 3)) * 32 + rpiece * 8); \
      __builtin_amdgcn_s_setprio(1); \
      _Pragma("unroll") for (int ni = 0; ni < 8; ++ni) \
        _Pragma("unroll") for (int mi = 0; mi < 4; ++mi) \
          acc[mi][ni] = __builtin_amdgcn_mfma_f32_16x16x32_bf16(bfr[ni], af[mi], acc[mi][ni], 0, 0, 0); \
      __builtin_amdgcn_s_setprio(0); } } while (0)

    G_DMA(0, 0);
#pragma unroll 1
    for (int kt = 0; kt < NK; kt += 2) {
      asm volatile("s_waitcnt vmcnt(0)" ::: "memory");
      __syncthreads();
      G_DMA(kt + 1, 1);
      G_COMPUTE(0);
      asm volatile("s_waitcnt vmcnt(0)" ::: "memory");
      __syncthreads();
      { const int kn = (kt + 2 < NK) ? kt + 2 : NK - 1; G_DMA(kn, 0); }
      G_COMPUTE(1);
    }
    asm volatile("s_waitcnt vmcnt(0)" ::: "memory");
    __syncthreads();
#undef GLDS
#undef G_DMA
#undef G_COMPUTE

    int quad_e = quad, l15_e = l15, t_e = t;
    asm volatile("" : "+v"(quad_e), "+v"(l15_e), "+v"(t_e));
    if (NORM) {
#pragma unroll
      for (int i = 0; i < 2; ++i) {
        float s = ss[i];
        s += shx<1>(s, lane); s += shx<2>(s, lane);
        if ((t_e & 3) == 0) rss[(t_e >> 2) + 64 * i] = rsqrtf(s * (1.f / 1024.f) + 1e-6f);
      }
      __syncthreads();
    }
    if (do_mma) {
#pragma unroll
    for (int mi = 0; mi < 4; ++mi) {
      __builtin_amdgcn_sched_barrier(0);
      const int rl = wm * 64 + mi * 16 + l15_e;
      const size_t grow = (size_t)mt * 128 + rl;
      const float rs = NORM ? rss[rl] : 1.f;
      const int cw = wn * 128 + quad_e * 32;
      if (EPI == EPI_G1A) {
        const int region = nt >> 2;
        bf16_t* xp = p.X + grow * 4096 + nt * 256 + cw;
#pragma unroll
        for (int c = 0; c < 4; ++c) {
          float v[8];
#pragma unroll
          for (int e = 0; e < 8; ++e) v[e] = acc[mi][2 * c + (e >> 2)][e & 3] * rs;
          if (region == 1 || region == 2) {
            float lb[8] = {0.f, 0.f, 0.f, 0.f, 0.f, 0.f, 0.f, 0.f};
            if (l == 1) {
              const float* l0p = p.lb_logits + (region - 1) * 1024 + ((nt * 256 + cw + c * 8) & 1023);
              const fl4 a0 = *(const fl4*)l0p, a1 = *(const fl4*)(l0p + 4);
              const fl4 b0 = *(const fl4*)(l0p + 2048), b1 = *(const fl4*)(l0p + 2052);
              lb[0] = 1.f / (1.f + __expf(a0.x - b0.x)); lb[1] = 1.f / (1.f + __expf(a0.y - b0.y));
              lb[2] = 1.f / (1.f + __expf(a0.z - b0.z)); lb[3] = 1.f / (1.f + __expf(a0.w - b0.w));
              lb[4] = 1.f / (1.f + __expf(a1.x - b1.x)); lb[5] = 1.f / (1.f + __expf(a1.y - b1.y));
              lb[6] = 1.f / (1.f + __expf(a1.z - b1.z)); lb[7] = 1.f / (1.f + __expf(a1.w - b1.w));
            }
#pragma unroll
            for (int e = 0; e < 8; ++e) {
              const float f = fmaxf(lb[e], 1e-30f) + (1.f - lb[e]) * sigmoidf_(v[e]);
              v[e] = __builtin_amdgcn_logf(f);
            }
          }
          *(u32x4*)(xp + c * 8) = MK4(pack2(v[0], v[1]), pack2(v[2], v[3]), pack2(v[4], v[5]), pack2(v[6], v[7]));
        }
      } else if (EPI == EPI_G1B) {
        if (nt < 8) {
          bf16_t* xp = p.X + grow * 2048 + nt * 256 + cw;
#pragma unroll
          for (int c = 0; c < 4; ++c)
            *(u32x4*)(xp + c * 8) = MK4(pack2(acc[mi][2 * c][0] * rs, acc[mi][2 * c][1] * rs), pack2(acc[mi][2 * c][2] * rs, acc[mi][2 * c][3] * rs),
                                        pack2(acc[mi][2 * c + 1][0] * rs, acc[mi][2 * c + 1][1] * rs), pack2(acc[mi][2 * c + 1][2] * rs, acc[mi][2 * c + 1][3] * rs));
        } else if (cw == 0) {
          bf16_t* rp = p.R + grow * 32;
#pragma unroll
          for (int c = 0; c < 4; ++c)
            *(u32x4*)(rp + c * 8) = MK4(pack2(acc[mi][2 * c][0] * rs, acc[mi][2 * c][1] * rs), pack2(acc[mi][2 * c][2] * rs, acc[mi][2 * c][3] * rs),
                                        pack2(acc[mi][2 * c + 1][0] * rs, acc[mi][2 * c + 1][1] * rs), pack2(acc[mi][2 * c + 1][2] * rs, acc[mi][2 * c + 1][3] * rs));
        }
      } else if (EPI == EPI_GATES) {
        const int uc = nt * 64 + wn * 32 + quad_e * 8;
        const u32x4 oa = *(const u32x4*)(p.O + grow * 2048 + uc);
        const u32x4 ob = *(const u32x4*)(p.O + grow * 2048 + 1024 + uc);
        const uint32_t oau[4] = {oa.x, oa.y, oa.z, oa.w}, obu[4] = {ob.x, ob.y, ob.z, ob.w};
        float u[8];
#pragma unroll
        for (int grp = 0; grp < 2; ++grp)
#pragma unroll
          for (int r = 0; r < 4; ++r) {
            const int idx = grp * 4 + r;
            const float ga = acc[mi][grp * 4 + 0][r] * rs, ma = acc[mi][grp * 4 + 1][r] * rs;
            const float gb = acc[mi][grp * 4 + 2][r] * rs, mb = acc[mi][grp * 4 + 3][r] * rs;
            const float ona = (idx & 1) ? __uint_as_float(oau[idx >> 1] & 0xffff0000u) : __uint_as_float(oau[idx >> 1] << 16);
            const float onb = (idx & 1) ? __uint_as_float(obu[idx >> 1] & 0xffff0000u) : __uint_as_float(obu[idx >> 1] << 16);
            u[idx] = sigmoidf_(ma) * (ga * sigmoidf_(ga)) * ona + sigmoidf_(mb) * (gb * sigmoidf_(gb)) * onb;
          }
        *(u32x4*)(p.X + tiled_off(grow, uc, 1024)) = MK4(pack2(u[0], u[1]), pack2(u[2], u[3]), pack2(u[4], u[5]), pack2(u[6], u[7]));
      } else if (EPI == EPI_WOUT || EPI == EPI_DOWN) {
        const bool meta = (mt == 128);
        if (!meta || rl < nvalid_meta) {
          const float* hin; float* hout;
          if (meta) { hout = p.hmeta + ((size_t)g * 128 + rl) * 1024; hin = hout; }
          else {
            const size_t trow = (size_t)mt * 128 + rl;
            hout = p.out + ((size_t)g * NTOKG + trow) * 1024;
            hin = (EPI == EPI_WOUT && l == 0) ? p.x[g] + trow * 1024 : hout;
          }
          const int col0 = nt * 256 + cw;
          bf16_t* hb = p.HB + tiled_off(grow, col0, 1024);
#pragma unroll
          for (int c = 0; c < 4; ++c) {
            const fl4 h0 = *(const fl4*)(hin + col0 + c * 8), h1 = *(const fl4*)(hin + col0 + c * 8 + 4);
            const fl4 o0 = MKF4(h0.x + acc[mi][2 * c][0], h0.y + acc[mi][2 * c][1], h0.z + acc[mi][2 * c][2], h0.w + acc[mi][2 * c][3]);
            const fl4 o1 = MKF4(h1.x + acc[mi][2 * c + 1][0], h1.y + acc[mi][2 * c + 1][1], h1.z + acc[mi][2 * c + 1][2], h1.w + acc[mi][2 * c + 1][3]);
            *(fl4*)(hout + col0 + c * 8) = o0;
            *(fl4*)(hout + col0 + c * 8 + 4) = o1;
            *(u32x4*)(hb + c * 8) = MK4(pack2(o0.x, o0.y), pack2(o0.z, o0.w), pack2(o1.x, o1.y), pack2(o1.z, o1.w));
          }
        }
      } else if (EPI == EPI_UP) {
        bf16_t* xp = p.X + tiled_off(grow, nt * 256 + cw, 4096);
#pragma unroll
        for (int c = 0; c < 4; ++c) {
          float v[8];
#pragma unroll
          for (int e = 0; e < 8; ++e) { const float a = fmaxf(acc[mi][2 * c + (e >> 2)][e & 3] * rs, 0.f); v[e] = a * a; }
          *(u32x4*)(xp + c * 8) = MK4(pack2(v[0], v[1]), pack2(v[2], v[3]), pack2(v[4], v[5]), pack2(v[6], v[7]));
        }
      }
    }
    }
  }
}

template <int MIX, int PASS>
__device__ __forceinline__ void scan_phase(const Params& p, int l, int g, char* smem) {
  constexpr int NH = MIX ? 4 : 8;
  constexpr int NDV = MIX ? 4 : 2;
  constexpr int XLD = MIX ? 2048 : 4096;
  bf16_t* QS = (bf16_t*)smem;
  bf16_t* KS = QS + 64 * 136;
  bf16_t* KT = KS + 64 * 136;
  bf16_t* LG = KT;
  bf16_t* Pm = QS;
  bf16_t* SmT = KS;
  bf16_t* VT = KT + 128 * 72;
  bf16_t* RS = VT + 64 * 72;
  float* em = (float*)(RS + 64 * 24);
  float* el = em + 128;
  float* tot = el + 128;
  const int bid_ = opaque_bid();
  const int t_outer = opaque_tid(smem);
  const int sps = g == 0 ? 16 : 4;
  constexpr bool do_out = (PASS == 3);
  const bf16_t* Xg = p.X;

  for (int item = bid_; item < 512; item += gridDim.x) {
    int t = t_outer;
    asm volatile("" : "+v"(t));
    const int lane = t & 63, w = t >> 6, quad = lane >> 4, l15 = lane & 15;
    const int dir = item & 1;
    const int dvb = (item >> 1) % NDV;
    const int head = ((item >> 1) / NDV) % NH;
    const int seg = item >> 5;
    const int seq = seg / sps;
    const bool first = (seg % sps) == 0;
    const int nsteps = 16 + (first ? 1 : 0);
    int qcol, kcol, vcol;
    bf16_t* Og; int OLD;
    if (MIX == 0) {
      qcol = head * 128; kcol = 1024 + dir * 1024 + head * 128; vcol = 3072 + head * 128 + dvb * 64;
      Og = p.O + dir * 1024 + head * 128 + dvb * 64; OLD = 2048;
    } else {
      qcol = head * 128; kcol = 512 + head * 128; vcol = 1024 + head * 256 + dvb * 64;
      Og = p.X + (size_t)MROWS * 2048 + (size_t)dir * MROWS * 1024 + head * 256 + dvb * 64; OLD = 1024;
    }
    bf16x8 wgf[2]; float bgv[2][4];
    if (MIX == 1) {
#pragma unroll
      for (int ct = 0; ct < 2; ++ct) {
        const int cc = 16 * (2 * w + ct) + l15;
        bf16x8 v = (bf16x8){0, 0, 0, 0, 0, 0, 0, 0};
        if (quad < 2) {
#pragma unroll
          for (int e = 0; e < 8; ++e)
            v[e] = (short)f2bf(p.w_gate[((size_t)(l * 2 + dir) * 16 + quad * 8 + e) * 512 + head * 128 + cc]);
        }
        wgf[ct] = v;
#pragma unroll
        for (int r = 0; r < 4; ++r) bgv[ct][r] = p.b_gate[(l * 2 + dir) * 512 + head * 128 + 16 * (2 * w + ct) + quad * 4 + r];
      }
    }
    f32x4 S[8];
#pragma unroll
    for (int a = 0; a < 8; ++a) S[a] = (f32x4){0.f, 0.f, 0.f, 0.f};
    if (do_out) {
      int s2 = dir == 0 ? seq * sps : seq * sps + sps - 1;
      const int stp = dir == 0 ? 1 : -1;
      for (; s2 != seg; s2 += stp) {
        const int item2 = ((s2 * NH + head) * NDV + dvb) * 2 + dir;
        const bf16_t* L = p.ST + (size_t)item2 * 8192;
        const float* G = p.GD + ((s2 * 8 + head) * 2 + dir) * 128;
#pragma unroll
        for (int a = 0; a < 8; ++a)
#pragma unroll
          for (int r = 0; r < 4; ++r) {
            const int k = 16 * (2 * w + (a >> 2)) + quad * 4 + r;
            S[a][r] = __builtin_amdgcn_exp2f(G[k]) * S[a][r] + bf2f(L[(a * 4 + r) * 256 + t]);
          }
      }
    }
    float gacc0 = 0.f, gacc1 = 0.f;

    u32x4 qr[4], kr[4], vr[2], rr;
    auto step_rows = [&](int s, int& rowbase, int& nv) {
      bool meta;
      if (dir == 0) { meta = first && s == 0; rowbase = (seg * 16 + s - (first ? 1 : 0)) * 64; }
      else { meta = (s == 16); rowbase = (seg * 16 + 15 - s) * 64; }
      if (meta) { rowbase = NTOKG + seq * 16; nv = 16; } else nv = 64;
    };
    const char* Xq = (const char*)(Xg + qcol);
    const char* Xk = (const char*)(Xg + kcol);
    const char* Xv = (const char*)(Xg + vcol);
    const char* Rb = (const char*)(p.R + dir * 16);
    auto gload = [&](int s) {
      int rowbase, nv; step_rows(s, rowbase, nv);
#pragma unroll
      for (int j = 0; j < 4; ++j) {
        const int i = (t >> 4) + 16 * j;
        const int mr = dir ? rowbase + nv - 1 - i : rowbase + i;
        u32x4 z = MK4(0, 0, 0, 0);
        if (i < nv) {
          const uint32_t vo = (uint32_t)(mr * XLD + (t & 15) * 8) * 2u;
          qr[j] = do_out ? *(const u32x4*)(Xq + vo) : z;
          kr[j] = *(const u32x4*)(Xk + vo);
        } else { qr[j] = z; kr[j] = z; }
      }
      {
        const int i = t >> 2;
        const int mr = dir ? rowbase + nv - 1 - i : rowbase + i;
        vr[0] = MK4(0, 0, 0, 0); vr[1] = vr[0];
        if (i < nv) {
          const uint32_t vo = (uint32_t)(mr * XLD + (t & 3) * 16) * 2u;
          vr[0] = *(const u32x4*)(Xv + vo); vr[1] = *(const u32x4*)(Xv + vo + 16);
        }
      }
      if (MIX == 1) {
        rr = MK4(0, 0, 0, 0);
        if (t < 128) {
          const int i = t >> 1;
          const int mr = dir ? rowbase + nv - 1 - i : rowbase + i;
          if (i < nv) rr = *(const u32x4*)(Rb + (uint32_t)(mr * 32 + (t & 1) * 8) * 2u);
        }
      }
    };
    gload(0);

    for (int s = 0; s < nsteps; ++s) {
      int rowbase, nv; step_rows(s, rowbase, nv);
#pragma unroll
      for (int j = 0; j < 4; ++j) {
        const int i = (t >> 4) + 16 * j;
        if (do_out) *(u32x4*)(QS + i * 136 + (t & 15) * 8) = qr[j];
        *(u32x4*)(KS + i * 136 + (t & 15) * 8) = kr[j];
      }
      {
        const int i = t >> 2, piece = t & 3;
        uint32_t vv[8] = {vr[0].x, vr[0].y, vr[0].z, vr[0].w, vr[1].x, vr[1].y, vr[1].z, vr[1].w};
        bf16_t* vtw = VT + piece * 16 * 72 + i;
#pragma unroll
        for (int e = 0; e < 16; ++e) vtw[e * 72] = (bf16_t)((vv[e >> 1] >> ((e & 1) * 16)) & 0xffffu);
      }
      if (MIX == 1 && t < 128) *(u32x4*)(RS + (t >> 1) * 24 + (t & 1) * 8) = rr;
      if (s + 1 < nsteps) gload(s + 1);
      __syncthreads();
      if (MIX == 1) {
        bf16x8 af[4];
#pragma unroll
        for (int it = 0; it < 4; ++it) {
          af[it] = (bf16x8){0, 0, 0, 0, 0, 0, 0, 0};
          if (quad < 2) af[it] = *(const bf16x8*)(RS + (16 * it + l15) * 24 + quad * 8);
        }
#pragma unroll
        for (int ct = 0; ct < 2; ++ct)
#pragma unroll
          for (int it = 0; it < 4; ++it) {
            f32x4 z = __builtin_amdgcn_mfma_f32_16x16x32_bf16(wgf[ct], af[it], (f32x4){0.f, 0.f, 0.f, 0.f}, 0, 0, 0);
            float ls[4];
#pragma unroll
            for (int r = 0; r < 4; ++r) {
              const float zz = fmaxf(z[r] + bgv[ct][r], -80.f);
              ls[r] = __builtin_amdgcn_logf(1.f + __builtin_amdgcn_exp2f(zz * -1.4426950408889634f)) * -0.0625f;
            }
            *(u32x2*)(LG + (16 * it + l15) * 128 + 16 * (2 * w + ct) + quad * 4) = MK2(pack2(ls[0], ls[1]), pack2(ls[2], ls[3]));
          }
        __syncthreads();
      }
      const int cp = t & 63, rg = t >> 6;
      const int nvl = nv - 16 * rg;
      float p0[16], p1[16];
      {
        float run0 = 0.f, run1 = 0.f;
        constexpr int LFS32 = (MIX == 0) ? 68 : 64;
        const uint32_t* lfp = (const uint32_t*)((MIX == 0) ? (KS + 16 * rg * 136) : (LG + 16 * rg * 128)) + cp;
#pragma unroll
        for (int ii = 0; ii < 16; ++ii) {
          if ((ii & 7) == 0) __builtin_amdgcn_sched_barrier(0);
          const uint32_t u = lfp[ii * LFS32];
          float l0 = __uint_as_float(u << 16), l1 = __uint_as_float(u & 0xffff0000u);
          if (ii >= nvl) { l0 = 0.f; l1 = 0.f; }
          run0 += l0; run1 += l1;
          p0[ii] = run0; p1[ii] = run1;
        }
        *(float2*)(tot + rg * 128 + 2 * cp) = make_float2(run0, run1);
      }
      __syncthreads();
      {
        const float2 ta = *(const float2*)(tot + 2 * cp), tb = *(const float2*)(tot + 128 + 2 * cp);
        const float2 tc = *(const float2*)(tot + 256 + 2 * cp), td = *(const float2*)(tot + 384 + 2 * cp);
        const float m0 = ta.x + tb.x, m1 = ta.y + tb.y;
        const float base0 = (rg > 0 ? ta.x : 0.f) + (rg > 1 ? tb.x : 0.f) + (rg > 2 ? tc.x : 0.f);
        const float base1 = (rg > 0 ? ta.y : 0.f) + (rg > 1 ? tb.y : 0.f) + (rg > 2 ? tc.y : 0.f);
        uint32_t* qp = (uint32_t*)(QS + 16 * rg * 136) + cp;
        uint32_t* kp = (uint32_t*)(KS + 16 * rg * 136) + cp;
        float skp0 = __builtin_amdgcn_exp2f(-fminf(fmaxf(base0 - m0, -115.f), 115.f));
        float skp1 = __builtin_amdgcn_exp2f(-fminf(fmaxf(base1 - m1, -115.f), 115.f));
        uint32_t kt0[8], kt1[8], kkprev = 0;
#pragma unroll
        for (int ii = 0; ii < 16; ++ii) {
          if ((ii & 3) == 0) __builtin_amdgcn_sched_barrier(0);
          const float e0 = fminf(fmaxf(base0 + p0[ii] - m0, -115.f), 115.f);
          const float e1 = fminf(fmaxf(base1 + p1[ii] - m1, -115.f), 115.f);
          const float sq0 = __builtin_amdgcn_exp2f(e0), sq1 = __builtin_amdgcn_exp2f(e1);
          const float sk0 = __builtin_amdgcn_rcpf(sq0), sk1 = __builtin_amdgcn_rcpf(sq1);
          if (do_out) {
            const uint32_t uq = qp[ii * 68];
            qp[ii * 68] = pack2(__uint_as_float(uq << 16) * sq0, __uint_as_float(uq & 0xffff0000u) * sq1);
          }
          float k0, k1;
          if (MIX == 0) { k0 = 1.f - sq0 * skp0; k1 = 1.f - sq1 * skp1; skp0 = sk0; skp1 = sk1; }
          else { const uint32_t uk = kp[ii * 68]; k0 = __uint_as_float(uk << 16); k1 = __uint_as_float(uk & 0xffff0000u); }
          const uint32_t kk = pack2(k0 * sk0, k1 * sk1);
          if (do_out) kp[ii * 68] = kk;
          if (ii & 1) {
            kt0[ii >> 1] = __builtin_amdgcn_perm(kk, kkprev, 0x05040100u);
            kt1[ii >> 1] = __builtin_amdgcn_perm(kk, kkprev, 0x07060302u);
          } else kkprev = kk;
        }
        u32x4* kd0 = (u32x4*)(KT + (2 * cp) * 72 + 16 * rg);
        u32x4* kd1 = (u32x4*)(KT + (2 * cp + 1) * 72 + 16 * rg);
        kd0[0] = MK4(kt0[0], kt0[1], kt0[2], kt0[3]); kd0[1] = MK4(kt0[4], kt0[5], kt0[6], kt0[7]);
        kd1[0] = MK4(kt1[0], kt1[1], kt1[2], kt1[3]); kd1[1] = MK4(kt1[4], kt1[5], kt1[6], kt1[7]);
        if (rg == 0) {
          *(float2*)(em + 2 * cp) = make_float2(__builtin_amdgcn_exp2f(m0), __builtin_amdgcn_exp2f(m1));
          *(float2*)(el + 2 * cp) = make_float2(__builtin_amdgcn_exp2f(tc.x + td.x), __builtin_amdgcn_exp2f(tc.y + td.y));
        }
        gacc0 += m0 + tc.x + td.x; gacc1 += m1 + tc.y + td.y;
      }
      __syncthreads();
      if (do_out) {
        bf16x8 qf[4];
#pragma unroll
        for (int ks = 0; ks < 4; ++ks) qf[ks] = *(const bf16x8*)(QS + (16 * w + l15) * 136 + ks * 32 + quad * 8);
        f32x4 pa[4];
#pragma unroll
        for (int jt = 0; jt < 4; ++jt) {
          pa[jt] = (f32x4){0.f, 0.f, 0.f, 0.f};
          if (jt <= w) {
#pragma unroll
            for (int ks = 0; ks < 4; ++ks) {
              bf16x8 kf = *(const bf16x8*)(KS + (16 * jt + l15) * 136 + ks * 32 + quad * 8);
              pa[jt] = __builtin_amdgcn_mfma_f32_16x16x32_bf16(kf, qf[ks], pa[jt], 0, 0, 0);
            }
          }
        }
        __syncthreads();
        {
          const int i = 16 * w + l15;
          bf16_t* pw = Pm + i * 72 + quad * 4;
#pragma unroll
          for (int jt = 0; jt < 4; ++jt) {
            const int j0 = 16 * jt + quad * 4;
            float pv[4];
#pragma unroll
            for (int r = 0; r < 4; ++r) pv[r] = (jt <= w && j0 + r <= i) ? pa[jt][r] : 0.f;
            *(u32x2*)(pw + 16 * jt) = MK2(pack2(pv[0], pv[1]), pack2(pv[2], pv[3]));
          }
        }
#pragma unroll
        for (int a = 0; a < 8; ++a) {
          const int k0 = 16 * (2 * w + (a >> 2)) + quad * 4;
          const int v = 16 * (a & 3) + l15;
          const fl4 e = *(const fl4*)(em + k0);
          S[a][0] *= e.x; S[a][1] *= e.y; S[a][2] *= e.z; S[a][3] *= e.w;
          *(u32x2*)(SmT + v * 136 + k0) = MK2(pack2(S[a][0], S[a][1]), pack2(S[a][2], S[a][3]));
        }
        __syncthreads();
        f32x4 oa[4];
#pragma unroll
        for (int vt = 0; vt < 4; ++vt) {
          oa[vt] = (f32x4){0.f, 0.f, 0.f, 0.f};
#pragma unroll
          for (int ks = 0; ks < 4; ++ks) {
            bf16x8 sf = *(const bf16x8*)(SmT + (16 * vt + l15) * 136 + ks * 32 + quad * 8);
            oa[vt] = __builtin_amdgcn_mfma_f32_16x16x32_bf16(sf, qf[ks], oa[vt], 0, 0, 0);
          }
        }
#pragma unroll
        for (int js = 0; js < 2; ++js) {
          bf16x8 pfr = *(const bf16x8*)(Pm + (16 * w + l15) * 72 + js * 32 + quad * 8);
#pragma unroll
          for (int vt = 0; vt < 4; ++vt) {
            bf16x8 vf = *(const bf16x8*)(VT + (16 * vt + l15) * 72 + js * 32 + quad * 8);
            oa[vt] = __builtin_amdgcn_mfma_f32_16x16x32_bf16(vf, pfr, oa[vt], 0, 0, 0);
          }
        }
        {
          const int i = 16 * w + l15;
          if (i < nv) {
            const int mr = dir ? rowbase + nv - 1 - i : rowbase + i;
            bf16_t* op = (bf16_t*)((char*)Og + (uint32_t)(mr * OLD + quad * 4) * 2u);
#pragma unroll
            for (int vt = 0; vt < 4; ++vt) *(u32x2*)(op + 16 * vt) = MK2(pack2(oa[vt][0], oa[vt][1]), pack2(oa[vt][2], oa[vt][3]));
          }
        }
      } else {
#pragma unroll
        for (int a = 0; a < 8; ++a) {
          const int k0 = 16 * (2 * w + (a >> 2)) + quad * 4;
          const fl4 e = *(const fl4*)(em + k0);
          S[a][0] *= e.x; S[a][1] *= e.y; S[a][2] *= e.z; S[a][3] *= e.w;
        }
      }
#pragma unroll
      for (int js = 0; js < 2; ++js) {
        bf16x8 kf[2];
#pragma unroll
        for (int ktl = 0; ktl < 2; ++ktl) kf[ktl] = *(const bf16x8*)(KT + (16 * (2 * w + ktl) + l15) * 72 + js * 32 + quad * 8);
#pragma unroll
        for (int vt = 0; vt < 4; ++vt) {
          bf16x8 vf = *(const bf16x8*)(VT + (16 * vt + l15) * 72 + js * 32 + quad * 8);
#pragma unroll
          for (int ktl = 0; ktl < 2; ++ktl)
            S[ktl * 4 + vt] = __builtin_amdgcn_mfma_f32_16x16x32_bf16(kf[ktl], vf, S[ktl * 4 + vt], 0, 0, 0);
        }
      }
#pragma unroll
      for (int a = 0; a < 8; ++a) {
        const int k0 = 16 * (2 * w + (a >> 2)) + quad * 4;
        const fl4 e = *(const fl4*)(el + k0);
        S[a][0] *= e.x; S[a][1] *= e.y; S[a][2] *= e.z; S[a][3] *= e.w;
      }
      __syncthreads();
    }
    if (!do_out) {
      bf16_t* L = p.ST + (size_t)item * 8192;
#pragma unroll
      for (int a = 0; a < 8; ++a)
#pragma unroll
        for (int r = 0; r < 4; ++r) L[(a * 4 + r) * 256 + t] = f2bf(S[a][r]);
      if (dvb == 0 && t < 64) *(float2*)(p.GD + ((seg * 8 + head) * 2 + dir) * 128 + 2 * t) = make_float2(gacc0, gacc1);
    }
  }
}

__device__ __forceinline__ void phase_hn(const Params& p, int l, char* smem) {
  const int bid_ = opaque_bid();
  const int t = opaque_tid(smem), lane = t & 63, w = t >> 6;
  const bf16_t* Y1 = p.X + (size_t)MROWS * 2048;
  const bf16_t* Y2 = Y1 + (size_t)MROWS * 1024;
  for (int row = bid_ * 4 + w; row < MROWS; row += gridDim.x * 4) {
    bf16_t* oa = p.O + (size_t)row * 2048 + lane * 16;
    float xa[16], xb[16];
    {
      u32x4 a0 = *(const u32x4*)(oa), a1 = *(const u32x4*)(oa + 8);
      u32x4 b0 = *(const u32x4*)(oa + 1024), b1 = *(const u32x4*)(oa + 1032);
      uint32_t ua[8] = {a0.x, a0.y, a0.z, a0.w, a1.x, a1.y, a1.z, a1.w};
      uint32_t ub[8] = {b0.x, b0.y, b0.z, b0.w, b1.x, b1.y, b1.z, b1.w};
#pragma unroll
      for (int e = 0; e < 8; ++e) {
        xa[2 * e] = __uint_as_float(ua[e] << 16) + __uint_as_float(ub[e] << 16);
        xa[2 * e + 1] = __uint_as_float(ua[e] & 0xffff0000u) + __uint_as_float(ub[e] & 0xffff0000u);
      }
      const bf16_t* y1 = Y1 + (size_t)row * 1024 + lane * 16;
      const bf16_t* y2 = Y2 + (size_t)row * 1024 + lane * 16;
      u32x4 c0 = *(const u32x4*)(y1), c1 = *(const u32x4*)(y1 + 8);
      u32x4 d0 = *(const u32x4*)(y2), d1 = *(const u32x4*)(y2 + 8);
      uint32_t uc[8] = {c0.x, c0.y, c0.z, c0.w, c1.x, c1.y, c1.z, c1.w};
      uint32_t ud[8] = {d0.x, d0.y, d0.z, d0.w, d1.x, d1.y, d1.z, d1.w};
#pragma unroll
      for (int e = 0; e < 8; ++e) {
        xb[2 * e] = __uint_as_float(uc[e] << 16) + __uint_as_float(ud[e] << 16);
        xb[2 * e + 1] = __uint_as_float(uc[e] & 0xffff0000u) + __uint_as_float(ud[e] & 0xffff0000u);
      }
    }
    float sa = 0.f, sb = 0.f;
#pragma unroll
    for (int e = 0; e < 16; ++e) { sa += xa[e] * xa[e]; sb += xb[e] * xb[e]; }
    sa += shx<1>(sa, lane); sa += shx<2>(sa, lane); sa += shx<4>(sa, lane);
    sb += shx<1>(sb, lane); sb += shx<2>(sb, lane); sb += shx<4>(sb, lane); sb += shx<8>(sb, lane);
    const float ra = rsqrtf(sa * (1.f / 128.f) + 1e-6f);
    const float rb = rsqrtf(sb * (1.f / 256.f) + 1e-6f);
    const float* na = p.norm_a + l * 1024 + lane * 16;
    const float* nb = p.norm_b + l * 1024 + lane * 16;
    uint32_t pa[8], pb[8];
#pragma unroll
    for (int e = 0; e < 8; ++e) {
      pa[e] = pack2(xa[2 * e] * ra * na[2 * e], xa[2 * e + 1] * ra * na[2 * e + 1]);
      pb[e] = pack2(xb[2 * e] * rb * nb[2 * e], xb[2 * e + 1] * rb * nb[2 * e + 1]);
    }
    *(u32x4*)(oa) = MK4(pa[0], pa[1], pa[2], pa[3]);
    *(u32x4*)(oa + 8) = MK4(pa[4], pa[5], pa[6], pa[7]);
    *(u32x4*)(oa + 1024) = MK4(pb[0], pb[1], pb[2], pb[3]);
    *(u32x4*)(oa + 1032) = MK4(pb[4], pb[5], pb[6], pb[7]);
  }
}

__device__ __forceinline__ void phase_final(const Params& p, char* smem) {
  const int bid_ = opaque_bid();
  const int t = opaque_tid(smem), lane = t & 63, w = t >> 6;
  for (int row = bid_ * 4 + w; row < 2 * NTOKG; row += gridDim.x * 4) {
    float* hp = p.out + (size_t)row * 1024;
    fl4 v[4];
    float s = 0.f;
#pragma unroll
    for (int j = 0; j < 4; ++j) {
      v[j] = *(const fl4*)(hp + j * 256 + lane * 4);
      s += v[j].x * v[j].x + v[j].y * v[j].y + v[j].z * v[j].z + v[j].w * v[j].w;
    }
    s += shx<1>(s, lane); s += shx<2>(s, lane); s += shx<4>(s, lane);
    s += shx<8>(s, lane); s += shx<16>(s, lane); s += shx<32>(s, lane);
    const float rs = rsqrtf(s * (1.f / 1024.f) + 1e-6f);
#pragma unroll
    for (int j = 0; j < 4; ++j) {
      const fl4 gn = *(const fl4*)(p.final_norm + j * 256 + lane * 4);
      fl4 o = MKF4(v[j].x * rs * gn.x, v[j].y * rs * gn.y, v[j].z * rs * gn.z, v[j].w * rs * gn.w);
      *(fl4*)(hp + j * 256 + lane * 4) = o;
    }
  }
}

__device__ __forceinline__ void phase_xcvt(const Params& p, int g, char* smem) {
  const int bid_ = opaque_bid();
  const int t = opaque_tid(smem);
  for (int idx = bid_ * 256 + t; idx < MROWS * 128; idx += gridDim.x * 256) {
    const int row = idx >> 7, c8 = idx & 127;
    const float* src = row < NTOKG ? p.x[g] + (size_t)row * 1024 + c8 * 8 : p.hmeta + ((size_t)g * 128 + (row - NTOKG)) * 1024 + c8 * 8;
    const fl4 a = *(const fl4*)src, b = *(const fl4*)(src + 4);
    *(u32x4*)(p.HB + tiled_off((size_t)row, c8 * 8, 1024)) = MK4(pack2(a.x, a.y), pack2(a.z, a.w), pack2(b.x, b.y), pack2(b.z, b.w));
  }
}

__device__ __forceinline__ void run_phase(const Params& p, int ph, char* smem) {
  if (ph == 0) { phase_init(p, smem); return; }
  if (ph == NPHASES - 1) { phase_final(p, smem); return; }
  const int q = ph - 1;
  const int g = q / 23, r = q % 23;
  if (r == 0) { phase_xcvt(p, g, smem); return; }
  const int l = (r - 1) / 11, st = (r - 1) % 11;
  switch (st) {
    case 0: gemm_phase<EPI_G1A>(p, l, g, smem); break;
    case 1: scan_phase<0, 1>(p, l, g, smem); break;
    case 2: scan_phase<0, 3>(p, l, g, smem); break;
    case 3: gemm_phase<EPI_G1B>(p, l, g, smem); break;
    case 4: scan_phase<1, 1>(p, l, g, smem); break;
    case 5: scan_phase<1, 3>(p, l, g, smem); break;
    case 6: phase_hn(p, l, smem); break;
    case 7: gemm_phase<EPI_GATES>(p, l, g, smem); break;
    case 8: gemm_phase<EPI_WOUT>(p, l, g, smem); break;
    case 9: gemm_phase<EPI_UP>(p, l, g, smem); break;
    default: gemm_phase<EPI_DOWN>(p, l, g, smem); break;
  }
}

template <int ST>
__global__ void __launch_bounds__(256, 2) pk(Params p, int l, int g) {
  extern __shared__ __attribute__((aligned(16))) char smem[];
  if (ST == 100) phase_init(p, smem);
  else if (ST == 101) phase_final(p, smem);
  else if (ST == 102) phase_xcvt(p, g, smem);
  else if (ST == 0) gemm_phase<EPI_G1A>(p, l, g, smem);
  else if (ST == 1) scan_phase<0, 1>(p, l, g, smem);
  else if (ST == 2) scan_phase<0, 3>(p, l, g, smem);
  else if (ST == 3) gemm_phase<EPI_G1B>(p, l, g, smem);
  else if (ST == 4) scan_phase<1, 1>(p, l, g, smem);
  else if (ST == 5) scan_phase<1, 3>(p, l, g, smem);
  else if (ST == 6) phase_hn(p, l, smem);
  else if (ST == 7) gemm_phase<EPI_GATES>(p, l, g, smem);
  else if (ST == 8) gemm_phase<EPI_WOUT>(p, l, g, smem);
  else if (ST == 9) gemm_phase<EPI_UP>(p, l, g, smem);
  else gemm_phase<EPI_DOWN>(p, l, g, smem);
}


#define XB_TMO      128
#define XB_XCNT(j)  (256  + 64 * (j))
#define XB_XSUB(j)  (1280 + 64 * (j))
#define XB_XGEN(j)  (2304 + 64 * (j))
#define XB_TOP      3328
#define XB_TOPGEN   3392
#define XCD_BAR_WORDS 3456
#define XB_SPIN_CAP (1u << 22)
#define LAS __attribute__((address_space(3)))
__device__ __forceinline__ unsigned xb_ld(unsigned* p)              { return __hip_atomic_load(p, __ATOMIC_RELAXED, __HIP_MEMORY_SCOPE_AGENT); }
__device__ __forceinline__ unsigned xb_add(unsigned* p, unsigned v) { return __hip_atomic_fetch_add(p, v, __ATOMIC_RELAXED, __HIP_MEMORY_SCOPE_AGENT); }
__device__ __forceinline__ unsigned xb_xcc_id() { return (unsigned)__builtin_amdgcn_s_getreg((3 << 11) | 20) & 0xFu; }
#define XB_SPIN(cond, bar) do { unsigned _sp = 0; while (cond) { __builtin_amdgcn_s_sleep(1); \
    if ((++_sp & 255u) == 0u) { if (xb_ld(&(bar)[XB_TMO])) break; if (_sp > XB_SPIN_CAP) { atomicAdd(&(bar)[XB_TMO], 1u); break; } } } } while (0)

__device__ __forceinline__ void xcd_barrier_complete(unsigned* bar, unsigned x, unsigned& nloc, unsigned& nx) {
  const unsigned G = gridDim.x * gridDim.y * gridDim.z;
  unsigned sum, cnt, mine, sp = 0u;
  for (;;) {
    sum = 0u; cnt = 0u; mine = 0u;
#pragma unroll
    for (unsigned j = 0; j < 16; ++j) { const unsigned c = xb_ld(&bar[XB_XCNT(j)]); sum += c; cnt += (c > 0u) ? 1u : 0u; mine = (j == x) ? c : mine; }
    if (sum == G) break;
    __builtin_amdgcn_s_sleep(1);
    if ((++sp & 255u) == 0u) { if (xb_ld(&bar[XB_TMO])) break; if (sp > XB_SPIN_CAP) { atomicAdd(&bar[XB_TMO], 1u); break; } }
  }
  nloc = mine > 0u ? mine : 1u; nx = cnt > 0u ? cnt : 1u;
}

__device__ __forceinline__ void xcd_barrier(unsigned* bar, volatile LAS unsigned* st, bool leader_thread) {
  asm volatile("s_waitcnt vmcnt(0)" ::: "memory");
  __syncthreads();
  if (leader_thread) {
    const unsigned x = xb_xcc_id();
    __builtin_amdgcn_s_waitcnt(0);
    unsigned nloc = st[0], nx = st[1];
    if (nloc == 0u) { xcd_barrier_complete(bar, x, nloc, nx); st[0] = nloc; st[1] = nx; }
    const unsigned old = xb_add(&bar[XB_XSUB(x)], 1u);
    const unsigned gen = old / nloc;
    if (old + 1u == (gen + 1u) * nloc) {
      __builtin_amdgcn_fence(__ATOMIC_RELEASE, "agent");
      asm volatile("s_waitcnt vmcnt(0)" ::: "memory");
      const unsigned og = xb_add(&bar[XB_TOP], 1u);
      const unsigned tg = og / nx;
      if (og + 1u == (tg + 1u) * nx) xb_add(&bar[XB_TOPGEN], 1u);
      else XB_SPIN(xb_ld(&bar[XB_TOPGEN]) == tg, bar);
      __builtin_amdgcn_fence(__ATOMIC_ACQUIRE, "agent");
      xb_add(&bar[XB_XGEN(x)], 1u);
      asm volatile("s_waitcnt vmcnt(0)" ::: "memory");
    } else {
      XB_SPIN(xb_ld(&bar[XB_XGEN(x)]) == gen, bar);
      __builtin_amdgcn_fence(__ATOMIC_ACQUIRE, "agent");
      asm volatile("s_waitcnt vmcnt(0)" ::: "memory");
    }
  }
  __syncthreads();
}

#ifndef MULTI_LAUNCH
__global__ void __launch_bounds__(256, 2) mega(Params p, int plo, int phi, int coop) {
  extern __shared__ __attribute__((aligned(16))) char smem[];
  volatile LAS unsigned* st = (volatile LAS unsigned*)(smem + LDS_BYTES + 16);
  {
    const int t0 = opaque_tid(smem);
    if (t0 == 0) { st[0] = 0u; st[1] = 0u; (void)xb_add(&p.bar[XB_XCNT(xb_xcc_id())], 1u); }
    __syncthreads();
  }
  for (int ph = plo; ph < phi; ++ph) {
    run_phase(p, ph, smem);
    if (coop && ph + 1 < phi) {
      if (ph == 0) cg::this_grid().sync();
      else { const int tb = opaque_tid(smem); xcd_barrier(p.bar, st, tb == 0); }
    }
  }
}

#endif

static inline size_t align_up(size_t x) { return (x + 255) & ~(size_t)255; }

extern "C" void kernel_launch(void* const* d_in, const int* in_sizes, int n_in,
                              void* d_out, int out_size, void* d_ws, size_t ws_size,
                              hipStream_t stream) {
  Params p{};
  p.x[0] = (const float*)d_in[0];
  p.x[1] = (const float*)d_in[1];
  p.meta = (const float*)d_in[2];
  p.attn_norm = (const float*)d_in[3];
  p.w_in = (const float*)d_in[4];
  p.lb_logits = (const float*)d_in[5];
  p.w_gate = (const float*)d_in[6];
  p.b_gate = (const float*)d_in[7];
  p.norm_a = (const float*)d_in[8];
  p.norm_b = (const float*)d_in[9];
  p.w_out = (const float*)d_in[10];
  p.mlp_norm = (const float*)d_in[11];
  p.w_up = (const float*)d_in[12];
  p.w_down = (const float*)d_in[13];
  p.final_norm = (const float*)d_in[14];
  p.out = (float*)d_out;
  char* ws = (char*)d_ws;
  size_t off = 0;
  p.W = (bf16_t*)(ws + off); off = align_up(off + (size_t)2 * LSTRIDE * 2);
  p.X = (bf16_t*)(ws + off); off = align_up(off + (size_t)MROWS * 4096 * 2);
  p.R = (bf16_t*)(ws + off); off = align_up(off + (size_t)MROWS * 32 * 2);
  p.O = (bf16_t*)(ws + off); off = align_up(off + (size_t)MROWS * 2048 * 2);
  p.HB = (bf16_t*)(ws + off); off = align_up(off + (size_t)MROWS * 1024 * 2);
  p.ST = (bf16_t*)(ws + off); off = align_up(off + (size_t)512 * 8192 * 2);
  p.GD = (float*)(ws + off); off = align_up(off + (size_t)16 * 8 * 2 * 128 * 4);
  p.hmeta = (float*)(ws + off); off = align_up(off + (size_t)2 * 128 * 1024 * 4);
  p.bar = (unsigned*)(ws + off); off = align_up(off + (size_t)XCD_BAR_WORDS * 4);
  if (off > ws_size) { fprintf(stderr, "workspace too small: need %zu have %zu\n", off, ws_size); return; }

#ifdef MULTI_LAUNCH
#define LAUNCH_PK(ST, l, g) do { \
    static bool attr_set_##ST = false; \
    if (!attr_set_##ST) { (void)hipFuncSetAttribute((const void*)pk<ST>, hipFuncAttributeMaxDynamicSharedMemorySize, LDS_BYTES + 32); attr_set_##ST = true; } \
    hipLaunchKernelGGL(pk<ST>, dim3(512), dim3(256), LDS_BYTES + 32, stream, p, l, g); } while (0)
  LAUNCH_PK(100, 0, 0);
  for (int g = 0; g < 2; ++g)
    for (int l = 0; l < 2; ++l) {
      if (l == 0) LAUNCH_PK(102, l, g);
      LAUNCH_PK(0, l, g); LAUNCH_PK(1, l, g); LAUNCH_PK(2, l, g); LAUNCH_PK(3, l, g); LAUNCH_PK(4, l, g); LAUNCH_PK(5, l, g);
      LAUNCH_PK(6, l, g); LAUNCH_PK(7, l, g); LAUNCH_PK(8, l, g); LAUNCH_PK(9, l, g); LAUNCH_PK(10, l, g);
    }
  LAUNCH_PK(101, 0, 0);
#else
  static int grid_blocks = 0;
  if (!grid_blocks) {
    (void)hipFuncSetAttribute((const void*)mega, hipFuncAttributeMaxDynamicSharedMemorySize, LDS_BYTES + 32);
    int dev = 0, cus = 0, per_cu = 0;
    (void)hipGetDevice(&dev);
    (void)hipDeviceGetAttribute(&cus, hipDeviceAttributeMultiprocessorCount, dev);
    (void)hipOccupancyMaxActiveBlocksPerMultiprocessor(&per_cu, (const void*)mega, 256, LDS_BYTES + 32);
    if (per_cu < 1) per_cu = 1;
    if (per_cu > 2) per_cu = 2;
    grid_blocks = cus * per_cu;
  }
  (void)hipMemsetAsync(p.bar, 0, (size_t)XCD_BAR_WORDS * 4, stream);
  int plo = 0, phi = NPHASES, coop = 1;
  void* args[] = {&p, &plo, &phi, &coop};
  hipError_t e = hipLaunchCooperativeKernel((const void*)mega, dim3(grid_blocks), dim3(256), args, LDS_BYTES + 32, stream);
  if (e != hipSuccess) fprintf(stderr, "cooperative launch failed: %s (grid %d)\n", hipGetErrorString(e), grid_blocks);
#endif
}
```

```cpp
#include <hip/hip_runtime.h>
#include <hip/hip_cooperative_groups.h>
#include <stdint.h>
#include <stdio.h>
namespace cg = cooperative_groups;

typedef __attribute__((ext_vector_type(8))) short bf16x8;
typedef __attribute__((ext_vector_type(4))) float f32x4;
typedef unsigned short bf16_t;
typedef uint32_t u32x4 __attribute__((ext_vector_type(4)));
typedef uint32_t u32x2 __attribute__((ext_vector_type(2)));
typedef float fl4 __attribute__((ext_vector_type(4)));
#define MK4(a,b,c,d) ((u32x4){(uint32_t)(a),(uint32_t)(b),(uint32_t)(c),(uint32_t)(d)})
#define MK2(a,b) ((u32x2){(uint32_t)(a),(uint32_t)(b)})
#define MKF4(a,b,c,d) ((fl4){(a),(b),(c),(d)})

#define NTOKG 16384
#define MROWS 16512
#define MTILES 129
#define LSTRIDE 20185088
#define WOFF_A 0
#define WOFF_B (4096 * 1024)
#define WOFF_G (6400 * 1024)
#define WOFF_O (10496 * 1024)
#define WOFF_U (11520 * 1024)
#define WOFF_D (15616 * 1024)
#define LDS_BYTES 80896
#define NPHASES 48

struct Params {
  const float* x[2];
  const float* meta;
  const float* attn_norm;
  const float* w_in;
  const float* lb_logits;
  const float* w_gate;
  const float* b_gate;
  const float* norm_a;
  const float* norm_b;
  const float* w_out;
  const float* mlp_norm;
  const float* w_up;
  const float* w_down;
  const float* final_norm;
  float* out;
  bf16_t* W;
  bf16_t* X;
  bf16_t* R;
  bf16_t* O;
  bf16_t* HB;
  bf16_t* ST;
  float* GD;
  float* hmeta;
  unsigned* bar;
};

__device__ __forceinline__ uint32_t pack2(float a, float b) {
  uint32_t r;
  asm("v_cvt_pk_bf16_f32 %0, %1, %2" : "=v"(r) : "v"(a), "v"(b));
  return r;
}
__device__ __forceinline__ bf16_t f2bf(float f) { return (bf16_t)(pack2(f, f) & 0xffffu); }
__device__ __forceinline__ int opaque_tid(char* smem) {
  int lane;
  asm volatile("v_mbcnt_lo_u32_b32 %0, -1, 0\n\tv_mbcnt_hi_u32_b32 %0, -1, %0" : "=v"(lane));
  int* cnt = (int*)(smem + LDS_BYTES);
  int w = 0;
  if (lane == 0) w = atomicAdd(cnt, 1);
  w = __builtin_amdgcn_readfirstlane(w) & 3;
  __syncthreads();
  return w * 64 + lane;
}
__device__ __forceinline__ int opaque_bid() { int b = blockIdx.x; asm volatile("" : "+s"(b)); return b; }
template <int M>
__device__ __forceinline__ float shx(float v, int lane) {
  if (M < 32) return __builtin_bit_cast(float, __builtin_amdgcn_ds_swizzle(__builtin_bit_cast(int, v), 0x1f | (M << 10)));
  return __builtin_bit_cast(float, __builtin_amdgcn_ds_bpermute((lane ^ M) << 2, __builtin_bit_cast(int, v)));
}
__device__ __forceinline__ float bf2f(bf16_t b) { return __uint_as_float(((uint32_t)b) << 16); }
__device__ __forceinline__ size_t tiled_off(size_t row, int col, int K) {
  return (((row >> 7) * (size_t)(K >> 5) + (size_t)(col >> 5)) * 128 + (row & 127)) * 32 + (size_t)(col & 31);
}
__device__ __forceinline__ float sigmoidf_(float x) { return __builtin_amdgcn_rcpf(1.f + __builtin_amdgcn_exp2f(x * -1.4426950408889634f)); }

__device__ __forceinline__ int w_in_col(int R, float& scale) {
  scale = 1.f;
  if (R < 4096) return R;
  if (R < 6400) {
    int n = R - 4096;
    if (n >= 2080) return -1;
    if (n < 512) scale = 0.08838834764831845f;
    return 5120 + n;
  }
  int n = R - 6400;
  int tt = n >> 8, wv = n & 255;
  int wn = wv >> 7, nl = wv & 127;
  int qd = nl >> 5, ni = (nl >> 2) & 7, r = nl & 3;
  int grp = ni >> 2, seg = ni & 3;
  int ucol = tt * 64 + wn * 32 + qd * 8 + grp * 4 + r;
  int base = seg == 0 ? 4096 : seg == 1 ? 8224 : seg == 2 ? 7200 : 9248;
  return base + ucol;
}

__device__ __forceinline__ void phase_init(const Params& p, char* smem) {
  const int t = opaque_tid(smem);
  const int bid_ = opaque_bid();
  for (int idx = bid_ * 256 + t; idx < 2 * 128 * 256; idx += gridDim.x * 256) {
    int g = idx / (128 * 256), r = (idx / 256) % 128, c4 = idx % 256;
    int nvalid = g == 0 ? 16 : 64;
    fl4 v = MKF4(0.f, 0.f, 0.f, 0.f);
    if (r < nvalid) v = *(const fl4*)(p.meta + (size_t)(r & 15) * 1024 + c4 * 4);
    *(fl4*)(p.hmeta + ((size_t)g * 128 + r) * 1024 + c4 * 4) = v;
  }
  float* tile = (float*)smem;
  const int per_layer = 3904 + 1024;
  for (int id = bid_; id < 2 * per_layer; id += gridDim.x) {
    int l = id / per_layer, r = id % per_layer;
    const float* src; int ld; const float* gain = nullptr; int K, n0, k0;
    bf16_t* dst;
    int kind;
    int cbase = 0;
    if (r < 3904) {
      int rt = r >> 4, kt = r & 15;
      n0 = rt * 64; k0 = kt * 64; K = 1024;
      dst = p.W + (size_t)l * LSTRIDE;
      if (n0 < 10496) { kind = 0; src = p.w_in + (size_t)l * 1024 * 10272; ld = 10272; gain = p.attn_norm + l * 1024; }
      else if (n0 < 11520) { kind = 1; src = p.w_out + (size_t)l * 1024 * 1024; ld = 1024; cbase = n0 - 10496; }
      else { kind = 1; src = p.w_up + (size_t)l * 1024 * 4096; ld = 4096; cbase = n0 - 11520; gain = p.mlp_norm + l * 1024; }
    } else {
      int r2 = r - 3904;
      int rt = r2 >> 6, kt = r2 & 63;
      n0 = rt * 64; k0 = kt * 64; K = 4096;
      dst = p.W + (size_t)l * LSTRIDE + WOFF_D;
      kind = 1; src = p.w_down + (size_t)l * 4096 * 1024; ld = 1024; cbase = n0;
    }
    {
      int n = t & 63;
      float scale = 1.f; int col;
      if (kind == 0) col = w_in_col(n0 + n, scale); else col = cbase + n;
#pragma unroll 4
      for (int i = 0; i < 16; ++i) {
        int kk = (t >> 6) + 4 * i;
        float v = 0.f;
        if (col >= 0) {
          v = src[(size_t)(k0 + kk) * ld + col] * scale;
          if (gain) v *= gain[k0 + kk];
        }
        tile[kk * 65 + n] = v;
      }
    }
    __syncthreads();
    {
      int n = t >> 2, piece = t & 3;
      uint32_t pk[8];
#pragma unroll
      for (int e = 0; e < 8; ++e) {
        float a = tile[(piece * 16 + 2 * e) * 65 + n];
        float b = tile[(piece * 16 + 2 * e + 1) * 65 + n];
        pk[e] = pack2(a, b);
      }
      const int Rr = n0 + n, kk = k0 + piece * 16;
      u32x4* d = (u32x4*)(dst + ((size_t)((Rr >> 8) * (K >> 5) + (kk >> 5)) * 256 + (Rr & 255)) * 32 + (kk & 31));
      d[0] = MK4(pk[0], pk[1], pk[2], pk[3]);
      d[1] = MK4(pk[4], pk[5], pk[6], pk[7]);
    }
    __syncthreads();
  }
}

enum { EPI_G1A = 0, EPI_G1B, EPI_GATES, EPI_WOUT, EPI_UP, EPI_DOWN };

template <int EPI>
__device__ __forceinline__ void gemm_phase(const Params& p, int l, int g, char* smem) {
  constexpr bool NORM = (EPI == EPI_G1A || EPI == EPI_G1B || EPI == EPI_GATES || EPI == EPI_UP);
  constexpr int K = (EPI == EPI_DOWN) ? 4096 : 1024;
  constexpr int NT = EPI == EPI_G1A ? 16 : EPI == EPI_G1B ? 9 : EPI == EPI_GATES ? 16 : EPI == EPI_WOUT ? 4 : EPI == EPI_UP ? 16 : 4;
  constexpr int WOFF = EPI == EPI_G1A ? WOFF_A : EPI == EPI_G1B ? WOFF_B : EPI == EPI_GATES ? WOFF_G : EPI == EPI_WOUT ? WOFF_O : EPI == EPI_UP ? WOFF_U : WOFF_D;
  constexpr int NK = K / 32;
  const bf16_t* Wl = p.W + (size_t)l * LSTRIDE + WOFF;
  bf16_t* As = (bf16_t*)smem;
  bf16_t* Bs = As + 2 * 128 * 32;
  float* rss = (float*)(Bs + 2 * 256 * 32);
  const int bid_ = opaque_bid();
  const int t = opaque_tid(smem), lane = t & 63, w = t >> 6, wm = w >> 1, wn = w & 1;
  const int quad = lane >> 4, l15 = lane & 15;
  const int nvalid_meta = g == 0 ? 16 : 64;

  for (int tile = bid_; tile < MTILES * NT; tile += gridDim.x) {
    const int mt = tile / NT, nt = tile % NT;
    const bf16_t* Ab = NORM ? p.HB + (size_t)mt * 128 * 1024 : p.X + (size_t)mt * 128 * K;
    const bf16_t* Bg = Wl + (size_t)nt * 256 * K;
    const bool do_mma = !(mt == 128 && wm == 1) && !(EPI == EPI_G1B && nt == 8 && wn == 1);

    f32x4 acc[4][8];
#pragma unroll
    for (int a = 0; a < 4; ++a)
#pragma unroll
      for (int b = 0; b < 8; ++b) acc[a][b] = (f32x4){0.f, 0.f, 0.f, 0.f};
    float ss[2] = {0.f, 0.f};
    int t_l = t;
    asm volatile("" : "+v"(t_l));
    const uint32_t voffA = (uint32_t)((t_l >> 2) * 64 + (((t_l & 3) ^ (((t_l >> 5) & 1) << 1)) * 16));
    const uint32_t voffB0 = (uint32_t)((t_l >> 2) * 64 + ((t_l & 3) * 16));
    const uint32_t voffB1 = (uint32_t)((t_l >> 2) * 64 + (((t_l & 3) ^ 2) * 16));
    const char* Abase = (const char*)Ab;
    const char* Bbase = (const char*)Bg;
    const int rpiece = quad ^ (((l15 >> 3) & 1) << 1);
#define GLDS(gp, lp) __builtin_amdgcn_global_load_lds((const __attribute__((address_space(1))) void*)(gp), (__attribute__((address_space(3))) void*)(lp), 16, 0, 0)
#define G_DMA(KT, BUF) do { \
      _Pragma("unroll") for (int i = 0; i < 2; ++i) \
        GLDS(Abase + (size_t)(KT) * 8192 + (size_t)i * 4096 + voffA, (char*)(As + (BUF) * 4096) + (i * 256 + t) * 16); \
      _Pragma("unroll") for (int i = 0; i < 4; ++i) \
        GLDS(Bbase + (size_t)(KT) * 16384 + (size_t)i * 4096 + ((i & 1) ? voffB1 : voffB0), (char*)(Bs + (BUF) * 8192) + (i * 256 + t) * 16); } while (0)
#define G_COMPUTE(BUF) do { \
      if (NORM) { \
        _Pragma("unroll") for (int i = 0; i < 2; ++i) { \
          const u32x4 av = *(const u32x4*)((const char*)(As + (BUF) * 4096) + (i * 256 + t) * 16); \
          const uint32_t uu[4] = {av.x, av.y, av.z, av.w}; \
          _Pragma("unroll") for (int e = 0; e < 4; ++e) { \
            const float lo = __uint_as_float(uu[e] << 16), hi = __uint_as_float(uu[e] & 0xffff0000u); \
            ss[i] += lo * lo + hi * hi; } } } \
      if (do_mma) { \
      const bf16_t* Aw = As + (BUF) * 4096; const bf16_t* Bw = Bs + (BUF) * 8192; \
      bf16x8 af[4], bfr[8]; \
      _Pragma("unroll") for (int mi = 0; mi < 4; ++mi) af[mi] = *(const bf16x8*)(Aw + (wm * 64 + mi * 16 + l15) * 32 + rpiece * 8); \
      _Pragma("unroll") for (int ni = 0; ni < 8; ++ni) bfr[ni] = *(const bf16x8*)(Bw + (wn * 128 + (l15 >> 2) * 32 + ni * 4 + (l15 & 3)) * 32 + rpiece * 8); \
      __builtin_amdgcn_s_setprio(1); \
      _Pragma("unroll") for (int ni = 0; ni < 8; ++ni) \
        _Pragma("unroll") for (int mi = 0; mi < 4; ++mi) \
          acc[mi][ni] = __builtin_amdgcn_mfma_f32_16x16x32_bf16(bfr[ni], af[mi], acc[mi][ni], 0, 0, 0); \
      __builtin_amdgcn_s_setprio(0); } } while (0)

    G_DMA(0, 0);
#pragma unroll 1
    for (int kt = 0; kt < NK; kt += 2) {
      asm volatile("s_waitcnt vmcnt(0)" ::: "memory");
      __syncthreads();
      G_DMA(kt + 1, 1);
      G_COMPUTE(0);
      asm volatile("s_waitcnt vmcnt(0)" ::: "memory");
      __syncthreads();
      { const int kn = (kt + 2 < NK) ? kt + 2 : NK - 1; G_DMA(kn, 0); }
      G_COMPUTE(1);
    }
    asm volatile("s_waitcnt vmcnt(0)" ::: "memory");
    __syncthreads();
#undef GLDS
#undef G_DMA
#undef G_COMPUTE

    int quad_e = quad, l15_e = l15, t_e = t;
    asm volatile("" : "+v"(quad_e), "+v"(l15_e), "+v"(t_e));
    if (NORM) {
#pragma unroll
      for (int i = 0; i < 2; ++i) {
        float s = ss[i];
        s += shx<1>(s, lane); s += shx<2>(s, lane);
        if ((t_e & 3) == 0) rss[(t_e >> 2) + 64 * i] = rsqrtf(s * (1.f / 1024.f) + 1e-6f);
      }
      __syncthreads();
    }
    if (do_mma) {
#pragma unroll
    for (int mi = 0; mi < 4; ++mi) {
      __builtin_amdgcn_sched_barrier(0);
      const int rl = wm * 64 + mi * 16 + l15_e;
      const size_t grow = (size_t)mt * 128 + rl;
      const float rs = NORM ? rss[rl] : 1.f;
      const int cw = wn * 128 + quad_e * 32;
      if (EPI == EPI_G1A) {
        const int region = nt >> 2;
        bf16_t* xp = p.X + grow * 4096 + nt * 256 + cw;
#pragma unroll
        for (int c = 0; c < 4; ++c) {
          float v[8];
#pragma unroll
          for (int e = 0; e < 8; ++e) v[e] = acc[mi][2 * c + (e >> 2)][e & 3] * rs;
          if (region == 1 || region == 2) {
            float lb[8] = {0.f, 0.f, 0.f, 0.f, 0.f, 0.f, 0.f, 0.f};
            if (l == 1) {
              const float* l0p = p.lb_logits + (region - 1) * 1024 + ((nt * 256 + cw + c * 8) & 1023);
              const fl4 a0 = *(const fl4*)l0p, a1 = *(const fl4*)(l0p + 4);
              const fl4 b0 = *(const fl4*)(l0p + 2048), b1 = *(const fl4*)(l0p + 2052);
              lb[0] = sigmoidf_(b0.x - a0.x); lb[1] = sigmoidf_(b0.y - a0.y);
              lb[2] = sigmoidf_(b0.z - a0.z); lb[3] = sigmoidf_(b0.w - a0.w);
              lb[4] = sigmoidf_(b1.x - a1.x); lb[5] = sigmoidf_(b1.y - a1.y);
              lb[6] = sigmoidf_(b1.z - a1.z); lb[7] = sigmoidf_(b1.w - a1.w);
            }
#pragma unroll
            for (int e = 0; e < 8; ++e) {
              const float f = fmaxf(lb[e], 1e-30f) + (1.f - lb[e]) * sigmoidf_(v[e]);
              v[e] = __builtin_amdgcn_logf(f);
            }
          }
          *(u32x4*)(xp + c * 8) = MK4(pack2(v[0], v[1]), pack2(v[2], v[3]), pack2(v[4], v[5]), pack2(v[6], v[7]));
        }
      } else if (EPI == EPI_G1B) {
        if (nt < 8) {
          bf16_t* xp = p.X + grow * 2048 + nt * 256 + cw;
#pragma unroll
          for (int c = 0; c < 4; ++c)
            *(u32x4*)(xp + c * 8) = MK4(pack2(acc[mi][2 * c][0] * rs, acc[mi][2 * c][1] * rs), pack2(acc[mi][2 * c][2] * rs, acc[mi][2 * c][3] * rs),
                                        pack2(acc[mi][2 * c + 1][0] * rs, acc[mi][2 * c + 1][1] * rs), pack2(acc[mi][2 * c + 1][2] * rs, acc[mi][2 * c + 1][3] * rs));
        } else if (cw == 0) {
          bf16_t* rp = p.R + grow * 32;
#pragma unroll
          for (int c = 0; c < 4; ++c)
            *(u32x4*)(rp + c * 8) = MK4(pack2(acc[mi][2 * c][0] * rs, acc[mi][2 * c][1] * rs), pack2(acc[mi][2 * c][2] * rs, acc[mi][2 * c][3] * rs),
                                        pack2(acc[mi][2 * c + 1][0] * rs, acc[mi][2 * c + 1][1] * rs), pack2(acc[mi][2 * c + 1][2] * rs, acc[mi][2 * c + 1][3] * rs));
        }
      } else if (EPI == EPI_GATES) {
        const int uc = nt * 64 + wn * 32 + quad_e * 8;
        const u32x4 oa = *(const u32x4*)(p.O + grow * 2048 + uc);
        const u32x4 ob = *(const u32x4*)(p.O + grow * 2048 + 1024 + uc);
        const uint32_t oau[4] = {oa.x, oa.y, oa.z, oa.w}, obu[4] = {ob.x, ob.y, ob.z, ob.w};
        float u[8];
#pragma unroll
        for (int grp = 0; grp < 2; ++grp)
#pragma unroll
          for (int r = 0; r < 4; ++r) {
            const int idx = grp * 4 + r;
            const float ga = acc[mi][grp * 4 + 0][r] * rs, ma = acc[mi][grp * 4 + 1][r] * rs;
            const float gb = acc[mi][grp * 4 + 2][r] * rs, mb = acc[mi][grp * 4 + 3][r] * rs;
            const float ona = (idx & 1) ? __uint_as_float(oau[idx >> 1] & 0xffff0000u) : __uint_as_float(oau[idx >> 1] << 16);
            const float onb = (idx & 1) ? __uint_as_float(obu[idx >> 1] & 0xffff0000u) : __uint_as_float(obu[idx >> 1] << 16);
            u[idx] = sigmoidf_(ma) * (ga * sigmoidf_(ga)) * ona + sigmoidf_(mb) * (gb * sigmoidf_(gb)) * onb;
          }
        *(u32x4*)(p.X + tiled_off(grow, uc, 1024)) = MK4(pack2(u[0], u[1]), pack2(u[2], u[3]), pack2(u[4], u[5]), pack2(u[6], u[7]));
      } else if (EPI == EPI_WOUT || EPI == EPI_DOWN) {
        const bool meta = (mt == 128);
        if (!meta || rl < nvalid_meta) {
          const float* hin; float* hout;
          if (meta) { hout = p.hmeta + ((size_t)g * 128 + rl) * 1024; hin = hout; }
          else {
            const size_t trow = (size_t)mt * 128 + rl;
            hout = p.out + ((size_t)g * NTOKG + trow) * 1024;
            hin = (EPI == EPI_WOUT && l == 0) ? p.x[g] + trow * 1024 : hout;
          }
          const int col0 = nt * 256 + cw;
          bf16_t* hb = p.HB + tiled_off(grow, col0, 1024);
#pragma unroll
          for (int c = 0; c < 4; ++c) {
            const fl4 h0 = *(const fl4*)(hin + col0 + c * 8), h1 = *(const fl4*)(hin + col0 + c * 8 + 4);
            const fl4 o0 = MKF4(h0.x + acc[mi][2 * c][0], h0.y + acc[mi][2 * c][1], h0.z + acc[mi][2 * c][2], h0.w + acc[mi][2 * c][3]);
            const fl4 o1 = MKF4(h1.x + acc[mi][2 * c + 1][0], h1.y + acc[mi][2 * c + 1][1], h1.z + acc[mi][2 * c + 1][2], h1.w + acc[mi][2 * c + 1][3]);
            *(fl4*)(hout + col0 + c * 8) = o0;
            *(fl4*)(hout + col0 + c * 8 + 4) = o1;
            *(u32x4*)(hb + c * 8) = MK4(pack2(o0.x, o0.y), pack2(o0.z, o0.w), pack2(o1.x, o1.y), pack2(o1.z, o1.w));
          }
        }
      } else if (EPI == EPI_UP) {
        bf16_t* xp = p.X + tiled_off(grow, nt * 256 + cw, 4096);
#pragma unroll
        for (int c = 0; c < 4; ++c) {
          float v[8];
#pragma unroll
          for (int e = 0; e < 8; ++e) { const float a = fmaxf(acc[mi][2 * c + (e >> 2)][e & 3] * rs, 0.f); v[e] = a * a; }
          *(u32x4*)(xp + c * 8) = MK4(pack2(v[0], v[1]), pack2(v[2], v[3]), pack2(v[4], v[5]), pack2(v[6], v[7]));
        }
      }
    }
    }
  }
}

template <int MIX, int PASS>
__device__ __forceinline__ void scan_phase(const Params& p, int l, int g, char* smem) {
  constexpr int NH = MIX ? 4 : 8;
  constexpr int NDV = MIX ? 4 : 2;
  constexpr int XLD = MIX ? 2048 : 4096;
  bf16_t* QS = (bf16_t*)smem;
  bf16_t* KS = QS + 64 * 136;
  bf16_t* KT = KS + 64 * 136;
  bf16_t* LG = KT;
  bf16_t* Pm = QS;
  bf16_t* SmT = KS;
  bf16_t* VT = KT + 128 * 72;
  bf16_t* RS = VT + 64 * 72;
  float* em = (float*)(RS + 64 * 24);
  float* el = em + 128;
  float* tot = el + 128;
  const int bid_ = opaque_bid();
  const int t_outer = opaque_tid(smem);
  const int sps = g == 0 ? 16 : 4;
  constexpr bool do_out = (PASS == 3);
  const bf16_t* Xg = p.X;

  for (int item = bid_; item < 512; item += gridDim.x) {
    int t = t_outer;
    asm volatile("" : "+v"(t));
    const int lane = t & 63, w = t >> 6, quad = lane >> 4, l15 = lane & 15;
    const int dir = item & 1;
    const int dvb = (item >> 1) % NDV;
    const int head = ((item >> 1) / NDV) % NH;
    const int seg = item >> 5;
    const int seq = seg / sps;
    const bool first = (seg % sps) == 0;
    const int nsteps = 16 + (first ? 1 : 0);
    int qcol, kcol, vcol;
    bf16_t* Og; int OLD;
    if (MIX == 0) {
      qcol = head * 128; kcol = 1024 + dir * 1024 + head * 128; vcol = 3072 + head * 128 + dvb * 64;
      Og = p.O + dir * 1024 + head * 128 + dvb * 64; OLD = 2048;
    } else {
      qcol = head * 128; kcol = 512 + head * 128; vcol = 1024 + head * 256 + dvb * 64;
      Og = p.X + (size_t)MROWS * 2048 + (size_t)dir * MROWS * 1024 + head * 256 + dvb * 64; OLD = 1024;
    }
    bf16x8 wgf[2]; float bgv[2][4];
    if (MIX == 1) {
#pragma unroll
      for (int ct = 0; ct < 2; ++ct) {
        const int cc = 16 * (2 * w + ct) + l15;
        bf16x8 v = (bf16x8){0, 0, 0, 0, 0, 0, 0, 0};
        if (quad < 2) {
#pragma unroll
          for (int e = 0; e < 8; ++e)
            v[e] = (short)f2bf(p.w_gate[((size_t)(l * 2 + dir) * 16 + quad * 8 + e) * 512 + head * 128 + cc]);
        }
        wgf[ct] = v;
#pragma unroll
        for (int r = 0; r < 4; ++r) bgv[ct][r] = p.b_gate[(l * 2 + dir) * 512 + head * 128 + 16 * (2 * w + ct) + quad * 4 + r];
      }
    }
    f32x4 S[8];
#pragma unroll
    for (int a = 0; a < 8; ++a) S[a] = (f32x4){0.f, 0.f, 0.f, 0.f};
    if (do_out) {
      int s2 = dir == 0 ? seq * sps : seq * sps + sps - 1;
      const int stp = dir == 0 ? 1 : -1;
      for (; s2 != seg; s2 += stp) {
        const int item2 = ((s2 * NH + head) * NDV + dvb) * 2 + dir;
        const bf16_t* L = p.ST + (size_t)item2 * 8192;
        const float* G = p.GD + ((s2 * 8 + head) * 2 + dir) * 128;
#pragma unroll
        for (int a = 0; a < 8; ++a)
#pragma unroll
          for (int r = 0; r < 4; ++r) {
            const int k = 16 * (2 * w + (a >> 2)) + quad * 4 + r;
            S[a][r] = __builtin_amdgcn_exp2f(G[k]) * S[a][r] + bf2f(L[(a * 4 + r) * 256 + t]);
          }
      }
    }
    float gacc0 = 0.f, gacc1 = 0.f;

    u32x4 qr[4], kr[4], vr[2], rr;
    auto step_rows = [&](int s, int& rowbase, int& nv) {
      bool meta;
      if (dir == 0) { meta = first && s == 0; rowbase = (seg * 16 + s - (first ? 1 : 0)) * 64; }
      else { meta = (s == 16); rowbase = (seg * 16 + 15 - s) * 64; }
      if (meta) { rowbase = NTOKG + seq * 16; nv = 16; } else nv = 64;
    };
    const char* Xq = (const char*)(Xg + qcol);
    const char* Xk = (const char*)(Xg + kcol);
    const char* Xv = (const char*)(Xg + vcol);
    const char* Rb = (const char*)(p.R + dir * 16);
    auto gload = [&](int s) {
      int rowbase, nv; step_rows(s, rowbase, nv);
#pragma unroll
      for (int j = 0; j < 4; ++j) {
        const int i = (t >> 4) + 16 * j;
        const int mr = dir ? rowbase + nv - 1 - i : rowbase + i;
        u32x4 z = MK4(0, 0, 0, 0);
        if (i < nv) {
          const uint32_t vo = (uint32_t)(mr * XLD + (t & 15) * 8) * 2u;
          qr[j] = do_out ? *(const u32x4*)(Xq + vo) : z;
          kr[j] = *(const u32x4*)(Xk + vo);
        } else { qr[j] = z; kr[j] = z; }
      }
      {
        const int i = t >> 2;
        const int mr = dir ? rowbase + nv - 1 - i : rowbase + i;
        vr[0] = MK4(0, 0, 0, 0); vr[1] = vr[0];
        if (i < nv) {
          const uint32_t vo = (uint32_t)(mr * XLD + (t & 3) * 16) * 2u;
          vr[0] = *(const u32x4*)(Xv + vo); vr[1] = *(const u32x4*)(Xv + vo + 16);
        }
      }
      if (MIX == 1) {
        rr = MK4(0, 0, 0, 0);
        if (t < 128) {
          const int i = t >> 1;
          const int mr = dir ? rowbase + nv - 1 - i : rowbase + i;
          if (i < nv) rr = *(const u32x4*)(Rb + (uint32_t)(mr * 32 + (t & 1) * 8) * 2u);
        }
      }
    };
    gload(0);

    for (int s = 0; s < nsteps; ++s) {
      int rowbase, nv; step_rows(s, rowbase, nv);
#pragma unroll
      for (int j = 0; j < 4; ++j) {
        const int i = (t >> 4) + 16 * j;
        if (do_out) *(u32x4*)(QS + i * 136 + (t & 15) * 8) = qr[j];
        *(u32x4*)(KS + i * 136 + (t & 15) * 8) = kr[j];
      }
      {
        const int i = t >> 2, piece = t & 3;
        uint32_t vv[8] = {vr[0].x, vr[0].y, vr[0].z, vr[0].w, vr[1].x, vr[1].y, vr[1].z, vr[1].w};
        bf16_t* vtw = VT + piece * 16 * 72 + i;
#pragma unroll
        for (int e = 0; e < 16; ++e) vtw[e * 72] = (bf16_t)((vv[e >> 1] >> ((e & 1) * 16)) & 0xffffu);
      }
      if (MIX == 1 && t < 128) *(u32x4*)(RS + (t >> 1) * 24 + (t & 1) * 8) = rr;
      if (s + 1 < nsteps) gload(s + 1);
      __syncthreads();
      if (MIX == 1) {
        bf16x8 af[4];
#pragma unroll
        for (int it = 0; it < 4; ++it) {
          af[it] = (bf16x8){0, 0, 0, 0, 0, 0, 0, 0};
          if (quad < 2) af[it] = *(const bf16x8*)(RS + (16 * it + l15) * 24 + quad * 8);
        }
#pragma unroll
        for (int ct = 0; ct < 2; ++ct)
#pragma unroll
          for (int it = 0; it < 4; ++it) {
            f32x4 z = __builtin_amdgcn_mfma_f32_16x16x32_bf16(wgf[ct], af[it], (f32x4){0.f, 0.f, 0.f, 0.f}, 0, 0, 0);
            float ls[4];
#pragma unroll
            for (int r = 0; r < 4; ++r) {
              const float zz = fmaxf(z[r] + bgv[ct][r], -80.f);
              ls[r] = __builtin_amdgcn_logf(1.f + __builtin_amdgcn_exp2f(zz * -1.4426950408889634f)) * -0.0625f;
            }
            *(u32x2*)(LG + (16 * it + l15) * 128 + 16 * (2 * w + ct) + quad * 4) = MK2(pack2(ls[0], ls[1]), pack2(ls[2], ls[3]));
          }
        __syncthreads();
      }
      const int cp = t & 63, rg = t >> 6;
      const int nvl = nv - 16 * rg;
      float p0[16], p1[16];
      {
        float run0 = 0.f, run1 = 0.f;
        constexpr int LFS32 = (MIX == 0) ? 68 : 64;
        const uint32_t* lfp = (const uint32_t*)((MIX == 0) ? (KS + 16 * rg * 136) : (LG + 16 * rg * 128)) + cp;
#pragma unroll
        for (int ii = 0; ii < 16; ++ii) {
          if ((ii & 7) == 0) __builtin_amdgcn_sched_barrier(0);
          const uint32_t u = lfp[ii * LFS32];
          float l0 = __uint_as_float(u << 16), l1 = __uint_as_float(u & 0xffff0000u);
          if (ii >= nvl) { l0 = 0.f; l1 = 0.f; }
          run0 += l0; run1 += l1;
          p0[ii] = run0; p1[ii] = run1;
        }
        *(float2*)(tot + rg * 128 + 2 * cp) = make_float2(run0, run1);
      }
      __syncthreads();
      {
        const float2 ta = *(const float2*)(tot + 2 * cp), tb = *(const float2*)(tot + 128 + 2 * cp);
        const float2 tc = *(const float2*)(tot + 256 + 2 * cp), td = *(const float2*)(tot + 384 + 2 * cp);
        const float m0 = ta.x + tb.x, m1 = ta.y + tb.y;
        const float base0 = (rg > 0 ? ta.x : 0.f) + (rg > 1 ? tb.x : 0.f) + (rg > 2 ? tc.x : 0.f);
        const float base1 = (rg > 0 ? ta.y : 0.f) + (rg > 1 ? tb.y : 0.f) + (rg > 2 ? tc.y : 0.f);
        uint32_t* qp = (uint32_t*)(QS + 16 * rg * 136) + cp;
        uint32_t* kp = (uint32_t*)(KS + 16 * rg * 136) + cp;
        float skp0 = __builtin_amdgcn_exp2f(-fminf(fmaxf(base0 - m0, -115.f), 115.f));
        float skp1 = __builtin_amdgcn_exp2f(-fminf(fmaxf(base1 - m1, -115.f), 115.f));
        uint32_t kt0[8], kt1[8], kkprev = 0;
#pragma unroll
        for (int ii = 0; ii < 16; ++ii) {
          if ((ii & 3) == 0) __builtin_amdgcn_sched_barrier(0);
          const float e0 = fminf(fmaxf(base0 + p0[ii] - m0, -115.f), 115.f);
          const float e1 = fminf(fmaxf(base1 + p1[ii] - m1, -115.f), 115.f);
          const float sq0 = __builtin_amdgcn_exp2f(e0), sq1 = __builtin_amdgcn_exp2f(e1);
          const float sk0 = __builtin_amdgcn_rcpf(sq0), sk1 = __builtin_amdgcn_rcpf(sq1);
          if (do_out) {
            const uint32_t uq = qp[ii * 68];
            qp[ii * 68] = pack2(__uint_as_float(uq << 16) * sq0, __uint_as_float(uq & 0xffff0000u) * sq1);
          }
          float k0, k1;
          if (MIX == 0) { k0 = 1.f - sq0 * skp0; k1 = 1.f - sq1 * skp1; skp0 = sk0; skp1 = sk1; }
          else { const uint32_t uk = kp[ii * 68]; k0 = __uint_as_float(uk << 16); k1 = __uint_as_float(uk & 0xffff0000u); }
          const uint32_t kk = pack2(k0 * sk0, k1 * sk1);
          if (do_out) kp[ii * 68] = kk;
          if (ii & 1) {
            kt0[ii >> 1] = __builtin_amdgcn_perm(kk, kkprev, 0x05040100u);
            kt1[ii >> 1] = __builtin_amdgcn_perm(kk, kkprev, 0x07060302u);
          } else kkprev = kk;
        }
        u32x4* kd0 = (u32x4*)(KT + (2 * cp) * 72 + 16 * rg);
        u32x4* kd1 = (u32x4*)(KT + (2 * cp + 1) * 72 + 16 * rg);
        kd0[0] = MK4(kt0[0], kt0[1], kt0[2], kt0[3]); kd0[1] = MK4(kt0[4], kt0[5], kt0[6], kt0[7]);
        kd1[0] = MK4(kt1[0], kt1[1], kt1[2], kt1[3]); kd1[1] = MK4(kt1[4], kt1[5], kt1[6], kt1[7]);
        if (rg == 0) {
          *(float2*)(em + 2 * cp) = make_float2(__builtin_amdgcn_exp2f(m0), __builtin_amdgcn_exp2f(m1));
          *(float2*)(el + 2 * cp) = make_float2(__builtin_amdgcn_exp2f(tc.x + td.x), __builtin_amdgcn_exp2f(tc.y + td.y));
        }
        gacc0 += m0 + tc.x + td.x; gacc1 += m1 + tc.y + td.y;
      }
      __syncthreads();
      if (do_out) {
        bf16x8 qf[4];
#pragma unroll
        for (int ks = 0; ks < 4; ++ks) qf[ks] = *(const bf16x8*)(QS + (16 * w + l15) * 136 + ks * 32 + quad * 8);
        f32x4 pa[4];
#pragma unroll
        for (int jt = 0; jt < 4; ++jt) {
          pa[jt] = (f32x4){0.f, 0.f, 0.f, 0.f};
          if (jt <= w) {
#pragma unroll
            for (int ks = 0; ks < 4; ++ks) {
              bf16x8 kf = *(const bf16x8*)(KS + (16 * jt + l15) * 136 + ks * 32 + quad * 8);
              pa[jt] = __builtin_amdgcn_mfma_f32_16x16x32_bf16(kf, qf[ks], pa[jt], 0, 0, 0);
            }
          }
        }
        __syncthreads();
        {
          const int i = 16 * w + l15;
          bf16_t* pw = Pm + i * 72 + quad * 4;
#pragma unroll
          for (int jt = 0; jt < 4; ++jt) {
            const int j0 = 16 * jt + quad * 4;
            float pv[4];
#pragma unroll
            for (int r = 0; r < 4; ++r) pv[r] = (jt <= w && j0 + r <= i) ? pa[jt][r] : 0.f;
            *(u32x2*)(pw + 16 * jt) = MK2(pack2(pv[0], pv[1]), pack2(pv[2], pv[3]));
          }
        }
#pragma unroll
        for (int a = 0; a < 8; ++a) {
          const int k0 = 16 * (2 * w + (a >> 2)) + quad * 4;
          const int v = 16 * (a & 3) + l15;
          const fl4 e = *(const fl4*)(em + k0);
          S[a][0] *= e.x; S[a][1] *= e.y; S[a][2] *= e.z; S[a][3] *= e.w;
          *(u32x2*)(SmT + v * 136 + k0) = MK2(pack2(S[a][0], S[a][1]), pack2(S[a][2], S[a][3]));
        }
        __syncthreads();
        f32x4 oa[4];
#pragma unroll
        for (int vt = 0; vt < 4; ++vt) {
          oa[vt] = (f32x4){0.f, 0.f, 0.f, 0.f};
#pragma unroll
          for (int ks = 0; ks < 4; ++ks) {
            bf16x8 sf = *(const bf16x8*)(SmT + (16 * vt + l15) * 136 + ks * 32 + quad * 8);
            oa[vt] = __builtin_amdgcn_mfma_f32_16x16x32_bf16(sf, qf[ks], oa[vt], 0, 0, 0);
          }
        }
#pragma unroll
        for (int js = 0; js < 2; ++js) {
          bf16x8 pfr = *(const bf16x8*)(Pm + (16 * w + l15) * 72 + js * 32 + quad * 8);
#pragma unroll
          for (int vt = 0; vt < 4; ++vt) {
            bf16x8 vf = *(const bf16x8*)(VT + (16 * vt + l15) * 72 + js * 32 + quad * 8);
            oa[vt] = __builtin_amdgcn_mfma_f32_16x16x32_bf16(vf, pfr, oa[vt], 0, 0, 0);
          }
        }
        {
          const int i = 16 * w + l15;
          if (i < nv) {
            const int mr = dir ? rowbase + nv - 1 - i : rowbase + i;
            bf16_t* op = (bf16_t*)((char*)Og + (uint32_t)(mr * OLD + quad * 4) * 2u);
#pragma unroll
            for (int vt = 0; vt < 4; ++vt) *(u32x2*)(op + 16 * vt) = MK2(pack2(oa[vt][0], oa[vt][1]), pack2(oa[vt][2], oa[vt][3]));
          }
        }
      } else {
#pragma unroll
        for (int a = 0; a < 8; ++a) {
          const int k0 = 16 * (2 * w + (a >> 2)) + quad * 4;
          const fl4 e = *(const fl4*)(em + k0);
          S[a][0] *= e.x; S[a][1] *= e.y; S[a][2] *= e.z; S[a][3] *= e.w;
        }
      }
#pragma unroll
      for (int js = 0; js < 2; ++js) {
        bf16x8 kf[2];
#pragma unroll
        for (int ktl = 0; ktl < 2; ++ktl) kf[ktl] = *(const bf16x8*)(KT + (16 * (2 * w + ktl) + l15) * 72 + js * 32 + quad * 8);
#pragma unroll
        for (int vt = 0; vt < 4; ++vt) {
          bf16x8 vf = *(const bf16x8*)(VT + (16 * vt + l15) * 72 + js * 32 + quad * 8);
#pragma unroll
          for (int ktl = 0; ktl < 2; ++ktl)
            S[ktl * 4 + vt] = __builtin_amdgcn_mfma_f32_16x16x32_bf16(kf[ktl], vf, S[ktl * 4 + vt], 0, 0, 0);
        }
      }
#pragma unroll
      for (int a = 0; a < 8; ++a) {
        const int k0 = 16 * (2 * w + (a >> 2)) + quad * 4;
        const fl4 e = *(const fl4*)(el + k0);
        S[a][0] *= e.x; S[a][1] *= e.y; S[a][2] *= e.z; S[a][3] *= e.w;
      }
      __syncthreads();
    }
    if (!do_out) {
      bf16_t* L = p.ST + (size_t)item * 8192;
#pragma unroll
      for (int a = 0; a < 8; ++a)
#pragma unroll
        for (int r = 0; r < 4; ++r) L[(a * 4 + r) * 256 + t] = f2bf(S[a][r]);
      if (dvb == 0 && t < 64) *(float2*)(p.GD + ((seg * 8 + head) * 2 + dir) * 128 + 2 * t) = make_float2(gacc0, gacc1);
    }
  }
}

__device__ __forceinline__ void phase_hn(const Params& p, int l, char* smem) {
  const int bid_ = opaque_bid();
  const int t = opaque_tid(smem), lane = t & 63, w = t >> 6;
  const bf16_t* Y1 = p.X + (size_t)MROWS * 2048;
  const bf16_t* Y2 = Y1 + (size_t)MROWS * 1024;
  for (int row = bid_ * 4 + w; row < MROWS; row += gridDim.x * 4) {
    bf16_t* oa = p.O + (size_t)row * 2048 + lane * 16;
    float xa[16], xb[16];
    {
      u32x4 a0 = *(const u32x4*)(oa), a1 = *(const u32x4*)(oa + 8);
      u32x4 b0 = *(const u32x4*)(oa + 1024), b1 = *(const u32x4*)(oa + 1032);
      uint32_t ua[8] = {a0.x, a0.y, a0.z, a0.w, a1.x, a1.y, a1.z, a1.w};
      uint32_t ub[8] = {b0.x, b0.y, b0.z, b0.w, b1.x, b1.y, b1.z, b1.w};
#pragma unroll
      for (int e = 0; e < 8; ++e) {
        xa[2 * e] = __uint_as_float(ua[e] << 16) + __uint_as_float(ub[e] << 16);
        xa[2 * e + 1] = __uint_as_float(ua[e] & 0xffff0000u) + __uint_as_float(ub[e] & 0xffff0000u);
      }
      const bf16_t* y1 = Y1 + (size_t)row * 1024 + lane * 16;
      const bf16_t* y2 = Y2 + (size_t)row * 1024 + lane * 16;
      u32x4 c0 = *(const u32x4*)(y1), c1 = *(const u32x4*)(y1 + 8);
      u32x4 d0 = *(const u32x4*)(y2), d1 = *(const u32x4*)(y2 + 8);
      uint32_t uc[8] = {c0.x, c0.y, c0.z, c0.w, c1.x, c1.y, c1.z, c1.w};
      uint32_t ud[8] = {d0.x, d0.y, d0.z, d0.w, d1.x, d1.y, d1.z, d1.w};
#pragma unroll
      for (int e = 0; e < 8; ++e) {
        xb[2 * e] = __uint_as_float(uc[e] << 16) + __uint_as_float(ud[e] << 16);
        xb[2 * e + 1] = __uint_as_float(uc[e] & 0xffff0000u) + __uint_as_float(ud[e] & 0xffff0000u);
      }
    }
    float sa = 0.f, sb = 0.f;
#pragma unroll
    for (int e = 0; e < 16; ++e) { sa += xa[e] * xa[e]; sb += xb[e] * xb[e]; }
    sa += shx<1>(sa, lane); sa += shx<2>(sa, lane); sa += shx<4>(sa, lane);
    sb += shx<1>(sb, lane); sb += shx<2>(sb, lane); sb += shx<4>(sb, lane); sb += shx<8>(sb, lane);
    const float ra = rsqrtf(sa * (1.f / 128.f) + 1e-6f);
    const float rb = rsqrtf(sb * (1.f / 256.f) + 1e-6f);
    const float* na = p.norm_a + l * 1024 + lane * 16;
    const float* nb = p.norm_b + l * 1024 + lane * 16;
    uint32_t pa[8], pb[8];
#pragma unroll
    for (int e = 0; e < 8; ++e) {
      pa[e] = pack2(xa[2 * e] * ra * na[2 * e], xa[2 * e + 1] * ra * na[2 * e + 1]);
      pb[e] = pack2(xb[2 * e] * rb * nb[2 * e], xb[2 * e + 1] * rb * nb[2 * e + 1]);
    }
    *(u32x4*)(oa) = MK4(pa[0], pa[1], pa[2], pa[3]);
    *(u32x4*)(oa + 8) = MK4(pa[4], pa[5], pa[6], pa[7]);
    *(u32x4*)(oa + 1024) = MK4(pb[0], pb[1], pb[2], pb[3]);
    *(u32x4*)(oa + 1032) = MK4(pb[4], pb[5], pb[6], pb[7]);
  }
}

__device__ __forceinline__ void phase_final(const Params& p, char* smem) {
  const int bid_ = opaque_bid();
  const int t = opaque_tid(smem), lane = t & 63, w = t >> 6;
  for (int row = bid_ * 4 + w; row < 2 * NTOKG; row += gridDim.x * 4) {
    float* hp = p.out + (size_t)row * 1024;
    fl4 v[4];
    float s = 0.f;
#pragma unroll
    for (int j = 0; j < 4; ++j) {
      v[j] = *(const fl4*)(hp + j * 256 + lane * 4);
      s += v[j].x * v[j].x + v[j].y * v[j].y + v[j].z * v[j].z + v[j].w * v[j].w;
    }
    s += shx<1>(s, lane); s += shx<2>(s, lane); s += shx<4>(s, lane);
    s += shx<8>(s, lane); s += shx<16>(s, lane); s += shx<32>(s, lane);
    const float rs = rsqrtf(s * (1.f / 1024.f) + 1e-6f);
#pragma unroll
    for (int j = 0; j < 4; ++j) {
      const fl4 gn = *(const fl4*)(p.final_norm + j * 256 + lane * 4);
      fl4 o = MKF4(v[j].x * rs * gn.x, v[j].y * rs * gn.y, v[j].z * rs * gn.z, v[j].w * rs * gn.w);
      *(fl4*)(hp + j * 256 + lane * 4) = o;
    }
  }
}

__device__ __forceinline__ void phase_xcvt(const Params& p, int g, char* smem) {
  const int bid_ = opaque_bid();
  const int t = opaque_tid(smem);
  for (int idx = bid_ * 256 + t; idx < MROWS * 128; idx += gridDim.x * 256) {
    const int row = idx >> 7, c8 = idx & 127;
    const float* src = row < NTOKG ? p.x[g] + (size_t)row * 1024 + c8 * 8 : p.hmeta + ((size_t)g * 128 + (row - NTOKG)) * 1024 + c8 * 8;
    const fl4 a = *(const fl4*)src, b = *(const fl4*)(src + 4);
    *(u32x4*)(p.HB + tiled_off((size_t)row, c8 * 8, 1024)) = MK4(pack2(a.x, a.y), pack2(a.z, a.w), pack2(b.x, b.y), pack2(b.z, b.w));
  }
}

__device__ __forceinline__ void run_phase(const Params& p, int ph, char* smem) {
  if (ph == 0) { phase_init(p, smem); return; }
  if (ph == NPHASES - 1) { phase_final(p, smem); return; }
  const int q = ph - 1;
  const int g = q / 23, r = q % 23;
  if (r == 0) { phase_xcvt(p, g, smem); return; }
  const int l = (r - 1) / 11, st = (r - 1) % 11;
  switch (st) {
    case 0: gemm_phase<EPI_G1A>(p, l, g, smem); break;
    case 1: scan_phase<0, 1>(p, l, g, smem); break;
    case 2: scan_phase<0, 3>(p, l, g, smem); break;
    case 3: gemm_phase<EPI_G1B>(p, l, g, smem); break;
    case 4: scan_phase<1, 1>(p, l, g, smem); break;
    case 5: scan_phase<1, 3>(p, l, g, smem); break;
    case 6: phase_hn(p, l, smem); break;
    case 7: gemm_phase<EPI_GATES>(p, l, g, smem); break;
    case 8: gemm_phase<EPI_WOUT>(p, l, g, smem); break;
    case 9: gemm_phase<EPI_UP>(p, l, g, smem); break;
    default: gemm_phase<EPI_DOWN>(p, l, g, smem); break;
  }
}

template <int ST>
__global__ void __launch_bounds__(256, 2) pk(Params p, int l, int g) {
  extern __shared__ __attribute__((aligned(16))) char smem[];
  if (ST == 100) phase_init(p, smem);
  else if (ST == 101) phase_final(p, smem);
  else if (ST == 102) phase_xcvt(p, g, smem);
  else if (ST == 0) gemm_phase<EPI_G1A>(p, l, g, smem);
  else if (ST == 1) scan_phase<0, 1>(p, l, g, smem);
  else if (ST == 2) scan_phase<0, 3>(p, l, g, smem);
  else if (ST == 3) gemm_phase<EPI_G1B>(p, l, g, smem);
  else if (ST == 4) scan_phase<1, 1>(p, l, g, smem);
  else if (ST == 5) scan_phase<1, 3>(p, l, g, smem);
  else if (ST == 6) phase_hn(p, l, smem);
  else if (ST == 7) gemm_phase<EPI_GATES>(p, l, g, smem);
  else if (ST == 8) gemm_phase<EPI_WOUT>(p, l, g, smem);
  else if (ST == 9) gemm_phase<EPI_UP>(p, l, g, smem);
  else gemm_phase<EPI_DOWN>(p, l, g, smem);
}


#define XB_TMO      128
#define XB_XCNT(j)  (256  + 64 * (j))
#define XB_XSUB(j)  (1280 + 64 * (j))
#define XB_XGEN(j)  (2304 + 64 * (j))
#define XB_TOP      3328
#define XB_TOPGEN   3392
#define XCD_BAR_WORDS 3456
#define XB_SPIN_CAP (1u << 22)
#define LAS __attribute__((address_space(3)))
__device__ __forceinline__ unsigned xb_ld(unsigned* p)              { return __hip_atomic_load(p, __ATOMIC_RELAXED, __HIP_MEMORY_SCOPE_AGENT); }
__device__ __forceinline__ unsigned xb_add(unsigned* p, unsigned v) { return __hip_atomic_fetch_add(p, v, __ATOMIC_RELAXED, __HIP_MEMORY_SCOPE_AGENT); }
__device__ __forceinline__ unsigned xb_xcc_id() { return (unsigned)__builtin_amdgcn_s_getreg((3 << 11) | 20) & 0xFu; }
#define XB_SPIN(cond, bar) do { unsigned _sp = 0; while (cond) { __builtin_amdgcn_s_sleep(1); \
    if ((++_sp & 255u) == 0u) { if (xb_ld(&(bar)[XB_TMO])) break; if (_sp > XB_SPIN_CAP) { atomicAdd(&(bar)[XB_TMO], 1u); break; } } } } while (0)

__device__ __forceinline__ void xcd_barrier_complete(unsigned* bar, unsigned x, unsigned& nloc, unsigned& nx) {
  const unsigned G = gridDim.x * gridDim.y * gridDim.z;
  unsigned sum, cnt, mine, sp = 0u;
  for (;;) {
    sum = 0u; cnt = 0u; mine = 0u;
#pragma unroll
    for (unsigned j = 0; j < 16; ++j) { const unsigned c = xb_ld(&bar[XB_XCNT(j)]); sum += c; cnt += (c > 0u) ? 1u : 0u; mine = (j == x) ? c : mine; }
    if (sum == G) break;
    __builtin_amdgcn_s_sleep(1);
    if ((++sp & 255u) == 0u) { if (xb_ld(&bar[XB_TMO])) break; if (sp > XB_SPIN_CAP) { atomicAdd(&bar[XB_TMO], 1u); break; } }
  }
  nloc = mine > 0u ? mine : 1u; nx = cnt > 0u ? cnt : 1u;
}

__device__ __forceinline__ void xcd_barrier(unsigned* bar, volatile LAS unsigned* st, bool leader_thread) {
  asm volatile("s_waitcnt vmcnt(0)" ::: "memory");
  __syncthreads();
  if (leader_thread) {
    const unsigned x = xb_xcc_id();
    __builtin_amdgcn_s_waitcnt(0);
    unsigned nloc = st[0], nx = st[1];
    if (nloc == 0u) { xcd_barrier_complete(bar, x, nloc, nx); st[0] = nloc; st[1] = nx; }
    const unsigned old = xb_add(&bar[XB_XSUB(x)], 1u);
    const unsigned gen = old / nloc;
    if (old + 1u == (gen + 1u) * nloc) {
      __builtin_amdgcn_fence(__ATOMIC_RELEASE, "agent");
      asm volatile("s_waitcnt vmcnt(0)" ::: "memory");
      const unsigned og = xb_add(&bar[XB_TOP], 1u);
      const unsigned tg = og / nx;
      if (og + 1u == (tg + 1u) * nx) xb_add(&bar[XB_TOPGEN], 1u);
      else XB_SPIN(xb_ld(&bar[XB_TOPGEN]) == tg, bar);
      __builtin_amdgcn_fence(__ATOMIC_ACQUIRE, "agent");
      xb_add(&bar[XB_XGEN(x)], 1u);
      asm volatile("s_waitcnt vmcnt(0)" ::: "memory");
    } else {
      XB_SPIN(xb_ld(&bar[XB_XGEN(x)]) == gen, bar);
      __builtin_amdgcn_fence(__ATOMIC_ACQUIRE, "agent");
      asm volatile("s_waitcnt vmcnt(0)" ::: "memory");
    }
  }
  __syncthreads();
}

#ifndef MULTI_LAUNCH
__global__ void __launch_bounds__(256, 2) mega(Params p, int plo, int phi, int coop) {
  extern __shared__ __attribute__((aligned(16))) char smem[];
  volatile LAS unsigned* st = (volatile LAS unsigned*)(smem + LDS_BYTES + 16);
  {
    const int t0 = opaque_tid(smem);
    if (t0 == 0) { st[0] = 0u; st[1] = 0u; (void)xb_add(&p.bar[XB_XCNT(xb_xcc_id())], 1u); }
    __syncthreads();
  }
  for (int ph = plo; ph < phi; ++ph) {
    run_phase(p, ph, smem);
    if (coop && ph + 1 < phi) {
      if (ph == 0) cg::this_grid().sync();
      else { const int tb = opaque_tid(smem); xcd_barrier(p.bar, st, tb == 0); }
    }
  }
}

#endif

static inline size_t align_up(size_t x) { return (x + 255) & ~(size_t)255; }

extern "C" void kernel_launch(void* const* d_in, const int* in_sizes, int n_in,
                              void* d_out, int out_size, void* d_ws, size_t ws_size,
                              hipStream_t stream) {
  Params p{};
  p.x[0] = (const float*)d_in[0];
  p.x[1] = (const float*)d_in[1];
  p.meta = (const float*)d_in[2];
  p.attn_norm = (const float*)d_in[3];
  p.w_in = (const float*)d_in[4];
  p.lb_logits = (const float*)d_in[5];
  p.w_gate = (const float*)d_in[6];
  p.b_gate = (const float*)d_in[7];
  p.norm_a = (const float*)d_in[8];
  p.norm_b = (const float*)d_in[9];
  p.w_out = (const float*)d_in[10];
  p.mlp_norm = (const float*)d_in[11];
  p.w_up = (const float*)d_in[12];
  p.w_down = (const float*)d_in[13];
  p.final_norm = (const float*)d_in[14];
  p.out = (float*)d_out;
  char* ws = (char*)d_ws;
  size_t off = 0;
  p.W = (bf16_t*)(ws + off); off = align_up(off + (size_t)2 * LSTRIDE * 2);
  p.X = (bf16_t*)(ws + off); off = align_up(off + (size_t)MROWS * 4096 * 2);
  p.R = (bf16_t*)(ws + off); off = align_up(off + (size_t)MROWS * 32 * 2);
  p.O = (bf16_t*)(ws + off); off = align_up(off + (size_t)MROWS * 2048 * 2);
  p.HB = (bf16_t*)(ws + off); off = align_up(off + (size_t)MROWS * 1024 * 2);
  p.ST = (bf16_t*)(ws + off); off = align_up(off + (size_t)512 * 8192 * 2);
  p.GD = (float*)(ws + off); off = align_up(off + (size_t)16 * 8 * 2 * 128 * 4);
  p.hmeta = (float*)(ws + off); off = align_up(off + (size_t)2 * 128 * 1024 * 4);
  p.bar = (unsigned*)(ws + off); off = align_up(off + (size_t)XCD_BAR_WORDS * 4);
  if (off > ws_size) { fprintf(stderr, "workspace too small: need %zu have %zu\n", off, ws_size); return; }

#ifdef MULTI_LAUNCH
#define LAUNCH_PK(ST, l, g) do { \
    static bool attr_set_##ST = false; \
    if (!attr_set_##ST) { (void)hipFuncSetAttribute((const void*)pk<ST>, hipFuncAttributeMaxDynamicSharedMemorySize, LDS_BYTES + 32); attr_set_##ST = true; } \
    hipLaunchKernelGGL(pk<ST>, dim3(512), dim3(256), LDS_BYTES + 32, stream, p, l, g); } while (0)
  LAUNCH_PK(100, 0, 0);
  for (int g = 0; g < 2; ++g)
    for (int l = 0; l < 2; ++l) {
      if (l == 0) LAUNCH_PK(102, l, g);
      LAUNCH_PK(0, l, g); LAUNCH_PK(1, l, g); LAUNCH_PK(2, l, g); LAUNCH_PK(3, l, g); LAUNCH_PK(4, l, g); LAUNCH_PK(5, l, g);
      LAUNCH_PK(6, l, g); LAUNCH_PK(7, l, g); LAUNCH_PK(8, l, g); LAUNCH_PK(9, l, g); LAUNCH_PK(10, l, g);
    }
  LAUNCH_PK(101, 0, 0);
#else
  static int grid_blocks = 0;
  if (!grid_blocks) {
    (void)hipFuncSetAttribute((const void*)mega, hipFuncAttributeMaxDynamicSharedMemorySize, LDS_BYTES + 32);
    int dev = 0, cus = 0, per_cu = 0;
    (void)hipGetDevice(&dev);
    (void)hipDeviceGetAttribute(&cus, hipDeviceAttributeMultiprocessorCount, dev);
    (void)hipOccupancyMaxActiveBlocksPerMultiprocessor(&per_cu, (const void*)mega, 256, LDS_BYTES + 32);
    if (per_cu < 1) per_cu = 1;
    if (per_cu > 2) per_cu = 2;
    grid_blocks = cus * per_cu;
  }
  (void)hipMemsetAsync(p.bar, 0, (size_t)XCD_BAR_WORDS * 4, stream);
  int plo = 0, phi = NPHASES, coop = 1;
  void* args[] = {&p, &plo, &phi, &coop};
  hipError_t e = hipLaunchCooperativeKernel((const void*)mega, dim3(grid_blocks), dim3(256), args, LDS_BYTES + 32, stream);
  if (e != hipSuccess) fprintf(stderr, "cooperative launch failed: %s (grid %d)\n", hipGetErrorString(e), grid_blocks);
#endif
}
```

```cpp
#include <hip/hip_runtime.h>
#include <hip/hip_cooperative_groups.h>
#include <stdint.h>
#include <stdio.h>
namespace cg = cooperative_groups;

typedef __attribute__((ext_vector_type(8))) short bf16x8;
typedef __attribute__((ext_vector_type(4))) float f32x4;
typedef unsigned short bf16_t;
typedef uint32_t u32x4 __attribute__((ext_vector_type(4)));
typedef uint32_t u32x2 __attribute__((ext_vector_type(2)));
typedef float fl4 __attribute__((ext_vector_type(4)));
#define MK4(a,b,c,d) ((u32x4){(uint32_t)(a),(uint32_t)(b),(uint32_t)(c),(uint32_t)(d)})
#define MK2(a,b) ((u32x2){(uint32_t)(a),(uint32_t)(b)})
#define MKF4(a,b,c,d) ((fl4){(a),(b),(c),(d)})

#define NTOKG 16384
#define MROWS 16512
#define MTILES 129
#define LSTRIDE 20185088
#define WOFF_A 0
#define WOFF_B (4096 * 1024)
#define WOFF_G (6400 * 1024)
#define WOFF_O (10496 * 1024)
#define WOFF_U (11520 * 1024)
#define WOFF_D (15616 * 1024)
#define LDS_BYTES 80896
#define NPHASES 48

struct Params {
  const float* x[2];
  const float* meta;
  const float* attn_norm;
  const float* w_in;
  const float* lb_logits;
  const float* w_gate;
  const float* b_gate;
  const float* norm_a;
  const float* norm_b;
  const float* w_out;
  const float* mlp_norm;
  const float* w_up;
  const float* w_down;
  const float* final_norm;
  float* out;
  bf16_t* W;
  bf16_t* X;
  bf16_t* R;
  bf16_t* O;
  bf16_t* HB;
  float* RSA;
  float* RSB;
  bf16_t* ST;
  float* GD;
  float* hmeta;
  unsigned* bar;
};

__device__ __forceinline__ uint32_t pack2(float a, float b) {
  uint32_t r;
  asm("v_cvt_pk_bf16_f32 %0, %1, %2" : "=v"(r) : "v"(a), "v"(b));
  return r;
}
__device__ __forceinline__ bf16_t f2bf(float f) { return (bf16_t)(pack2(f, f) & 0xffffu); }
__device__ __forceinline__ int opaque_tid(char* smem) {
  int lane;
  asm volatile("v_mbcnt_lo_u32_b32 %0, -1, 0\n\tv_mbcnt_hi_u32_b32 %0, -1, %0" : "=v"(lane));
  int* cnt = (int*)(smem + LDS_BYTES);
  int w = 0;
  if (lane == 0) w = atomicAdd(cnt, 1);
  w = __builtin_amdgcn_readfirstlane(w) & 3;
  __syncthreads();
  return w * 64 + lane;
}
__device__ __forceinline__ int opaque_bid() { int b = blockIdx.x; asm volatile("" : "+s"(b)); return b; }
template <int M>
__device__ __forceinline__ float shx(float v, int lane) {
  if (M < 32) return __builtin_bit_cast(float, __builtin_amdgcn_ds_swizzle(__builtin_bit_cast(int, v), 0x1f | (M << 10)));
  return __builtin_bit_cast(float, __builtin_amdgcn_ds_bpermute((lane ^ M) << 2, __builtin_bit_cast(int, v)));
}
__device__ __forceinline__ float bf2f(bf16_t b) { return __uint_as_float(((uint32_t)b) << 16); }
__device__ __forceinline__ size_t tiled_off(size_t row, int col, int K) {
  return (((row >> 7) * (size_t)(K >> 5) + (size_t)(col >> 5)) * 128 + (row & 127)) * 32 + (size_t)(col & 31);
}
__device__ __forceinline__ float sigmoidf_(float x) { return __builtin_amdgcn_rcpf(1.f + __builtin_amdgcn_exp2f(x * -1.4426950408889634f)); }

__device__ __forceinline__ int w_in_col(int R, float& scale) {
  scale = 1.f;
  if (R < 4096) return R;
  if (R < 6400) {
    int n = R - 4096;
    if (n >= 2080) return -1;
    if (n < 512) scale = 0.08838834764831845f;
    return 5120 + n;
  }
  int n = R - 6400;
  int tt = n >> 8, wv = n & 255;
  int wn = wv >> 7, nl = wv & 127;
  int qd = nl >> 5, ni = (nl >> 2) & 7, r = nl & 3;
  int grp = ni >> 2, seg = ni & 3;
  int ucol = tt * 64 + wn * 32 + qd * 8 + grp * 4 + r;
  int base = seg == 0 ? 4096 : seg == 1 ? 8224 : seg == 2 ? 7200 : 9248;
  return base + ucol;
}

__device__ __forceinline__ void phase_init(const Params& p, char* smem) {
  const int t = opaque_tid(smem);
  const int bid_ = opaque_bid();
  for (int idx = bid_ * 256 + t; idx < 2 * 128 * 256; idx += gridDim.x * 256) {
    int g = idx / (128 * 256), r = (idx / 256) % 128, c4 = idx % 256;
    int nvalid = g == 0 ? 16 : 64;
    fl4 v = MKF4(0.f, 0.f, 0.f, 0.f);
    if (r < nvalid) v = *(const fl4*)(p.meta + (size_t)(r & 15) * 1024 + c4 * 4);
    *(fl4*)(p.hmeta + ((size_t)g * 128 + r) * 1024 + c4 * 4) = v;
  }
  float* tile = (float*)smem;
  const int per_layer = 3904 + 1024;
  for (int id = bid_; id < 2 * per_layer; id += gridDim.x) {
    int l = id / per_layer, r = id % per_layer;
    const float* src; int ld; const float* gain = nullptr; int K, n0, k0;
    bf16_t* dst;
    int kind;
    int cbase = 0;
    if (r < 3904) {
      int rt = r >> 4, kt = r & 15;
      n0 = rt * 64; k0 = kt * 64; K = 1024;
      dst = p.W + (size_t)l * LSTRIDE;
      if (n0 < 10496) { kind = 0; src = p.w_in + (size_t)l * 1024 * 10272; ld = 10272; gain = p.attn_norm + l * 1024; }
      else if (n0 < 11520) { kind = 1; src = p.w_out + (size_t)l * 1024 * 1024; ld = 1024; cbase = n0 - 10496; }
      else { kind = 1; src = p.w_up + (size_t)l * 1024 * 4096; ld = 4096; cbase = n0 - 11520; gain = p.mlp_norm + l * 1024; }
    } else {
      int r2 = r - 3904;
      int rt = r2 >> 6, kt = r2 & 63;
      n0 = rt * 64; k0 = kt * 64; K = 4096;
      dst = p.W + (size_t)l * LSTRIDE + WOFF_D;
      kind = 1; src = p.w_down + (size_t)l * 4096 * 1024; ld = 1024; cbase = n0;
    }
    {
      int n = t & 63;
      float scale = 1.f; int col;
      if (kind == 0) col = w_in_col(n0 + n, scale); else col = cbase + n;
#pragma unroll 4
      for (int i = 0; i < 16; ++i) {
        int kk = (t >> 6) + 4 * i;
        float v = 0.f;
        if (col >= 0) {
          v = src[(size_t)(k0 + kk) * ld + col] * scale;
          if (gain) v *= gain[k0 + kk];
        }
        tile[kk * 65 + n] = v;
      }
    }
    __syncthreads();
    {
      int n = t >> 2, piece = t & 3;
      uint32_t pk[8];
#pragma unroll
      for (int e = 0; e < 8; ++e) {
        float a = tile[(piece * 16 + 2 * e) * 65 + n];
        float b = tile[(piece * 16 + 2 * e + 1) * 65 + n];
        pk[e] = pack2(a, b);
      }
      const int Rr = n0 + n, kk = k0 + piece * 16;
      u32x4* d = (u32x4*)(dst + ((size_t)((Rr >> 8) * (K >> 5) + (kk >> 5)) * 256 + (Rr & 255)) * 32 + (kk & 31));
      d[0] = MK4(pk[0], pk[1], pk[2], pk[3]);
      d[1] = MK4(pk[4], pk[5], pk[6], pk[7]);
    }
    __syncthreads();
  }
}

enum { EPI_G1A = 0, EPI_G1B, EPI_GATES, EPI_WOUT, EPI_UP, EPI_DOWN };

template <int EPI>
__device__ __forceinline__ void gemm_phase(const Params& p, int l, int g, char* smem) {
  constexpr bool NORM = (EPI == EPI_G1A || EPI == EPI_G1B || EPI == EPI_GATES || EPI == EPI_UP);
  constexpr int K = (EPI == EPI_DOWN) ? 4096 : 1024;
  constexpr int NT = EPI == EPI_G1A ? 16 : EPI == EPI_G1B ? 9 : EPI == EPI_GATES ? 16 : EPI == EPI_WOUT ? 4 : EPI == EPI_UP ? 16 : 4;
  constexpr int WOFF = EPI == EPI_G1A ? WOFF_A : EPI == EPI_G1B ? WOFF_B : EPI == EPI_GATES ? WOFF_G : EPI == EPI_WOUT ? WOFF_O : EPI == EPI_UP ? WOFF_U : WOFF_D;
  constexpr int NK = K / 32;
  const bf16_t* Wl = p.W + (size_t)l * LSTRIDE + WOFF;
  bf16_t* As = (bf16_t*)smem;
  bf16_t* Bs = As + 2 * 128 * 32;
  float* rss = (float*)(Bs + 2 * 256 * 32);
  const int bid_ = opaque_bid();
  const int t = opaque_tid(smem), lane = t & 63, w = t >> 6, wm = w >> 1, wn = w & 1;
  const int quad = lane >> 4, l15 = lane & 15;
  const int nvalid_meta = g == 0 ? 16 : 64;

  if (EPI == EPI_G1A) for (int i = bid_ * 256 + t; i < MROWS; i += gridDim.x * 256) p.RSB[i] = 0.f;
  if (EPI == EPI_UP) for (int i = bid_ * 256 + t; i < MROWS; i += gridDim.x * 256) p.RSA[i] = 0.f;
  for (int tile = bid_; tile < MTILES * NT; tile += gridDim.x) {
    const int mt = tile / NT, nt = tile % NT;
    const bf16_t* Ab = NORM ? p.HB + (size_t)mt * 128 * 1024 : p.X + (size_t)mt * 128 * K;
    const bf16_t* Bg = Wl + (size_t)nt * 256 * K;
    const bool do_mma = !(mt == 128 && wm == 1) && !(EPI == EPI_G1B && nt == 8 && wn == 1);

    f32x4 acc[4][8];
#pragma unroll
    for (int a = 0; a < 4; ++a)
#pragma unroll
      for (int b = 0; b < 8; ++b) acc[a][b] = (f32x4){0.f, 0.f, 0.f, 0.f};
    int t_l = t;
    asm volatile("" : "+v"(t_l));
    const uint32_t voffA = (uint32_t)((t_l >> 2) * 64 + (((t_l & 3) ^ (((t_l >> 5) & 1) << 1)) * 16));
    const uint32_t voffB0 = (uint32_t)((t_l >> 2) * 64 + ((t_l & 3) * 16));
    const uint32_t voffB1 = (uint32_t)((t_l >> 2) * 64 + (((t_l & 3) ^ 2) * 16));
    const char* Abase = (const char*)Ab;
    const char* Bbase = (const char*)Bg;
    const int rpiece = quad ^ (((l15 >> 3) & 1) << 1);
    const int w_s = __builtin_amdgcn_readfirstlane(t_l >> 6);
#define GLDS(gp, lp) __builtin_amdgcn_global_load_lds((const __attribute__((address_space(1))) void*)(gp), (__attribute__((address_space(3))) void*)(lp), 16, 0, 0)
#define G_DMA(KT, BUF) do { \
      const char* ua = Abase + (size_t)(KT) * 8192; const char* ub = Bbase + (size_t)(KT) * 16384; \
      asm volatile("" : "+s"(ua), "+s"(ub));     \
      char* la = (char*)(As + (BUF) * 4096) + w_s * 1024; char* lb = (char*)(Bs + (BUF) * 8192) + w_s * 1024;     \
      _Pragma("unroll") for (int i = 0; i < 2; ++i) GLDS(ua + i * 4096 + voffA, la + i * 4096); \
      _Pragma("unroll") for (int i = 0; i < 4; ++i) GLDS(ub + i * 4096 + ((i & 1) ? voffB1 : voffB0), lb + i * 4096); } while (0)
#define G_COMPUTE(BUF) do { \
      if (do_mma) { \
      const bf16_t* Aw = As + (BUF) * 4096; const bf16_t* Bw = Bs + (BUF) * 8192; \
      bf16x8 af[4], bfr[8]; \
      _Pragma("unroll") for (int mi = 0; mi < 4; ++mi) af[mi] = *(const bf16x8*)(Aw + (wm * 64 + mi * 16 + l15) * 32 + rpiece * 8); \
      _Pragma("unroll") for (int ni = 0; ni < 8; ++ni) bfr[ni] = *(const bf16x8*)(Bw + (wn * 128 + (l15 >> 2) * 32 + ni * 4 + (l15 & 3)) * 32 + rpiece * 8); \
      __builtin_amdgcn_s_setprio(1); \
      _Pragma("unroll") for (int ni = 0; ni < 8; ++ni) \
        _Pragma("unroll") for (int mi = 0; mi < 4; ++mi) \
          acc[mi][ni] = __builtin_amdgcn_mfma_f32_16x16x32_bf16(bfr[ni], af[mi], acc[mi][ni], 0, 0, 0); \
      __builtin_amdgcn_s_setprio(0); } } while (0)

    G_DMA(0, 0);
#pragma unroll 1
    for (int kt = 0; kt < NK; kt += 2) {
      asm volatile("s_waitcnt vmcnt(0)" ::: "memory");
      __syncthreads();
      G_DMA(kt + 1, 1);
      G_COMPUTE(0);
      asm volatile("s_waitcnt vmcnt(0)" ::: "memory");
      __syncthreads();
      { const int kn = (kt + 2 < NK) ? kt + 2 : NK - 1; G_DMA(kn, 0); }
      G_COMPUTE(1);
    }
    asm volatile("s_waitcnt vmcnt(0)" ::: "memory");
    __syncthreads();
#undef GLDS
#undef G_DMA
#undef G_COMPUTE

    int quad_e = quad, l15_e = l15, t_e = t;
    asm volatile("" : "+v"(quad_e), "+v"(l15_e), "+v"(t_e));
    if (do_mma) {
#pragma unroll
    for (int mi = 0; mi < 4; ++mi) {
      __builtin_amdgcn_sched_barrier(0);
      const int rl = wm * 64 + mi * 16 + l15_e;
      const size_t grow = (size_t)mt * 128 + rl;
      const float rs = NORM ? rsqrtf((EPI == EPI_UP ? p.RSB : p.RSA)[grow] * (1.f / 1024.f) + 1e-6f) : 1.f;
      const int cw = wn * 128 + quad_e * 32;
      if (EPI == EPI_G1A) {
        const int region = nt >> 2;
        bf16_t* xp = p.X + grow * 4096 + nt * 256 + cw;
#pragma unroll
        for (int c = 0; c < 4; ++c) {
          float v[8];
#pragma unroll
          for (int e = 0; e < 8; ++e) v[e] = acc[mi][2 * c + (e >> 2)][e & 3] * rs;
          if (region == 1 || region == 2) {
            float lb[8] = {0.f, 0.f, 0.f, 0.f, 0.f, 0.f, 0.f, 0.f};
            if (l == 1) {
              const float* l0p = p.lb_logits + (region - 1) * 1024 + ((nt * 256 + cw + c * 8) & 1023);
              const fl4 a0 = *(const fl4*)l0p, a1 = *(const fl4*)(l0p + 4);
              const fl4 b0 = *(const fl4*)(l0p + 2048), b1 = *(const fl4*)(l0p + 2052);
              lb[0] = sigmoidf_(b0.x - a0.x); lb[1] = sigmoidf_(b0.y - a0.y);
              lb[2] = sigmoidf_(b0.z - a0.z); lb[3] = sigmoidf_(b0.w - a0.w);
              lb[4] = sigmoidf_(b1.x - a1.x); lb[5] = sigmoidf_(b1.y - a1.y);
              lb[6] = sigmoidf_(b1.z - a1.z); lb[7] = sigmoidf_(b1.w - a1.w);
            }
#pragma unroll
            for (int e = 0; e < 8; ++e) {
              const float f = fmaxf(lb[e], 1e-30f) + (1.f - lb[e]) * sigmoidf_(v[e]);
              v[e] = __builtin_amdgcn_logf(f);
            }
          }
          *(u32x4*)(xp + c * 8) = MK4(pack2(v[0], v[1]), pack2(v[2], v[3]), pack2(v[4], v[5]), pack2(v[6], v[7]));
        }
      } else if (EPI == EPI_G1B) {
        if (nt < 8) {
          bf16_t* xp = p.X + grow * 2048 + nt * 256 + cw;
#pragma unroll
          for (int c = 0; c < 4; ++c)
            *(u32x4*)(xp + c * 8) = MK4(pack2(acc[mi][2 * c][0] * rs, acc[mi][2 * c][1] * rs), pack2(acc[mi][2 * c][2] * rs, acc[mi][2 * c][3] * rs),
                                        pack2(acc[mi][2 * c + 1][0] * rs, acc[mi][2 * c + 1][1] * rs), pack2(acc[mi][2 * c + 1][2] * rs, acc[mi][2 * c + 1][3] * rs));
        } else if (cw == 0) {
          bf16_t* rp = p.R + grow * 32;
#pragma unroll
          for (int c = 0; c < 4; ++c)
            *(u32x4*)(rp + c * 8) = MK4(pack2(acc[mi][2 * c][0] * rs, acc[mi][2 * c][1] * rs), pack2(acc[mi][2 * c][2] * rs, acc[mi][2 * c][3] * rs),
                                        pack2(acc[mi][2 * c + 1][0] * rs, acc[mi][2 * c + 1][1] * rs), pack2(acc[mi][2 * c + 1][2] * rs, acc[mi][2 * c + 1][3] * rs));
        }
      } else if (EPI == EPI_GATES) {
        const int uc = nt * 64 + wn * 32 + quad_e * 8;
        const u32x4 oa = *(const u32x4*)(p.O + grow * 2048 + uc);
        const u32x4 ob = *(const u32x4*)(p.O + grow * 2048 + 1024 + uc);
        const uint32_t oau[4] = {oa.x, oa.y, oa.z, oa.w}, obu[4] = {ob.x, ob.y, ob.z, ob.w};
        float u[8];
#pragma unroll
        for (int grp = 0; grp < 2; ++grp)
#pragma unroll
          for (int r = 0; r < 4; ++r) {
            const int idx = grp * 4 + r;
            const float ga = acc[mi][grp * 4 + 0][r] * rs, ma = acc[mi][grp * 4 + 1][r] * rs;
            const float gb = acc[mi][grp * 4 + 2][r] * rs, mb = acc[mi][grp * 4 + 3][r] * rs;
            const float ona = (idx & 1) ? __uint_as_float(oau[idx >> 1] & 0xffff0000u) : __uint_as_float(oau[idx >> 1] << 16);
            const float onb = (idx & 1) ? __uint_as_float(obu[idx >> 1] & 0xffff0000u) : __uint_as_float(obu[idx >> 1] << 16);
            u[idx] = sigmoidf_(ma) * (ga * sigmoidf_(ga)) * ona + sigmoidf_(mb) * (gb * sigmoidf_(gb)) * onb;
          }
        *(u32x4*)(p.X + tiled_off(grow, uc, 1024)) = MK4(pack2(u[0], u[1]), pack2(u[2], u[3]), pack2(u[4], u[5]), pack2(u[6], u[7]));
      } else if (EPI == EPI_WOUT || EPI == EPI_DOWN) {
        const bool meta = (mt == 128);
        float hsq = 0.f;
        if (!meta || rl < nvalid_meta) {
          const float* hin; float* hout;
          if (meta) { hout = p.hmeta + ((size_t)g * 128 + rl) * 1024; hin = hout; }
          else {
            const size_t trow = (size_t)mt * 128 + rl;
            hout = p.out + ((size_t)g * NTOKG + trow) * 1024;
            hin = (EPI == EPI_WOUT && l == 0) ? p.x[g] + trow * 1024 : hout;
          }
          const int col0 = nt * 256 + cw;
          bf16_t* hb = p.HB + tiled_off(grow, col0, 1024);
#pragma unroll
          for (int c = 0; c < 4; ++c) {
            const fl4 h0 = *(const fl4*)(hin + col0 + c * 8), h1 = *(const fl4*)(hin + col0 + c * 8 + 4);
            const fl4 o0 = MKF4(h0.x + acc[mi][2 * c][0], h0.y + acc[mi][2 * c][1], h0.z + acc[mi][2 * c][2], h0.w + acc[mi][2 * c][3]);
            const fl4 o1 = MKF4(h1.x + acc[mi][2 * c + 1][0], h1.y + acc[mi][2 * c + 1][1], h1.z + acc[mi][2 * c + 1][2], h1.w + acc[mi][2 * c + 1][3]);
            *(fl4*)(hout + col0 + c * 8) = o0;
            *(fl4*)(hout + col0 + c * 8 + 4) = o1;
            *(u32x4*)(hb + c * 8) = MK4(pack2(o0.x, o0.y), pack2(o0.z, o0.w), pack2(o1.x, o1.y), pack2(o1.z, o1.w));
            hsq += o0.x * o0.x + o0.y * o0.y + o0.z * o0.z + o0.w * o0.w + o1.x * o1.x + o1.y * o1.y + o1.z * o1.z + o1.w * o1.w;
          }
        }
        hsq += shx<16>(hsq, lane); hsq += shx<32>(hsq, lane);
        if (quad_e == 0 && (!meta || rl < nvalid_meta)) atomicAdd((EPI == EPI_WOUT ? p.RSB : p.RSA) + grow, hsq);
      } else if (EPI == EPI_UP) {
        bf16_t* xp = p.X + tiled_off(grow, nt * 256 + cw, 4096);
#pragma unroll
        for (int c = 0; c < 4; ++c) {
          float v[8];
#pragma unroll
          for (int e = 0; e < 8; ++e) { const float a = fmaxf(acc[mi][2 * c + (e >> 2)][e & 3] * rs, 0.f); v[e] = a * a; }
          *(u32x4*)(xp + c * 8) = MK4(pack2(v[0], v[1]), pack2(v[2], v[3]), pack2(v[4], v[5]), pack2(v[6], v[7]));
        }
      }
    }
    }
  }
}

template <int MIX, int PASS>
__device__ __forceinline__ void scan_phase(const Params& p, int l, int g, char* smem) {
  constexpr int NH = MIX ? 4 : 8;
  constexpr int NDV = MIX ? 4 : 2;
  constexpr int XLD = MIX ? 2048 : 4096;
  bf16_t* QS = (bf16_t*)smem;
  bf16_t* KS = QS + 64 * 136;
  bf16_t* KT = KS + 64 * 136;
  bf16_t* LG = KT;
  bf16_t* Pm = QS;
  bf16_t* SmT = KS;
  bf16_t* VT = KT + 128 * 72;
  bf16_t* RS = VT + 64 * 72;
  float* em = (float*)(RS + 64 * 24);
  float* el = em + 128;
  float* tot = el + 128;
  const int bid_ = opaque_bid();
  const int t_outer = opaque_tid(smem);
  const int sps = g == 0 ? 16 : 4;
  constexpr bool do_out = (PASS == 3);
  const bf16_t* Xg = p.X;

  for (int item = bid_; item < 512; item += gridDim.x) {
    int t = t_outer;
    asm volatile("" : "+v"(t));
    const int lane = t & 63, w = t >> 6, quad = lane >> 4, l15 = lane & 15;
    const int dir = item & 1;
    const int dvb = (item >> 1) % NDV;
    const int head = ((item >> 1) / NDV) % NH;
    const int seg = item >> 5;
    const int seq = seg / sps;
    const bool first = (seg % sps) == 0;
    const int nsteps = 16 + (first ? 1 : 0);
    int qcol, kcol, vcol;
    bf16_t* Og; int OLD;
    if (MIX == 0) {
      qcol = head * 128; kcol = 1024 + dir * 1024 + head * 128; vcol = 3072 + head * 128 + dvb * 64;
      Og = p.O + dir * 1024 + head * 128 + dvb * 64; OLD = 2048;
    } else {
      qcol = head * 128; kcol = 512 + head * 128; vcol = 1024 + head * 256 + dvb * 64;
      Og = p.X + (size_t)MROWS * 2048 + (size_t)dir * MROWS * 1024 + head * 256 + dvb * 64; OLD = 1024;
    }
    bf16x8 wgf[2]; float bgv[2][4];
    if (MIX == 1) {
#pragma unroll
      for (int ct = 0; ct < 2; ++ct) {
        const int cc = 16 * (2 * w + ct) + l15;
        bf16x8 v = (bf16x8){0, 0, 0, 0, 0, 0, 0, 0};
        if (quad < 2) {
#pragma unroll
          for (int e = 0; e < 8; ++e)
            v[e] = (short)f2bf(p.w_gate[((size_t)(l * 2 + dir) * 16 + quad * 8 + e) * 512 + head * 128 + cc]);
        }
        wgf[ct] = v;
#pragma unroll
        for (int r = 0; r < 4; ++r) bgv[ct][r] = p.b_gate[(l * 2 + dir) * 512 + head * 128 + 16 * (2 * w + ct) + quad * 4 + r];
      }
    }
    f32x4 S[8];
#pragma unroll
    for (int a = 0; a < 8; ++a) S[a] = (f32x4){0.f, 0.f, 0.f, 0.f};
    if (do_out) {
      int s2 = dir == 0 ? seq * sps : seq * sps + sps - 1;
      const int stp = dir == 0 ? 1 : -1;
      for (; s2 != seg; s2 += stp) {
        const int item2 = ((s2 * NH + head) * NDV + dvb) * 2 + dir;
        const bf16_t* L = p.ST + (size_t)item2 * 8192;
        const float* G = p.GD + ((s2 * 8 + head) * 2 + dir) * 128;
#pragma unroll
        for (int a = 0; a < 8; ++a)
#pragma unroll
          for (int r = 0; r < 4; ++r) {
            const int k = 16 * (2 * w + (a >> 2)) + quad * 4 + r;
            S[a][r] = __builtin_amdgcn_exp2f(G[k]) * S[a][r] + bf2f(L[(a * 4 + r) * 256 + t]);
          }
      }
    }
    float gacc0 = 0.f, gacc1 = 0.f;

    u32x4 qr[4], kr[4], vr[2], rr;
    auto step_rows = [&](int s, int& rowbase, int& nv) {
      bool meta;
      if (dir == 0) { meta = first && s == 0; rowbase = (seg * 16 + s - (first ? 1 : 0)) * 64; }
      else { meta = (s == 16); rowbase = (seg * 16 + 15 - s) * 64; }
      if (meta) { rowbase = NTOKG + seq * 16; nv = 16; } else nv = 64;
    };
    const char* Xq = (const char*)(Xg + qcol);
    const char* Xk = (const char*)(Xg + kcol);
    const char* Xv = (const char*)(Xg + vcol);
    const char* Rb = (const char*)(p.R + dir * 16);
    auto gload = [&](int s) {
      int rowbase, nv; step_rows(s, rowbase, nv);
#pragma unroll
      for (int j = 0; j < 4; ++j) {
        const int i = (t >> 4) + 16 * j;
        const int mr = dir ? rowbase + nv - 1 - i : rowbase + i;
        u32x4 z = MK4(0, 0, 0, 0);
        if (i < nv) {
          const uint32_t vo = (uint32_t)(mr * XLD + (t & 15) * 8) * 2u;
          qr[j] = do_out ? *(const u32x4*)(Xq + vo) : z;
          kr[j] = *(const u32x4*)(Xk + vo);
        } else { qr[j] = z; kr[j] = z; }
      }
      {
        const int i = t >> 2;
        const int mr = dir ? rowbase + nv - 1 - i : rowbase + i;
        vr[0] = MK4(0, 0, 0, 0); vr[1] = vr[0];
        if (i < nv) {
          const uint32_t vo = (uint32_t)(mr * XLD + (t & 3) * 16) * 2u;
          vr[0] = *(const u32x4*)(Xv + vo); vr[1] = *(const u32x4*)(Xv + vo + 16);
        }
      }
      if (MIX == 1) {
        rr = MK4(0, 0, 0, 0);
        if (t < 128) {
          const int i = t >> 1;
          const int mr = dir ? rowbase + nv - 1 - i : rowbase + i;
          if (i < nv) rr = *(const u32x4*)(Rb + (uint32_t)(mr * 32 + (t & 1) * 8) * 2u);
        }
      }
    };
    gload(0);

    for (int s = 0; s < nsteps; ++s) {
      int rowbase, nv; step_rows(s, rowbase, nv);
#pragma unroll
      for (int j = 0; j < 4; ++j) {
        const int i = (t >> 4) + 16 * j;
        if (do_out) *(u32x4*)(QS + i * 136 + (t & 15) * 8) = qr[j];
        *(u32x4*)(KS + i * 136 + (t & 15) * 8) = kr[j];
      }
      {
        const int i = t >> 2, piece = t & 3;
        uint32_t vv[8] = {vr[0].x, vr[0].y, vr[0].z, vr[0].w, vr[1].x, vr[1].y, vr[1].z, vr[1].w};
        bf16_t* vtw = VT + piece * 16 * 72 + i;
#pragma unroll
        for (int e = 0; e < 16; ++e) vtw[e * 72] = (bf16_t)((vv[e >> 1] >> ((e & 1) * 16)) & 0xffffu);
      }
      if (MIX == 1 && t < 128) *(u32x4*)(RS + (t >> 1) * 24 + (t & 1) * 8) = rr;
      if (s + 1 < nsteps) gload(s + 1);
      __syncthreads();
      if (MIX == 1) {
        bf16x8 af[4];
#pragma unroll
        for (int it = 0; it < 4; ++it) {
          af[it] = (bf16x8){0, 0, 0, 0, 0, 0, 0, 0};
          if (quad < 2) af[it] = *(const bf16x8*)(RS + (16 * it + l15) * 24 + quad * 8);
        }
#pragma unroll
        for (int ct = 0; ct < 2; ++ct)
#pragma unroll
          for (int it = 0; it < 4; ++it) {
            f32x4 z = __builtin_amdgcn_mfma_f32_16x16x32_bf16(wgf[ct], af[it], (f32x4){0.f, 0.f, 0.f, 0.f}, 0, 0, 0);
            float ls[4];
#pragma unroll
            for (int r = 0; r < 4; ++r) {
              const float zz = fmaxf(z[r] + bgv[ct][r], -80.f);
              ls[r] = __builtin_amdgcn_logf(1.f + __builtin_amdgcn_exp2f(zz * -1.4426950408889634f)) * -0.0625f;
            }
            *(u32x2*)(LG + (16 * it + l15) * 128 + 16 * (2 * w + ct) + quad * 4) = MK2(pack2(ls[0], ls[1]), pack2(ls[2], ls[3]));
          }
        __syncthreads();
      }
      const int cp = t & 63, rg = t >> 6;
      const int nvl = nv - 16 * rg;
      float p0[16], p1[16];
      {
        float run0 = 0.f, run1 = 0.f;
        constexpr int LFS32 = (MIX == 0) ? 68 : 64;
        const uint32_t* lfp = (const uint32_t*)((MIX == 0) ? (KS + 16 * rg * 136) : (LG + 16 * rg * 128)) + cp;
#pragma unroll
        for (int ii = 0; ii < 16; ++ii) {
          if ((ii & 7) == 0) __builtin_amdgcn_sched_barrier(0);
          const uint32_t u = lfp[ii * LFS32];
          float l0 = __uint_as_float(u << 16), l1 = __uint_as_float(u & 0xffff0000u);
          if (ii >= nvl) { l0 = 0.f; l1 = 0.f; }
          run0 += l0; run1 += l1;
          p0[ii] = run0; p1[ii] = run1;
        }
        *(float2*)(tot + rg * 128 + 2 * cp) = make_float2(run0, run1);
      }
      __syncthreads();
      {
        const float2 ta = *(const float2*)(tot + 2 * cp), tb = *(const float2*)(tot + 128 + 2 * cp);
        const float2 tc = *(const float2*)(tot + 256 + 2 * cp), td = *(const float2*)(tot + 384 + 2 * cp);
        const float m0 = ta.x + tb.x, m1 = ta.y + tb.y;
        const float base0 = (rg > 0 ? ta.x : 0.f) + (rg > 1 ? tb.x : 0.f) + (rg > 2 ? tc.x : 0.f);
        const float base1 = (rg > 0 ? ta.y : 0.f) + (rg > 1 ? tb.y : 0.f) + (rg > 2 ? tc.y : 0.f);
        uint32_t* qp = (uint32_t*)(QS + 16 * rg * 136) + cp;
        uint32_t* kp = (uint32_t*)(KS + 16 * rg * 136) + cp;
        float skp0 = __builtin_amdgcn_exp2f(-fminf(fmaxf(base0 - m0, -115.f), 115.f));
        float skp1 = __builtin_amdgcn_exp2f(-fminf(fmaxf(base1 - m1, -115.f), 115.f));
        uint32_t kt0[8], kt1[8], kkprev = 0;
#pragma unroll
        for (int ii = 0; ii < 16; ++ii) {
          if ((ii & 3) == 0) __builtin_amdgcn_sched_barrier(0);
          const float e0 = fminf(fmaxf(base0 + p0[ii] - m0, -115.f), 115.f);
          const float e1 = fminf(fmaxf(base1 + p1[ii] - m1, -115.f), 115.f);
          const float sq0 = __builtin_amdgcn_exp2f(e0), sq1 = __builtin_amdgcn_exp2f(e1);
          const float sk0 = __builtin_amdgcn_rcpf(sq0), sk1 = __builtin_amdgcn_rcpf(sq1);
          if (do_out) {
            const uint32_t uq = qp[ii * 68];
            qp[ii * 68] = pack2(__uint_as_float(uq << 16) * sq0, __uint_as_float(uq & 0xffff0000u) * sq1);
          }
          float k0, k1;
          if (MIX == 0) { k0 = 1.f - sq0 * skp0; k1 = 1.f - sq1 * skp1; skp0 = sk0; skp1 = sk1; }
          else { const uint32_t uk = kp[ii * 68]; k0 = __uint_as_float(uk << 16); k1 = __uint_as_float(uk & 0xffff0000u); }
          const uint32_t kk = pack2(k0 * sk0, k1 * sk1);
          if (do_out) kp[ii * 68] = kk;
          if (ii & 1) {
            kt0[ii >> 1] = __builtin_amdgcn_perm(kk, kkprev, 0x05040100u);
            kt1[ii >> 1] = __builtin_amdgcn_perm(kk, kkprev, 0x07060302u);
          } else kkprev = kk;
        }
        u32x4* kd0 = (u32x4*)(KT + (2 * cp) * 72 + 16 * rg);
        u32x4* kd1 = (u32x4*)(KT + (2 * cp + 1) * 72 + 16 * rg);
        kd0[0] = MK4(kt0[0], kt0[1], kt0[2], kt0[3]); kd0[1] = MK4(kt0[4], kt0[5], kt0[6], kt0[7]);
        kd1[0] = MK4(kt1[0], kt1[1], kt1[2], kt1[3]); kd1[1] = MK4(kt1[4], kt1[5], kt1[6], kt1[7]);
        if (rg == 0) {
          *(float2*)(em + 2 * cp) = make_float2(__builtin_amdgcn_exp2f(m0), __builtin_amdgcn_exp2f(m1));
          *(float2*)(el + 2 * cp) = make_float2(__builtin_amdgcn_exp2f(tc.x + td.x), __builtin_amdgcn_exp2f(tc.y + td.y));
        }
        gacc0 += m0 + tc.x + td.x; gacc1 += m1 + tc.y + td.y;
      }
      __syncthreads();
      if (do_out) {
        bf16x8 qf[4];
#pragma unroll
        for (int ks = 0; ks < 4; ++ks) qf[ks] = *(const bf16x8*)(QS + (16 * w + l15) * 136 + ks * 32 + quad * 8);
        f32x4 pa[4];
#pragma unroll
        for (int jt = 0; jt < 4; ++jt) {
          pa[jt] = (f32x4){0.f, 0.f, 0.f, 0.f};
          if (jt <= w) {
#pragma unroll
            for (int ks = 0; ks < 4; ++ks) {
              bf16x8 kf = *(const bf16x8*)(KS + (16 * jt + l15) * 136 + ks * 32 + quad * 8);
              pa[jt] = __builtin_amdgcn_mfma_f32_16x16x32_bf16(kf, qf[ks], pa[jt], 0, 0, 0);
            }
          }
        }
        __syncthreads();
        {
          const int i = 16 * w + l15;
          bf16_t* pw = Pm + i * 72 + quad * 4;
#pragma unroll
          for (int jt = 0; jt < 4; ++jt) {
            const int j0 = 16 * jt + quad * 4;
            float pv[4];
#pragma unroll
            for (int r = 0; r < 4; ++r) pv[r] = (jt <= w && j0 + r <= i) ? pa[jt][r] : 0.f;
            *(u32x2*)(pw + 16 * jt) = MK2(pack2(pv[0], pv[1]), pack2(pv[2], pv[3]));
          }
        }
#pragma unroll
        for (int a = 0; a < 8; ++a) {
          const int k0 = 16 * (2 * w + (a >> 2)) + quad * 4;
          const int v = 16 * (a & 3) + l15;
          const fl4 e = *(const fl4*)(em + k0);
          S[a][0] *= e.x; S[a][1] *= e.y; S[a][2] *= e.z; S[a][3] *= e.w;
          *(u32x2*)(SmT + v * 136 + k0) = MK2(pack2(S[a][0], S[a][1]), pack2(S[a][2], S[a][3]));
        }
        __syncthreads();
        f32x4 oa[4];
#pragma unroll
        for (int vt = 0; vt < 4; ++vt) {
          oa[vt] = (f32x4){0.f, 0.f, 0.f, 0.f};
#pragma unroll
          for (int ks = 0; ks < 4; ++ks) {
            bf16x8 sf = *(const bf16x8*)(SmT + (16 * vt + l15) * 136 + ks * 32 + quad * 8);
            oa[vt] = __builtin_amdgcn_mfma_f32_16x16x32_bf16(sf, qf[ks], oa[vt], 0, 0, 0);
          }
        }
#pragma unroll
        for (int js = 0; js < 2; ++js) {
          bf16x8 pfr = *(const bf16x8*)(Pm + (16 * w + l15) * 72 + js * 32 + quad * 8);
#pragma unroll
          for (int vt = 0; vt < 4; ++vt) {
            bf16x8 vf = *(const bf16x8*)(VT + (16 * vt + l15) * 72 + js * 32 + quad * 8);
            oa[vt] = __builtin_amdgcn_mfma_f32_16x16x32_bf16(vf, pfr, oa[vt], 0, 0, 0);
          }
        }
        {
          const int i = 16 * w + l15;
          if (i < nv) {
            const int mr = dir ? rowbase + nv - 1 - i : rowbase + i;
            bf16_t* op = (bf16_t*)((char*)Og + (uint32_t)(mr * OLD + quad * 4) * 2u);
#pragma unroll
            for (int vt = 0; vt < 4; ++vt) *(u32x2*)(op + 16 * vt) = MK2(pack2(oa[vt][0], oa[vt][1]), pack2(oa[vt][2], oa[vt][3]));
          }
        }
      } else {
#pragma unroll
        for (int a = 0; a < 8; ++a) {
          const int k0 = 16 * (2 * w + (a >> 2)) + quad * 4;
          const fl4 e = *(const fl4*)(em + k0);
          S[a][0] *= e.x; S[a][1] *= e.y; S[a][2] *= e.z; S[a][3] *= e.w;
        }
      }
#pragma unroll
      for (int js = 0; js < 2; ++js) {
        bf16x8 kf[2];
#pragma unroll
        for (int ktl = 0; ktl < 2; ++ktl) kf[ktl] = *(const bf16x8*)(KT + (16 * (2 * w + ktl) + l15) * 72 + js * 32 + quad * 8);
#pragma unroll
        for (int vt = 0; vt < 4; ++vt) {
          bf16x8 vf = *(const bf16x8*)(VT + (16 * vt + l15) * 72 + js * 32 + quad * 8);
#pragma unroll
          for (int ktl = 0; ktl < 2; ++ktl)
            S[ktl * 4 + vt] = __builtin_amdgcn_mfma_f32_16x16x32_bf16(kf[ktl], vf, S[ktl * 4 + vt], 0, 0, 0);
        }
      }
#pragma unroll
      for (int a = 0; a < 8; ++a) {
        const int k0 = 16 * (2 * w + (a >> 2)) + quad * 4;
        const fl4 e = *(const fl4*)(el + k0);
        S[a][0] *= e.x; S[a][1] *= e.y; S[a][2] *= e.z; S[a][3] *= e.w;
      }
      __syncthreads();
    }
    if (!do_out) {
      bf16_t* L = p.ST + (size_t)item * 8192;
#pragma unroll
      for (int a = 0; a < 8; ++a)
#pragma unroll
        for (int r = 0; r < 4; ++r) L[(a * 4 + r) * 256 + t] = f2bf(S[a][r]);
      if (dvb == 0 && t < 64) *(float2*)(p.GD + ((seg * 8 + head) * 2 + dir) * 128 + 2 * t) = make_float2(gacc0, gacc1);
    }
  }
}

__device__ __forceinline__ void phase_hn(const Params& p, int l, char* smem) {
  const int bid_ = opaque_bid();
  const int t = opaque_tid(smem), lane = t & 63, w = t >> 6;
  const bf16_t* Y1 = p.X + (size_t)MROWS * 2048;
  const bf16_t* Y2 = Y1 + (size_t)MROWS * 1024;
  for (int row = bid_ * 4 + w; row < MROWS; row += gridDim.x * 4) {
    bf16_t* oa = p.O + (size_t)row * 2048 + lane * 16;
    float xa[16], xb[16];
    {
      u32x4 a0 = *(const u32x4*)(oa), a1 = *(const u32x4*)(oa + 8);
      u32x4 b0 = *(const u32x4*)(oa + 1024), b1 = *(const u32x4*)(oa + 1032);
      uint32_t ua[8] = {a0.x, a0.y, a0.z, a0.w, a1.x, a1.y, a1.z, a1.w};
      uint32_t ub[8] = {b0.x, b0.y, b0.z, b0.w, b1.x, b1.y, b1.z, b1.w};
#pragma unroll
      for (int e = 0; e < 8; ++e) {
        xa[2 * e] = __uint_as_float(ua[e] << 16) + __uint_as_float(ub[e] << 16);
        xa[2 * e + 1] = __uint_as_float(ua[e] & 0xffff0000u) + __uint_as_float(ub[e] & 0xffff0000u);
      }
      const bf16_t* y1 = Y1 + (size_t)row * 1024 + lane * 16;
      const bf16_t* y2 = Y2 + (size_t)row * 1024 + lane * 16;
      u32x4 c0 = *(const u32x4*)(y1), c1 = *(const u32x4*)(y1 + 8);
      u32x4 d0 = *(const u32x4*)(y2), d1 = *(const u32x4*)(y2 + 8);
      uint32_t uc[8] = {c0.x, c0.y, c0.z, c0.w, c1.x, c1.y, c1.z, c1.w};
      uint32_t ud[8] = {d0.x, d0.y, d0.z, d0.w, d1.x, d1.y, d1.z, d1.w};
#pragma unroll
      for (int e = 0; e < 8; ++e) {
        xb[2 * e] = __uint_as_float(uc[e] << 16) + __uint_as_float(ud[e] << 16);
        xb[2 * e + 1] = __uint_as_float(uc[e] & 0xffff0000u) + __uint_as_float(ud[e] & 0xffff0000u);
      }
    }
    float sa = 0.f, sb = 0.f;
#pragma unroll
    for (int e = 0; e < 16; ++e) { sa += xa[e] * xa[e]; sb += xb[e] * xb[e]; }
    sa += shx<1>(sa, lane); sa += shx<2>(sa, lane); sa += shx<4>(sa, lane);
    sb += shx<1>(sb, lane); sb += shx<2>(sb, lane); sb += shx<4>(sb, lane); sb += shx<8>(sb, lane);
    const float ra = rsqrtf(sa * (1.f / 128.f) + 1e-6f);
    const float rb = rsqrtf(sb * (1.f / 256.f) + 1e-6f);
    const float* na = p.norm_a + l * 1024 + lane * 16;
    const float* nb = p.norm_b + l * 1024 + lane * 16;
    uint32_t pa[8], pb[8];
#pragma unroll
    for (int e = 0; e < 8; ++e) {
      pa[e] = pack2(xa[2 * e] * ra * na[2 * e], xa[2 * e + 1] * ra * na[2 * e + 1]);
      pb[e] = pack2(xb[2 * e] * rb * nb[2 * e], xb[2 * e + 1] * rb * nb[2 * e + 1]);
    }
    *(u32x4*)(oa) = MK4(pa[0], pa[1], pa[2], pa[3]);
    *(u32x4*)(oa + 8) = MK4(pa[4], pa[5], pa[6], pa[7]);
    *(u32x4*)(oa + 1024) = MK4(pb[0], pb[1], pb[2], pb[3]);
    *(u32x4*)(oa + 1032) = MK4(pb[4], pb[5], pb[6], pb[7]);
  }
}

__device__ __forceinline__ void phase_final(const Params& p, char* smem) {
  const int bid_ = opaque_bid();
  const int t = opaque_tid(smem), lane = t & 63, w = t >> 6;
  for (int row = bid_ * 4 + w; row < 2 * NTOKG; row += gridDim.x * 4) {
    float* hp = p.out + (size_t)row * 1024;
    fl4 v[4];
    float s = 0.f;
#pragma unroll
    for (int j = 0; j < 4; ++j) {
      v[j] = *(const fl4*)(hp + j * 256 + lane * 4);
      s += v[j].x * v[j].x + v[j].y * v[j].y + v[j].z * v[j].z + v[j].w * v[j].w;
    }
    s += shx<1>(s, lane); s += shx<2>(s, lane); s += shx<4>(s, lane);
    s += shx<8>(s, lane); s += shx<16>(s, lane); s += shx<32>(s, lane);
    const float rs = rsqrtf(s * (1.f / 1024.f) + 1e-6f);
#pragma unroll
    for (int j = 0; j < 4; ++j) {
      const fl4 gn = *(const fl4*)(p.final_norm + j * 256 + lane * 4);
      fl4 o = MKF4(v[j].x * rs * gn.x, v[j].y * rs * gn.y, v[j].z * rs * gn.z, v[j].w * rs * gn.w);
      *(fl4*)(hp + j * 256 + lane * 4) = o;
    }
  }
}

__device__ __forceinline__ void phase_xcvt(const Params& p, int g, char* smem) {
  const int bid_ = opaque_bid();
  const int t = opaque_tid(smem), lane = t & 63, w = t >> 6;
  for (int row = bid_ * 4 + w; row < MROWS; row += gridDim.x * 4) {
    const float* src = row < NTOKG ? p.x[g] + (size_t)row * 1024 : p.hmeta + ((size_t)g * 128 + (row - NTOKG)) * 1024;
    float ssq = 0.f;
#pragma unroll
    for (int j = 0; j < 2; ++j) {
      const int c8 = j * 64 + lane;
      const fl4 a = *(const fl4*)(src + c8 * 8), b = *(const fl4*)(src + c8 * 8 + 4);
      ssq += a.x * a.x + a.y * a.y + a.z * a.z + a.w * a.w + b.x * b.x + b.y * b.y + b.z * b.z + b.w * b.w;
      *(u32x4*)(p.HB + tiled_off((size_t)row, c8 * 8, 1024)) = MK4(pack2(a.x, a.y), pack2(a.z, a.w), pack2(b.x, b.y), pack2(b.z, b.w));
    }
    ssq += shx<1>(ssq, lane); ssq += shx<2>(ssq, lane); ssq += shx<4>(ssq, lane);
    ssq += shx<8>(ssq, lane); ssq += shx<16>(ssq, lane); ssq += shx<32>(ssq, lane);
    if (lane == 0) p.RSA[row] = ssq;
  }
}

__device__ __forceinline__ void run_phase(const Params& p, int ph, char* smem) {
  if (ph == 0) { phase_init(p, smem); return; }
  if (ph == NPHASES - 1) { phase_final(p, smem); return; }
  const int q = ph - 1;
  const int g = q / 23, r = q % 23;
  if (r == 0) { phase_xcvt(p, g, smem); return; }
  const int l = (r - 1) / 11, st = (r - 1) % 11;
  switch (st) {
    case 0: gemm_phase<EPI_G1A>(p, l, g, smem); break;
    case 1: scan_phase<0, 1>(p, l, g, smem); break;
    case 2: scan_phase<0, 3>(p, l, g, smem); break;
    case 3: gemm_phase<EPI_G1B>(p, l, g, smem); break;
    case 4: scan_phase<1, 1>(p, l, g, smem); break;
    case 5: scan_phase<1, 3>(p, l, g, smem); break;
    case 6: phase_hn(p, l, smem); break;
    case 7: gemm_phase<EPI_GATES>(p, l, g, smem); break;
    case 8: gemm_phase<EPI_WOUT>(p, l, g, smem); break;
    case 9: gemm_phase<EPI_UP>(p, l, g, smem); break;
    default: gemm_phase<EPI_DOWN>(p, l, g, smem); break;
  }
}

template <int ST>
__global__ void __launch_bounds__(256, 2) pk(Params p, int l, int g) {
  extern __shared__ __attribute__((aligned(16))) char smem[];
  if (ST == 100) phase_init(p, smem);
  else if (ST == 101) phase_final(p, smem);
  else if (ST == 102) phase_xcvt(p, g, smem);
  else if (ST == 0) gemm_phase<EPI_G1A>(p, l, g, smem);
  else if (ST == 1) scan_phase<0, 1>(p, l, g, smem);
  else if (ST == 2) scan_phase<0, 3>(p, l, g, smem);
  else if (ST == 3) gemm_phase<EPI_G1B>(p, l, g, smem);
  else if (ST == 4) scan_phase<1, 1>(p, l, g, smem);
  else if (ST == 5) scan_phase<1, 3>(p, l, g, smem);
  else if (ST == 6) phase_hn(p, l, smem);
  else if (ST == 7) gemm_phase<EPI_GATES>(p, l, g, smem);
  else if (ST == 8) gemm_phase<EPI_WOUT>(p, l, g, smem);
  else if (ST == 9) gemm_phase<EPI_UP>(p, l, g, smem);
  else gemm_phase<EPI_DOWN>(p, l, g, smem);
}


#define XB_TMO      128
#define XB_XCNT(j)  (256  + 64 * (j))
#define XB_XSUB(j)  (1280 + 64 * (j))
#define XB_XGEN(j)  (2304 + 64 * (j))
#define XB_TOP      3328
#define XB_TOPGEN   3392
#define XCD_BAR_WORDS 3456
#define XB_SPIN_CAP (1u << 22)
#define LAS __attribute__((address_space(3)))
__device__ __forceinline__ unsigned xb_ld(unsigned* p)              { return __hip_atomic_load(p, __ATOMIC_RELAXED, __HIP_MEMORY_SCOPE_AGENT); }
__device__ __forceinline__ unsigned xb_add(unsigned* p, unsigned v) { return __hip_atomic_fetch_add(p, v, __ATOMIC_RELAXED, __HIP_MEMORY_SCOPE_AGENT); }
__device__ __forceinline__ unsigned xb_xcc_id() { return (unsigned)__builtin_amdgcn_s_getreg((3 << 11) | 20) & 0xFu; }
#define XB_SPIN(cond, bar) do { unsigned _sp = 0; while (cond) { __builtin_amdgcn_s_sleep(1); \
    if ((++_sp & 255u) == 0u) { if (xb_ld(&(bar)[XB_TMO])) break; if (_sp > XB_SPIN_CAP) { atomicAdd(&(bar)[XB_TMO], 1u); break; } } } } while (0)

__device__ __forceinline__ void xcd_barrier_complete(unsigned* bar, unsigned x, unsigned& nloc, unsigned& nx) {
  const unsigned G = gridDim.x * gridDim.y * gridDim.z;
  unsigned sum, cnt, mine, sp = 0u;
  for (;;) {
    sum = 0u; cnt = 0u; mine = 0u;
#pragma unroll
    for (unsigned j = 0; j < 16; ++j) { const unsigned c = xb_ld(&bar[XB_XCNT(j)]); sum += c; cnt += (c > 0u) ? 1u : 0u; mine = (j == x) ? c : mine; }
    if (sum == G) break;
    __builtin_amdgcn_s_sleep(1);
    if ((++sp & 255u) == 0u) { if (xb_ld(&bar[XB_TMO])) break; if (sp > XB_SPIN_CAP) { atomicAdd(&bar[XB_TMO], 1u); break; } }
  }
  nloc = mine > 0u ? mine : 1u; nx = cnt > 0u ? cnt : 1u;
}

__device__ __forceinline__ void xcd_barrier(unsigned* bar, volatile LAS unsigned* st, bool leader_thread) {
  asm volatile("s_waitcnt vmcnt(0)" ::: "memory");
  __syncthreads();
  if (leader_thread) {
    const unsigned x = xb_xcc_id();
    __builtin_amdgcn_s_waitcnt(0);
    unsigned nloc = st[0], nx = st[1];
    if (nloc == 0u) { xcd_barrier_complete(bar, x, nloc, nx); st[0] = nloc; st[1] = nx; }
    const unsigned old = xb_add(&bar[XB_XSUB(x)], 1u);
    const unsigned gen = old / nloc;
    if (old + 1u == (gen + 1u) * nloc) {
      __builtin_amdgcn_fence(__ATOMIC_RELEASE, "agent");
      asm volatile("s_waitcnt vmcnt(0)" ::: "memory");
      const unsigned og = xb_add(&bar[XB_TOP], 1u);
      const unsigned tg = og / nx;
      if (og + 1u == (tg + 1u) * nx) xb_add(&bar[XB_TOPGEN], 1u);
      else XB_SPIN(xb_ld(&bar[XB_TOPGEN]) == tg, bar);
      __builtin_amdgcn_fence(__ATOMIC_ACQUIRE, "agent");
      xb_add(&bar[XB_XGEN(x)], 1u);
      asm volatile("s_waitcnt vmcnt(0)" ::: "memory");
    } else {
      XB_SPIN(xb_ld(&bar[XB_XGEN(x)]) == gen, bar);
      __builtin_amdgcn_fence(__ATOMIC_ACQUIRE, "agent");
      asm volatile("s_waitcnt vmcnt(0)" ::: "memory");
    }
  }
  __syncthreads();
}

#ifndef MULTI_LAUNCH
__global__ void __launch_bounds__(256, 2) mega(Params p, int plo, int phi, int coop) {
  extern __shared__ __attribute__((aligned(16))) char smem[];
  volatile LAS unsigned* st = (volatile LAS unsigned*)(smem + LDS_BYTES + 16);
  {
    const int t0 = opaque_tid(smem);
    if (t0 == 0) { st[0] = 0u; st[1] = 0u; (void)xb_add(&p.bar[XB_XCNT(xb_xcc_id())], 1u); }
    __syncthreads();
  }
  for (int ph = plo; ph < phi; ++ph) {
    run_phase(p, ph, smem);
    if (coop && ph + 1 < phi) {
      if (ph == 0) cg::this_grid().sync();
      else { const int tb = opaque_tid(smem); xcd_barrier(p.bar, st, tb == 0); }
    }
  }
}

#endif

static inline size_t align_up(size_t x) { return (x + 255) & ~(size_t)255; }

extern "C" void kernel_launch(void* const* d_in, const int* in_sizes, int n_in,
                              void* d_out, int out_size, void* d_ws, size_t ws_size,
                              hipStream_t stream) {
  Params p{};
  p.x[0] = (const float*)d_in[0];
  p.x[1] = (const float*)d_in[1];
  p.meta = (const float*)d_in[2];
  p.attn_norm = (const float*)d_in[3];
  p.w_in = (const float*)d_in[4];
  p.lb_logits = (const float*)d_in[5];
  p.w_gate = (const float*)d_in[6];
  p.b_gate = (const float*)d_in[7];
  p.norm_a = (const float*)d_in[8];
  p.norm_b = (const float*)d_in[9];
  p.w_out = (const float*)d_in[10];
  p.mlp_norm = (const float*)d_in[11];
  p.w_up = (const float*)d_in[12];
  p.w_down = (const float*)d_in[13];
  p.final_norm = (const float*)d_in[14];
  p.out = (float*)d_out;
  char* ws = (char*)d_ws;
  size_t off = 0;
  p.W = (bf16_t*)(ws + off); off = align_up(off + (size_t)2 * LSTRIDE * 2);
  p.X = (bf16_t*)(ws + off); off = align_up(off + (size_t)MROWS * 4096 * 2);
  p.R = (bf16_t*)(ws + off); off = align_up(off + (size_t)MROWS * 32 * 2);
  p.O = (bf16_t*)(ws + off); off = align_up(off + (size_t)MROWS * 2048 * 2);
  p.HB = (bf16_t*)(ws + off); off = align_up(off + (size_t)MROWS * 1024 * 2);
  p.RSA = (float*)(ws + off); off = align_up(off + (size_t)MROWS * 4);
  p.RSB = (float*)(ws + off); off = align_up(off + (size_t)MROWS * 4);
  p.ST = (bf16_t*)(ws + off); off = align_up(off + (size_t)512 * 8192 * 2);
  p.GD = (float*)(ws + off); off = align_up(off + (size_t)16 * 8 * 2 * 128 * 4);
  p.hmeta = (float*)(ws + off); off = align_up(off + (size_t)2 * 128 * 1024 * 4);
  p.bar = (unsigned*)(ws + off); off = align_up(off + (size_t)XCD_BAR_WORDS * 4);
  if (off > ws_size) { fprintf(stderr, "workspace too small: need %zu have %zu\n", off, ws_size); return; }

#ifdef MULTI_LAUNCH
#define LAUNCH_PK(ST, l, g) do { \
    static bool attr_set_##ST = false; \
    if (!attr_set_##ST) { (void)hipFuncSetAttribute((const void*)pk<ST>, hipFuncAttributeMaxDynamicSharedMemorySize, LDS_BYTES + 32); attr_set_##ST = true; } \
    hipLaunchKernelGGL(pk<ST>, dim3(512), dim3(256), LDS_BYTES + 32, stream, p, l, g); } while (0)
  LAUNCH_PK(100, 0, 0);
  for (int g = 0; g < 2; ++g)
    for (int l = 0; l < 2; ++l) {
      if (l == 0) LAUNCH_PK(102, l, g);
      LAUNCH_PK(0, l, g); LAUNCH_PK(1, l, g); LAUNCH_PK(2, l, g); LAUNCH_PK(3, l, g); LAUNCH_PK(4, l, g); LAUNCH_PK(5, l, g);
      LAUNCH_PK(6, l, g); LAUNCH_PK(7, l, g); LAUNCH_PK(8, l, g); LAUNCH_PK(9, l, g); LAUNCH_PK(10, l, g);
    }
  LAUNCH_PK(101, 0, 0);
#else
  static int grid_blocks = 0;
  if (!grid_blocks) {
    (void)hipFuncSetAttribute((const void*)mega, hipFuncAttributeMaxDynamicSharedMemorySize, LDS_BYTES + 32);
    int dev = 0, cus = 0, per_cu = 0;
    (void)hipGetDevice(&dev);
    (void)hipDeviceGetAttribute(&cus, hipDeviceAttributeMultiprocessorCount, dev);
    (void)hipOccupancyMaxActiveBlocksPerMultiprocessor(&per_cu, (const void*)mega, 256, LDS_BYTES + 32);
    if (per_cu < 1) per_cu = 1;
    if (per_cu > 2) per_cu = 2;
    grid_blocks = cus * per_cu;
  }
  (void)hipMemsetAsync(p.bar, 0, (size_t)XCD_BAR_WORDS * 4, stream);
  int plo = 0, phi = NPHASES, coop = 1;
  void* args[] = {&p, &plo, &phi, &coop};
  hipError_t e = hipLaunchCooperativeKernel((const void*)mega, dim3(grid_blocks), dim3(256), args, LDS_BYTES + 32, stream);
  if (e != hipSuccess) fprintf(stderr, "cooperative launch failed: %s (grid %d)\n", hipGetErrorString(e), grid_blocks);
#endif
}
```

```cpp
#include <hip/hip_runtime.h>
#include <hip/hip_cooperative_groups.h>
#include <stdint.h>
#include <stdio.h>
namespace cg = cooperative_groups;

typedef __attribute__((ext_vector_type(8))) short bf16x8;
typedef __attribute__((ext_vector_type(4))) float f32x4;
typedef unsigned short bf16_t;
typedef uint32_t u32x4 __attribute__((ext_vector_type(4)));
typedef uint32_t u32x2 __attribute__((ext_vector_type(2)));
typedef float fl4 __attribute__((ext_vector_type(4)));
#define MK4(a,b,c,d) ((u32x4){(uint32_t)(a),(uint32_t)(b),(uint32_t)(c),(uint32_t)(d)})
#define MK2(a,b) ((u32x2){(uint32_t)(a),(uint32_t)(b)})
#define MKF4(a,b,c,d) ((fl4){(a),(b),(c),(d)})

#define NTOKG 16384
#define MROWS 16512
#define MTILES 129
#define LSTRIDE 20185088
#define WOFF_A 0
#define WOFF_B (4096 * 1024)
#define WOFF_G (6400 * 1024)
#define WOFF_O (10496 * 1024)
#define WOFF_U (11520 * 1024)
#define WOFF_D (15616 * 1024)
#define LDS_BYTES 80896
#define NPHASES 48

struct Params {
  const float* x[2];
  const float* meta;
  const float* attn_norm;
  const float* w_in;
  const float* lb_logits;
  const float* w_gate;
  const float* b_gate;
  const float* norm_a;
  const float* norm_b;
  const float* w_out;
  const float* mlp_norm;
  const float* w_up;
  const float* w_down;
  const float* final_norm;
  float* out;
  bf16_t* W;
  bf16_t* X;
  bf16_t* R;
  bf16_t* O;
  bf16_t* HB;
  float* RSA;
  float* RSB;
  bf16_t* ST;
  float* GD;
  float* hmeta;
  unsigned* bar;
};

__device__ __forceinline__ uint32_t pack2(float a, float b) {
  uint32_t r;
  asm("v_cvt_pk_bf16_f32 %0, %1, %2" : "=v"(r) : "v"(a), "v"(b));
  return r;
}
__device__ __forceinline__ bf16_t f2bf(float f) { return (bf16_t)(pack2(f, f) & 0xffffu); }
__device__ __forceinline__ int opaque_tid(char* smem) {
  int lane;
  asm volatile("v_mbcnt_lo_u32_b32 %0, -1, 0\n\tv_mbcnt_hi_u32_b32 %0, -1, %0" : "=v"(lane));
  int* cnt = (int*)(smem + LDS_BYTES);
  int w = 0;
  if (lane == 0) w = atomicAdd(cnt, 1);
  w = __builtin_amdgcn_readfirstlane(w) & 3;
  __syncthreads();
  return w * 64 + lane;
}
__device__ __forceinline__ int opaque_bid() { int b = blockIdx.x; asm volatile("" : "+s"(b)); return b; }
template <int M>
__device__ __forceinline__ float shx(float v, int lane) {
  if (M < 32) return __builtin_bit_cast(float, __builtin_amdgcn_ds_swizzle(__builtin_bit_cast(int, v), 0x1f | (M << 10)));
  return __builtin_bit_cast(float, __builtin_amdgcn_ds_bpermute((lane ^ M) << 2, __builtin_bit_cast(int, v)));
}
__device__ __forceinline__ float bf2f(bf16_t b) { return __uint_as_float(((uint32_t)b) << 16); }
__device__ __forceinline__ size_t tiled_off(size_t row, int col, int K) {
  return (((row >> 7) * (size_t)(K >> 5) + (size_t)(col >> 5)) * 128 + (row & 127)) * 32 + (size_t)(col & 31);
}
__device__ __forceinline__ float sigmoidf_(float x) { return __builtin_amdgcn_rcpf(1.f + __builtin_amdgcn_exp2f(x * -1.4426950408889634f)); }

__device__ __forceinline__ int w_in_col(int R, float& scale) {
  scale = 1.f;
  if (R < 4096) return R;
  if (R < 6400) {
    int n = R - 4096;
    if (n >= 2080) return -1;
    if (n < 512) scale = 0.08838834764831845f;
    return 5120 + n;
  }
  int n = R - 6400;
  int tt = n >> 8, wv = n & 255;
  int wn = wv >> 7, nl = wv & 127;
  int qd = nl >> 5, ni = (nl >> 2) & 7, r = nl & 3;
  int grp = ni >> 2, seg = ni & 3;
  int ucol = tt * 64 + wn * 32 + qd * 8 + grp * 4 + r;
  int base = seg == 0 ? 4096 : seg == 1 ? 8224 : seg == 2 ? 7200 : 9248;
  return base + ucol;
}

__device__ __forceinline__ void phase_init(const Params& p, char* smem) {
  const int t = opaque_tid(smem);
  const int bid_ = opaque_bid();
  for (int idx = bid_ * 256 + t; idx < 2 * 128 * 256; idx += gridDim.x * 256) {
    int g = idx / (128 * 256), r = (idx / 256) % 128, c4 = idx % 256;
    int nvalid = g == 0 ? 16 : 64;
    fl4 v = MKF4(0.f, 0.f, 0.f, 0.f);
    if (r < nvalid) v = *(const fl4*)(p.meta + (size_t)(r & 15) * 1024 + c4 * 4);
    *(fl4*)(p.hmeta + ((size_t)g * 128 + r) * 1024 + c4 * 4) = v;
  }
  float* tile = (float*)smem;
  const int per_layer = 3904 + 1024;
  for (int id = bid_; id < 2 * per_layer; id += gridDim.x) {
    int l = id / per_layer, r = id % per_layer;
    const float* src; int ld; const float* gain = nullptr; int K, n0, k0;
    bf16_t* dst;
    int kind;
    int cbase = 0;
    if (r < 3904) {
      int rt = r >> 4, kt = r & 15;
      n0 = rt * 64; k0 = kt * 64; K = 1024;
      dst = p.W + (size_t)l * LSTRIDE;
      if (n0 < 10496) { kind = 0; src = p.w_in + (size_t)l * 1024 * 10272; ld = 10272; gain = p.attn_norm + l * 1024; }
      else if (n0 < 11520) { kind = 1; src = p.w_out + (size_t)l * 1024 * 1024; ld = 1024; cbase = n0 - 10496; }
      else { kind = 1; src = p.w_up + (size_t)l * 1024 * 4096; ld = 4096; cbase = n0 - 11520; gain = p.mlp_norm + l * 1024; }
    } else {
      int r2 = r - 3904;
      int rt = r2 >> 6, kt = r2 & 63;
      n0 = rt * 64; k0 = kt * 64; K = 4096;
      dst = p.W + (size_t)l * LSTRIDE + WOFF_D;
      kind = 1; src = p.w_down + (size_t)l * 4096 * 1024; ld = 1024; cbase = n0;
    }
    {
      int n = t & 63;
      float scale = 1.f; int col;
      if (kind == 0) col = w_in_col(n0 + n, scale); else col = cbase + n;
#pragma unroll 4
      for (int i = 0; i < 16; ++i) {
        int kk = (t >> 6) + 4 * i;
        float v = 0.f;
        if (col >= 0) {
          v = src[(size_t)(k0 + kk) * ld + col] * scale;
          if (gain) v *= gain[k0 + kk];
        }
        tile[kk * 65 + n] = v;
      }
    }
    __syncthreads();
    {
      int n = t >> 2, piece = t & 3;
      uint32_t pk[8];
#pragma unroll
      for (int e = 0; e < 8; ++e) {
        float a = tile[(piece * 16 + 2 * e) * 65 + n];
        float b = tile[(piece * 16 + 2 * e + 1) * 65 + n];
        pk[e] = pack2(a, b);
      }
      const int Rr = n0 + n, kk = k0 + piece * 16;
      u32x4* d = (u32x4*)(dst + ((size_t)((Rr >> 8) * (K >> 5) + (kk >> 5)) * 256 + (Rr & 255)) * 32 + (kk & 31));
      d[0] = MK4(pk[0], pk[1], pk[2], pk[3]);
      d[1] = MK4(pk[4], pk[5], pk[6], pk[7]);
    }
    __syncthreads();
  }
}

enum { EPI_G1A = 0, EPI_G1B, EPI_GATES, EPI_WOUT, EPI_UP, EPI_DOWN };

template <int EPI>
__device__ __forceinline__ void gemm_phase(const Params& p, int l, int g, char* smem) {
  constexpr bool NORM = (EPI == EPI_G1A || EPI == EPI_G1B || EPI == EPI_GATES || EPI == EPI_UP);
  constexpr int K = (EPI == EPI_DOWN) ? 4096 : 1024;
  constexpr int NT = EPI == EPI_G1A ? 16 : EPI == EPI_G1B ? 9 : EPI == EPI_GATES ? 16 : EPI == EPI_WOUT ? 4 : EPI == EPI_UP ? 16 : 4;
  constexpr int WOFF = EPI == EPI_G1A ? WOFF_A : EPI == EPI_G1B ? WOFF_B : EPI == EPI_GATES ? WOFF_G : EPI == EPI_WOUT ? WOFF_O : EPI == EPI_UP ? WOFF_U : WOFF_D;
  constexpr int NK = K / 32;
  const bf16_t* Wl = p.W + (size_t)l * LSTRIDE + WOFF;
  bf16_t* As = (bf16_t*)smem;
  bf16_t* Bs = As + 2 * 128 * 32;
  float* rss = (float*)(Bs + 2 * 256 * 32);
  const int bid_ = opaque_bid();
  const int t = opaque_tid(smem), lane = t & 63, w = t >> 6, wm = w >> 1, wn = w & 1;
  const int quad = lane >> 4, l15 = lane & 15;
  const int nvalid_meta = g == 0 ? 16 : 64;

  if (EPI == EPI_G1A) for (int i = bid_ * 256 + t; i < MROWS; i += gridDim.x * 256) p.RSB[i] = 0.f;
  if (EPI == EPI_UP) for (int i = bid_ * 256 + t; i < MROWS; i += gridDim.x * 256) p.RSA[i] = 0.f;
  bool pre = false;
  for (int tile = bid_; tile < MTILES * NT; tile += gridDim.x) {
    const int mt = tile / NT, nt = tile % NT;
    const bf16_t* Ab = NORM ? p.HB + (size_t)mt * 128 * 1024 : p.X + (size_t)mt * 128 * K;
    const bf16_t* Bg = Wl + (size_t)nt * 256 * K;
    const bool do_mma = !(mt == 128 && wm == 1) && !(EPI == EPI_G1B && nt == 8 && wn == 1);

    f32x4 acc[4][8];
#pragma unroll
    for (int a = 0; a < 4; ++a)
#pragma unroll
      for (int b = 0; b < 8; ++b) acc[a][b] = (f32x4){0.f, 0.f, 0.f, 0.f};
    int t_l = t;
    asm volatile("" : "+v"(t_l));
    const uint32_t voffA = (uint32_t)((t_l >> 2) * 64 + (((t_l & 3) ^ (((t_l >> 5) & 1) << 1)) * 16));
    const uint32_t voffB0 = (uint32_t)((t_l >> 2) * 64 + ((t_l & 3) * 16));
    const uint32_t voffB1 = (uint32_t)((t_l >> 2) * 64 + (((t_l & 3) ^ 2) * 16));
    const char* Abase = (const char*)Ab;
    const char* Bbase = (const char*)Bg;
    const int rpiece = quad ^ (((l15 >> 3) & 1) << 1);
    const int w_s = __builtin_amdgcn_readfirstlane(t_l >> 6);
#define GLDS(gp, lp) __builtin_amdgcn_global_load_lds((const __attribute__((address_space(1))) void*)(gp), (__attribute__((address_space(3))) void*)(lp), 16, 0, 0)
#define G_DMA(KT, BUF) G_DMA2(Abase, Bbase, KT, BUF)
#define G_DMA2(AB_, BB_, KT, BUF) do { \
      const char* ua = (AB_) + (size_t)(KT) * 8192; const char* ub = (BB_) + (size_t)(KT) * 16384; \
      asm volatile("" : "+s"(ua), "+s"(ub));     \
      char* la = (char*)(As + (BUF) * 4096) + w_s * 1024; char* lb = (char*)(Bs + (BUF) * 8192) + w_s * 1024;     \
      _Pragma("unroll") for (int i = 0; i < 2; ++i) GLDS(ua + i * 4096 + voffA, la + i * 4096); \
      _Pragma("unroll") for (int i = 0; i < 4; ++i) GLDS(ub + i * 4096 + ((i & 1) ? voffB1 : voffB0), lb + i * 4096); } while (0)
#define G_COMPUTE(BUF) do { \
      if (do_mma) { \
      const bf16_t* Aw = As + (BUF) * 4096; const bf16_t* Bw = Bs + (BUF) * 8192; \
      bf16x8 af[4], bfr[8]; \
      _Pragma("unroll") for (int mi = 0; mi < 4; ++mi) af[mi] = *(const bf16x8*)(Aw + (wm * 64 + mi * 16 + l15) * 32 + rpiece * 8); \
      _Pragma("unroll") for (int ni = 0; ni < 8; ++ni) bfr[ni] = *(const bf16x8*)(Bw + (wn * 128 + (l15 >> 2) * 32 + ni * 4 + (l15 & 3)) * 32 + rpiece * 8); \
      __builtin_amdgcn_s_setprio(1); \
      _Pragma("unroll") for (int ni = 0; ni < 8; ++ni) \
        _Pragma("unroll") for (int mi = 0; mi < 4; ++mi) \
          acc[mi][ni] = __builtin_amdgcn_mfma_f32_16x16x32_bf16(bfr[ni], af[mi], acc[mi][ni], 0, 0, 0); \
      __builtin_amdgcn_s_setprio(0); } } while (0)

    if (!pre) G_DMA(0, 0);
#pragma unroll 1
    for (int kt = 0; kt < NK; kt += 2) {
      asm volatile("s_waitcnt vmcnt(0)" ::: "memory");
      __syncthreads();
      G_DMA(kt + 1, 1);
      G_COMPUTE(0);
      asm volatile("s_waitcnt vmcnt(0)" ::: "memory");
      __syncthreads();
      { const int kn = (kt + 2 < NK) ? kt + 2 : NK - 1; G_DMA(kn, 0); }
      G_COMPUTE(1);
    }
    asm volatile("s_waitcnt vmcnt(0)" ::: "memory");
    __syncthreads();
    {
      const int tile2 = tile + (int)gridDim.x;
      pre = tile2 < MTILES * NT;
      if (pre) {
        const int mt2 = tile2 / NT, nt2 = tile2 % NT;
        const char* Ab2 = (const char*)(NORM ? p.HB + (size_t)mt2 * 128 * 1024 : p.X + (size_t)mt2 * 128 * K);
        const char* Bg2 = (const char*)(Wl + (size_t)nt2 * 256 * K);
        G_DMA2(Ab2, Bg2, 0, 0);
      }
    }
#undef GLDS
#undef G_DMA
#undef G_DMA2
#undef G_COMPUTE

    int quad_e = quad, l15_e = l15, t_e = t;
    asm volatile("" : "+v"(quad_e), "+v"(l15_e), "+v"(t_e));
    if (do_mma) {
#pragma unroll
    for (int mi = 0; mi < 4; ++mi) {
      __builtin_amdgcn_sched_barrier(0);
      const int rl = wm * 64 + mi * 16 + l15_e;
      const size_t grow = (size_t)mt * 128 + rl;
      const float rs = NORM ? rsqrtf((EPI == EPI_UP ? p.RSB : p.RSA)[grow] * (1.f / 1024.f) + 1e-6f) : 1.f;
      const int cw = wn * 128 + quad_e * 32;
      if (EPI == EPI_G1A) {
        const int region = nt >> 2;
        bf16_t* xp = p.X + grow * 4096 + nt * 256 + cw;
#pragma unroll
        for (int c = 0; c < 4; ++c) {
          float v[8];
#pragma unroll
          for (int e = 0; e < 8; ++e) v[e] = acc[mi][2 * c + (e >> 2)][e & 3] * rs;
          if (region == 1 || region == 2) {
            float lb[8] = {0.f, 0.f, 0.f, 0.f, 0.f, 0.f, 0.f, 0.f};
            if (l == 1) {
              const float* l0p = p.lb_logits + (region - 1) * 1024 + ((nt * 256 + cw + c * 8) & 1023);
              const fl4 a0 = *(const fl4*)l0p, a1 = *(const fl4*)(l0p + 4);
              const fl4 b0 = *(const fl4*)(l0p + 2048), b1 = *(const fl4*)(l0p + 2052);
              lb[0] = sigmoidf_(b0.x - a0.x); lb[1] = sigmoidf_(b0.y - a0.y);
              lb[2] = sigmoidf_(b0.z - a0.z); lb[3] = sigmoidf_(b0.w - a0.w);
              lb[4] = sigmoidf_(b1.x - a1.x); lb[5] = sigmoidf_(b1.y - a1.y);
              lb[6] = sigmoidf_(b1.z - a1.z); lb[7] = sigmoidf_(b1.w - a1.w);
            }
#pragma unroll
            for (int e = 0; e < 8; ++e) {
              const float f = fmaxf(lb[e], 1e-30f) + (1.f - lb[e]) * sigmoidf_(v[e]);
              v[e] = __builtin_amdgcn_logf(f);
            }
          }
          *(u32x4*)(xp + c * 8) = MK4(pack2(v[0], v[1]), pack2(v[2], v[3]), pack2(v[4], v[5]), pack2(v[6], v[7]));
        }
      } else if (EPI == EPI_G1B) {
        if (nt < 8) {
          bf16_t* xp = p.X + grow * 2048 + nt * 256 + cw;
#pragma unroll
          for (int c = 0; c < 4; ++c)
            *(u32x4*)(xp + c * 8) = MK4(pack2(acc[mi][2 * c][0] * rs, acc[mi][2 * c][1] * rs), pack2(acc[mi][2 * c][2] * rs, acc[mi][2 * c][3] * rs),
                                        pack2(acc[mi][2 * c + 1][0] * rs, acc[mi][2 * c + 1][1] * rs), pack2(acc[mi][2 * c + 1][2] * rs, acc[mi][2 * c + 1][3] * rs));
        } else if (cw == 0) {
          bf16_t* rp = p.R + grow * 32;
#pragma unroll
          for (int c = 0; c < 4; ++c)
            *(u32x4*)(rp + c * 8) = MK4(pack2(acc[mi][2 * c][0] * rs, acc[mi][2 * c][1] * rs), pack2(acc[mi][2 * c][2] * rs, acc[mi][2 * c][3] * rs),
                                        pack2(acc[mi][2 * c + 1][0] * rs, acc[mi][2 * c + 1][1] * rs), pack2(acc[mi][2 * c + 1][2] * rs, acc[mi][2 * c + 1][3] * rs));
        }
      } else if (EPI == EPI_GATES) {
        const int uc = nt * 64 + wn * 32 + quad_e * 8;
        const u32x4 oa = *(const u32x4*)(p.O + grow * 2048 + uc);
        const u32x4 ob = *(const u32x4*)(p.O + grow * 2048 + 1024 + uc);
        const uint32_t oau[4] = {oa.x, oa.y, oa.z, oa.w}, obu[4] = {ob.x, ob.y, ob.z, ob.w};
        float u[8];
#pragma unroll
        for (int grp = 0; grp < 2; ++grp)
#pragma unroll
          for (int r = 0; r < 4; ++r) {
            const int idx = grp * 4 + r;
            const float ga = acc[mi][grp * 4 + 0][r] * rs, ma = acc[mi][grp * 4 + 1][r] * rs;
            const float gb = acc[mi][grp * 4 + 2][r] * rs, mb = acc[mi][grp * 4 + 3][r] * rs;
            const float ona = (idx & 1) ? __uint_as_float(oau[idx >> 1] & 0xffff0000u) : __uint_as_float(oau[idx >> 1] << 16);
            const float onb = (idx & 1) ? __uint_as_float(obu[idx >> 1] & 0xffff0000u) : __uint_as_float(obu[idx >> 1] << 16);
            u[idx] = sigmoidf_(ma) * (ga * sigmoidf_(ga)) * ona + sigmoidf_(mb) * (gb * sigmoidf_(gb)) * onb;
          }
        *(u32x4*)(p.X + tiled_off(grow, uc, 1024)) = MK4(pack2(u[0], u[1]), pack2(u[2], u[3]), pack2(u[4], u[5]), pack2(u[6], u[7]));
      } else if (EPI == EPI_WOUT || EPI == EPI_DOWN) {
        const bool meta = (mt == 128);
        float hsq = 0.f;
        if (!meta || rl < nvalid_meta) {
          const float* hin; float* hout;
          if (meta) { hout = p.hmeta + ((size_t)g * 128 + rl) * 1024; hin = hout; }
          else {
            const size_t trow = (size_t)mt * 128 + rl;
            hout = p.out + ((size_t)g * NTOKG + trow) * 1024;
            hin = (EPI == EPI_WOUT && l == 0) ? p.x[g] + trow * 1024 : hout;
          }
          const int col0 = nt * 256 + cw;
          bf16_t* hb = p.HB + tiled_off(grow, col0, 1024);
#pragma unroll
          for (int c = 0; c < 4; ++c) {
            const fl4 h0 = *(const fl4*)(hin + col0 + c * 8), h1 = *(const fl4*)(hin + col0 + c * 8 + 4);
            const fl4 o0 = MKF4(h0.x + acc[mi][2 * c][0], h0.y + acc[mi][2 * c][1], h0.z + acc[mi][2 * c][2], h0.w + acc[mi][2 * c][3]);
            const fl4 o1 = MKF4(h1.x + acc[mi][2 * c + 1][0], h1.y + acc[mi][2 * c + 1][1], h1.z + acc[mi][2 * c + 1][2], h1.w + acc[mi][2 * c + 1][3]);
            *(fl4*)(hout + col0 + c * 8) = o0;
            *(fl4*)(hout + col0 + c * 8 + 4) = o1;
            *(u32x4*)(hb + c * 8) = MK4(pack2(o0.x, o0.y), pack2(o0.z, o0.w), pack2(o1.x, o1.y), pack2(o1.z, o1.w));
            hsq += o0.x * o0.x + o0.y * o0.y + o0.z * o0.z + o0.w * o0.w + o1.x * o1.x + o1.y * o1.y + o1.z * o1.z + o1.w * o1.w;
          }
        }
        hsq += shx<16>(hsq, lane); hsq += shx<32>(hsq, lane);
        if (quad_e == 0 && (!meta || rl < nvalid_meta)) atomicAdd((EPI == EPI_WOUT ? p.RSB : p.RSA) + grow, hsq);
      } else if (EPI == EPI_UP) {
        bf16_t* xp = p.X + tiled_off(grow, nt * 256 + cw, 4096);
#pragma unroll
        for (int c = 0; c < 4; ++c) {
          float v[8];
#pragma unroll
          for (int e = 0; e < 8; ++e) { const float a = fmaxf(acc[mi][2 * c + (e >> 2)][e & 3] * rs, 0.f); v[e] = a * a; }
          *(u32x4*)(xp + c * 8) = MK4(pack2(v[0], v[1]), pack2(v[2], v[3]), pack2(v[4], v[5]), pack2(v[6], v[7]));
        }
      }
    }
    }
  }
}

template <int MIX, int PASS>
__device__ __forceinline__ void scan_phase(const Params& p, int l, int g, char* smem) {
  constexpr int NH = MIX ? 4 : 8;
  constexpr int NDV = MIX ? 4 : 2;
  constexpr int XLD = MIX ? 2048 : 4096;
  bf16_t* QS = (bf16_t*)smem;
  bf16_t* KS = QS + 64 * 136;
  bf16_t* KT = KS + 64 * 136;
  bf16_t* LG = KT;
  bf16_t* Pm = QS;
  bf16_t* SmT = KS;
  bf16_t* VT = KT + 128 * 72;
  bf16_t* RS = VT + 64 * 72;
  float* em = (float*)(RS + 64 * 24);
  float* el = em + 128;
  float* tot = el + 128;
  const int bid_ = opaque_bid();
  const int t_outer = opaque_tid(smem);
  const int sps = g == 0 ? 16 : 4;
  constexpr bool do_out = (PASS == 3);
  const bf16_t* Xg = p.X;

  for (int item = bid_; item < 512; item += gridDim.x) {
    int t = t_outer;
    asm volatile("" : "+v"(t));
    const int lane = t & 63, w = t >> 6, quad = lane >> 4, l15 = lane & 15;
    const int dir = item & 1;
    const int dvb = (item >> 1) % NDV;
    const int head = ((item >> 1) / NDV) % NH;
    const int seg = item >> 5;
    const int seq = seg / sps;
    const bool first = (seg % sps) == 0;
    const int nsteps = 16 + (first ? 1 : 0);
    int qcol, kcol, vcol;
    bf16_t* Og; int OLD;
    if (MIX == 0) {
      qcol = head * 128; kcol = 1024 + dir * 1024 + head * 128; vcol = 3072 + head * 128 + dvb * 64;
      Og = p.O + dir * 1024 + head * 128 + dvb * 64; OLD = 2048;
    } else {
      qcol = head * 128; kcol = 512 + head * 128; vcol = 1024 + head * 256 + dvb * 64;
      Og = p.X + (size_t)MROWS * 2048 + (size_t)dir * MROWS * 1024 + head * 256 + dvb * 64; OLD = 1024;
    }
    bf16x8 wgf[2]; float bgv[2][4];
    if (MIX == 1) {
#pragma unroll
      for (int ct = 0; ct < 2; ++ct) {
        const int cc = 16 * (2 * w + ct) + l15;
        bf16x8 v = (bf16x8){0, 0, 0, 0, 0, 0, 0, 0};
        if (quad < 2) {
#pragma unroll
          for (int e = 0; e < 8; ++e)
            v[e] = (short)f2bf(p.w_gate[((size_t)(l * 2 + dir) * 16 + quad * 8 + e) * 512 + head * 128 + cc]);
        }
        wgf[ct] = v;
#pragma unroll
        for (int r = 0; r < 4; ++r) bgv[ct][r] = p.b_gate[(l * 2 + dir) * 512 + head * 128 + 16 * (2 * w + ct) + quad * 4 + r];
      }
    }
    f32x4 S[8];
#pragma unroll
    for (int a = 0; a < 8; ++a) S[a] = (f32x4){0.f, 0.f, 0.f, 0.f};
    if (do_out) {
      int s2 = dir == 0 ? seq * sps : seq * sps + sps - 1;
      const int stp = dir == 0 ? 1 : -1;
      for (; s2 != seg; s2 += stp) {
        const int item2 = ((s2 * NH + head) * NDV + dvb) * 2 + dir;
        const bf16_t* L = p.ST + (size_t)item2 * 8192;
        const float* G = p.GD + ((s2 * 8 + head) * 2 + dir) * 128;
#pragma unroll
        for (int a = 0; a < 8; ++a)
#pragma unroll
          for (int r = 0; r < 4; ++r) {
            const int k = 16 * (2 * w + (a >> 2)) + quad * 4 + r;
            S[a][r] = __builtin_amdgcn_exp2f(G[k]) * S[a][r] + bf2f(L[(a * 4 + r) * 256 + t]);
          }
      }
    }
    float gacc0 = 0.f, gacc1 = 0.f;

    u32x4 qr[4], kr[4], vr[2], rr;
    auto step_rows = [&](int s, int& rowbase, int& nv) {
      bool meta;
      if (dir == 0) { meta = first && s == 0; rowbase = (seg * 16 + s - (first ? 1 : 0)) * 64; }
      else { meta = (s == 16); rowbase = (seg * 16 + 15 - s) * 64; }
      if (meta) { rowbase = NTOKG + seq * 16; nv = 16; } else nv = 64;
    };
    const char* Xq = (const char*)(Xg + qcol);
    const char* Xk = (const char*)(Xg + kcol);
    const char* Xv = (const char*)(Xg + vcol);
    const char* Rb = (const char*)(p.R + dir * 16);
    auto gload = [&](int s) {
      int rowbase, nv; step_rows(s, rowbase, nv);
#pragma unroll
      for (int j = 0; j < 4; ++j) {
        const int i = (t >> 4) + 16 * j;
        const int mr = dir ? rowbase + nv - 1 - i : rowbase + i;
        u32x4 z = MK4(0, 0, 0, 0);
        if (i < nv) {
          const uint32_t vo = (uint32_t)(mr * XLD + (t & 15) * 8) * 2u;
          qr[j] = do_out ? *(const u32x4*)(Xq + vo) : z;
          kr[j] = *(const u32x4*)(Xk + vo);
        } else { qr[j] = z; kr[j] = z; }
      }
      {
        const int i = t >> 2;
        const int mr = dir ? rowbase + nv - 1 - i : rowbase + i;
        vr[0] = MK4(0, 0, 0, 0); vr[1] = vr[0];
        if (i < nv) {
          const uint32_t vo = (uint32_t)(mr * XLD + (t & 3) * 16) * 2u;
          vr[0] = *(const u32x4*)(Xv + vo); vr[1] = *(const u32x4*)(Xv + vo + 16);
        }
      }
      if (MIX == 1) {
        rr = MK4(0, 0, 0, 0);
        if (t < 128) {
          const int i = t >> 1;
          const int mr = dir ? rowbase + nv - 1 - i : rowbase + i;
          if (i < nv) rr = *(const u32x4*)(Rb + (uint32_t)(mr * 32 + (t & 1) * 8) * 2u);
        }
      }
    };
    gload(0);

    for (int s = 0; s < nsteps; ++s) {
      int rowbase, nv; step_rows(s, rowbase, nv);
#pragma unroll
      for (int j = 0; j < 4; ++j) {
        const int i = (t >> 4) + 16 * j;
        if (do_out) *(u32x4*)(QS + i * 136 + (t & 15) * 8) = qr[j];
        *(u32x4*)(KS + i * 136 + (t & 15) * 8) = kr[j];
      }
      {
        const int i = t >> 2, piece = t & 3;
        uint32_t vv[8] = {vr[0].x, vr[0].y, vr[0].z, vr[0].w, vr[1].x, vr[1].y, vr[1].z, vr[1].w};
        bf16_t* vtw = VT + piece * 16 * 72 + i;
#pragma unroll
        for (int e = 0; e < 16; ++e) vtw[e * 72] = (bf16_t)((vv[e >> 1] >> ((e & 1) * 16)) & 0xffffu);
      }
      if (MIX == 1 && t < 128) *(u32x4*)(RS + (t >> 1) * 24 + (t & 1) * 8) = rr;
      if (s + 1 < nsteps) gload(s + 1);
      __syncthreads();
      if (MIX == 1) {
        bf16x8 af[4];
#pragma unroll
        for (int it = 0; it < 4; ++it) {
          af[it] = (bf16x8){0, 0, 0, 0, 0, 0, 0, 0};
          if (quad < 2) af[it] = *(const bf16x8*)(RS + (16 * it + l15) * 24 + quad * 8);
        }
#pragma unroll
        for (int ct = 0; ct < 2; ++ct)
#pragma unroll
          for (int it = 0; it < 4; ++it) {
            f32x4 z = __builtin_amdgcn_mfma_f32_16x16x32_bf16(wgf[ct], af[it], (f32x4){0.f, 0.f, 0.f, 0.f}, 0, 0, 0);
            float ls[4];
#pragma unroll
            for (int r = 0; r < 4; ++r) {
              const float zz = fmaxf(z[r] + bgv[ct][r], -80.f);
              ls[r] = __builtin_amdgcn_logf(1.f + __builtin_amdgcn_exp2f(zz * -1.4426950408889634f)) * -0.0625f;
            }
            *(u32x2*)(LG + (16 * it + l15) * 128 + 16 * (2 * w + ct) + quad * 4) = MK2(pack2(ls[0], ls[1]), pack2(ls[2], ls[3]));
          }
        __syncthreads();
      }
      const int cp = t & 63, rg = t >> 6;
      const int nvl = nv - 16 * rg;
      float p0[16], p1[16];
      {
        float run0 = 0.f, run1 = 0.f;
        constexpr int LFS32 = (MIX == 0) ? 68 : 64;
        const uint32_t* lfp = (const uint32_t*)((MIX == 0) ? (KS + 16 * rg * 136) : (LG + 16 * rg * 128)) + cp;
#pragma unroll
        for (int ii = 0; ii < 16; ++ii) {
          if ((ii & 7) == 0) __builtin_amdgcn_sched_barrier(0);
          const uint32_t u = lfp[ii * LFS32];
          float l0 = __uint_as_float(u << 16), l1 = __uint_as_float(u & 0xffff0000u);
          if (ii >= nvl) { l0 = 0.f; l1 = 0.f; }
          run0 += l0; run1 += l1;
          p0[ii] = run0; p1[ii] = run1;
        }
        *(float2*)(tot + rg * 128 + 2 * cp) = make_float2(run0, run1);
      }
      __syncthreads();
      {
        const float2 ta = *(const float2*)(tot + 2 * cp), tb = *(const float2*)(tot + 128 + 2 * cp);
        const float2 tc = *(const float2*)(tot + 256 + 2 * cp), td = *(const float2*)(tot + 384 + 2 * cp);
        const float m0 = ta.x + tb.x, m1 = ta.y + tb.y;
        const float base0 = (rg > 0 ? ta.x : 0.f) + (rg > 1 ? tb.x : 0.f) + (rg > 2 ? tc.x : 0.f);
        const float base1 = (rg > 0 ? ta.y : 0.f) + (rg > 1 ? tb.y : 0.f) + (rg > 2 ? tc.y : 0.f);
        uint32_t* qp = (uint32_t*)(QS + 16 * rg * 136) + cp;
        uint32_t* kp = (uint32_t*)(KS + 16 * rg * 136) + cp;
        float skp0 = __builtin_amdgcn_exp2f(-fminf(fmaxf(base0 - m0, -115.f), 115.f));
        float skp1 = __builtin_amdgcn_exp2f(-fminf(fmaxf(base1 - m1, -115.f), 115.f));
        uint32_t kt0[8], kt1[8], kkprev = 0;
#pragma unroll
        for (int ii = 0; ii < 16; ++ii) {
          if ((ii & 3) == 0) __builtin_amdgcn_sched_barrier(0);
          const float e0 = fminf(fmaxf(base0 + p0[ii] - m0, -115.f), 115.f);
          const float e1 = fminf(fmaxf(base1 + p1[ii] - m1, -115.f), 115.f);
          const float sq0 = __builtin_amdgcn_exp2f(e0), sq1 = __builtin_amdgcn_exp2f(e1);
          const float sk0 = __builtin_amdgcn_rcpf(sq0), sk1 = __builtin_amdgcn_rcpf(sq1);
          if (do_out) {
            const uint32_t uq = qp[ii * 68];
            qp[ii * 68] = pack2(__uint_as_float(uq << 16) * sq0, __uint_as_float(uq & 0xffff0000u) * sq1);
          }
          float k0, k1;
          if (MIX == 0) { k0 = 1.f - sq0 * skp0; k1 = 1.f - sq1 * skp1; skp0 = sk0; skp1 = sk1; }
          else { const uint32_t uk = kp[ii * 68]; k0 = __uint_as_float(uk << 16); k1 = __uint_as_float(uk & 0xffff0000u); }
          const uint32_t kk = pack2(k0 * sk0, k1 * sk1);
          if (do_out) kp[ii * 68] = kk;
          if (ii & 1) {
            kt0[ii >> 1] = __builtin_amdgcn_perm(kk, kkprev, 0x05040100u);
            kt1[ii >> 1] = __builtin_amdgcn_perm(kk, kkprev, 0x07060302u);
          } else kkprev = kk;
        }
        u32x4* kd0 = (u32x4*)(KT + (2 * cp) * 72 + 16 * rg);
        u32x4* kd1 = (u32x4*)(KT + (2 * cp + 1) * 72 + 16 * rg);
        kd0[0] = MK4(kt0[0], kt0[1], kt0[2], kt0[3]); kd0[1] = MK4(kt0[4], kt0[5], kt0[6], kt0[7]);
        kd1[0] = MK4(kt1[0], kt1[1], kt1[2], kt1[3]); kd1[1] = MK4(kt1[4], kt1[5], kt1[6], kt1[7]);
        if (rg == 0) {
          *(float2*)(em + 2 * cp) = make_float2(__builtin_amdgcn_exp2f(m0), __builtin_amdgcn_exp2f(m1));
          *(float2*)(el + 2 * cp) = make_float2(__builtin_amdgcn_exp2f(tc.x + td.x), __builtin_amdgcn_exp2f(tc.y + td.y));
        }
        gacc0 += m0 + tc.x + td.x; gacc1 += m1 + tc.y + td.y;
      }
      __syncthreads();
      if (do_out) {
        bf16x8 qf[4];
#pragma unroll
        for (int ks = 0; ks < 4; ++ks) qf[ks] = *(const bf16x8*)(QS + (16 * w + l15) * 136 + ks * 32 + quad * 8);
        f32x4 pa[4];
#pragma unroll
        for (int jt = 0; jt < 4; ++jt) {
          pa[jt] = (f32x4){0.f, 0.f, 0.f, 0.f};
          if (jt <= w) {
#pragma unroll
            for (int ks = 0; ks < 4; ++ks) {
              bf16x8 kf = *(const bf16x8*)(KS + (16 * jt + l15) * 136 + ks * 32 + quad * 8);
              pa[jt] = __builtin_amdgcn_mfma_f32_16x16x32_bf16(kf, qf[ks], pa[jt], 0, 0, 0);
            }
          }
        }
        __syncthreads();
        {
          const int i = 16 * w + l15;
          bf16_t* pw = Pm + i * 72 + quad * 4;
#pragma unroll
          for (int jt = 0; jt < 4; ++jt) {
            const int j0 = 16 * jt + quad * 4;
            float pv[4];
#pragma unroll
            for (int r = 0; r < 4; ++r) pv[r] = (jt <= w && j0 + r <= i) ? pa[jt][r] : 0.f;
            *(u32x2*)(pw + 16 * jt) = MK2(pack2(pv[0], pv[1]), pack2(pv[2], pv[3]));
          }
        }
#pragma unroll
        for (int a = 0; a < 8; ++a) {
          const int k0 = 16 * (2 * w + (a >> 2)) + quad * 4;
          const int v = 16 * (a & 3) + l15;
          const fl4 e = *(const fl4*)(em + k0);
          S[a][0] *= e.x; S[a][1] *= e.y; S[a][2] *= e.z; S[a][3] *= e.w;
          *(u32x2*)(SmT + v * 136 + k0) = MK2(pack2(S[a][0], S[a][1]), pack2(S[a][2], S[a][3]));
        }
        __syncthreads();
        f32x4 oa[4];
#pragma unroll
        for (int vt = 0; vt < 4; ++vt) {
          oa[vt] = (f32x4){0.f, 0.f, 0.f, 0.f};
#pragma unroll
          for (int ks = 0; ks < 4; ++ks) {
            bf16x8 sf = *(const bf16x8*)(SmT + (16 * vt + l15) * 136 + ks * 32 + quad * 8);
            oa[vt] = __builtin_amdgcn_mfma_f32_16x16x32_bf16(sf, qf[ks], oa[vt], 0, 0, 0);
          }
        }
#pragma unroll
        for (int js = 0; js < 2; ++js) {
          bf16x8 pfr = *(const bf16x8*)(Pm + (16 * w + l15) * 72 + js * 32 + quad * 8);
#pragma unroll
          for (int vt = 0; vt < 4; ++vt) {
            bf16x8 vf = *(const bf16x8*)(VT + (16 * vt + l15) * 72 + js * 32 + quad * 8);
            oa[vt] = __builtin_amdgcn_mfma_f32_16x16x32_bf16(vf, pfr, oa[vt], 0, 0, 0);
          }
        }
        {
          const int i = 16 * w + l15;
          if (i < nv) {
            const int mr = dir ? rowbase + nv - 1 - i : rowbase + i;
            bf16_t* op = (bf16_t*)((char*)Og + (uint32_t)(mr * OLD + quad * 4) * 2u);
#pragma unroll
            for (int vt = 0; vt < 4; ++vt) *(u32x2*)(op + 16 * vt) = MK2(pack2(oa[vt][0], oa[vt][1]), pack2(oa[vt][2], oa[vt][3]));
          }
        }
      } else {
#pragma unroll
        for (int a = 0; a < 8; ++a) {
          const int k0 = 16 * (2 * w + (a >> 2)) + quad * 4;
          const fl4 e = *(const fl4*)(em + k0);
          S[a][0] *= e.x; S[a][1] *= e.y; S[a][2] *= e.z; S[a][3] *= e.w;
        }
      }
#pragma unroll
      for (int js = 0; js < 2; ++js) {
        bf16x8 kf[2];
#pragma unroll
        for (int ktl = 0; ktl < 2; ++ktl) kf[ktl] = *(const bf16x8*)(KT + (16 * (2 * w + ktl) + l15) * 72 + js * 32 + quad * 8);
#pragma unroll
        for (int vt = 0; vt < 4; ++vt) {
          bf16x8 vf = *(const bf16x8*)(VT + (16 * vt + l15) * 72 + js * 32 + quad * 8);
#pragma unroll
          for (int ktl = 0; ktl < 2; ++ktl)
            S[ktl * 4 + vt] = __builtin_amdgcn_mfma_f32_16x16x32_bf16(kf[ktl], vf, S[ktl * 4 + vt], 0, 0, 0);
        }
      }
#pragma unroll
      for (int a = 0; a < 8; ++a) {
        const int k0 = 16 * (2 * w + (a >> 2)) + quad * 4;
        const fl4 e = *(const fl4*)(el + k0);
        S[a][0] *= e.x; S[a][1] *= e.y; S[a][2] *= e.z; S[a][3] *= e.w;
      }
      __syncthreads();
    }
    if (!do_out) {
      bf16_t* L = p.ST + (size_t)item * 8192;
#pragma unroll
      for (int a = 0; a < 8; ++a)
#pragma unroll
        for (int r = 0; r < 4; ++r) L[(a * 4 + r) * 256 + t] = f2bf(S[a][r]);
      if (dvb == 0 && t < 64) *(float2*)(p.GD + ((seg * 8 + head) * 2 + dir) * 128 + 2 * t) = make_float2(gacc0, gacc1);
    }
  }
}

__device__ __forceinline__ void phase_hn(const Params& p, int l, char* smem) {
  const int bid_ = opaque_bid();
  const int t = opaque_tid(smem), lane = t & 63, w = t >> 6;
  const bf16_t* Y1 = p.X + (size_t)MROWS * 2048;
  const bf16_t* Y2 = Y1 + (size_t)MROWS * 1024;
  for (int row = bid_ * 4 + w; row < MROWS; row += gridDim.x * 4) {
    bf16_t* oa = p.O + (size_t)row * 2048 + lane * 16;
    float xa[16], xb[16];
    {
      u32x4 a0 = *(const u32x4*)(oa), a1 = *(const u32x4*)(oa + 8);
      u32x4 b0 = *(const u32x4*)(oa + 1024), b1 = *(const u32x4*)(oa + 1032);
      uint32_t ua[8] = {a0.x, a0.y, a0.z, a0.w, a1.x, a1.y, a1.z, a1.w};
      uint32_t ub[8] = {b0.x, b0.y, b0.z, b0.w, b1.x, b1.y, b1.z, b1.w};
#pragma unroll
      for (int e = 0; e < 8; ++e) {
        xa[2 * e] = __uint_as_float(ua[e] << 16) + __uint_as_float(ub[e] << 16);
        xa[2 * e + 1] = __uint_as_float(ua[e] & 0xffff0000u) + __uint_as_float(ub[e] & 0xffff0000u);
      }
      const bf16_t* y1 = Y1 + (size_t)row * 1024 + lane * 16;
      const bf16_t* y2 = Y2 + (size_t)row * 1024 + lane * 16;
      u32x4 c0 = *(const u32x4*)(y1), c1 = *(const u32x4*)(y1 + 8);
      u32x4 d0 = *(const u32x4*)(y2), d1 = *(const u32x4*)(y2 + 8);
      uint32_t uc[8] = {c0.x, c0.y, c0.z, c0.w, c1.x, c1.y, c1.z, c1.w};
      uint32_t ud[8] = {d0.x, d0.y, d0.z, d0.w, d1.x, d1.y, d1.z, d1.w};
#pragma unroll
      for (int e = 0; e < 8; ++e) {
        xb[2 * e] = __uint_as_float(uc[e] << 16) + __uint_as_float(ud[e] << 16);
        xb[2 * e + 1] = __uint_as_float(uc[e] & 0xffff0000u) + __uint_as_float(ud[e] & 0xffff0000u);
      }
    }
    float sa = 0.f, sb = 0.f;
#pragma unroll
    for (int e = 0; e < 16; ++e) { sa += xa[e] * xa[e]; sb += xb[e] * xb[e]; }
    sa += shx<1>(sa, lane); sa += shx<2>(sa, lane); sa += shx<4>(sa, lane);
    sb += shx<1>(sb, lane); sb += shx<2>(sb, lane); sb += shx<4>(sb, lane); sb += shx<8>(sb, lane);
    const float ra = rsqrtf(sa * (1.f / 128.f) + 1e-6f);
    const float rb = rsqrtf(sb * (1.f / 256.f) + 1e-6f);
    const float* na = p.norm_a + l * 1024 + lane * 16;
    const float* nb = p.norm_b + l * 1024 + lane * 16;
    uint32_t pa[8], pb[8];
#pragma unroll
    for (int e = 0; e < 8; ++e) {
      pa[e] = pack2(xa[2 * e] * ra * na[2 * e], xa[2 * e + 1] * ra * na[2 * e + 1]);
      pb[e] = pack2(xb[2 * e] * rb * nb[2 * e], xb[2 * e + 1] * rb * nb[2 * e + 1]);
    }
    *(u32x4*)(oa) = MK4(pa[0], pa[1], pa[2], pa[3]);
    *(u32x4*)(oa + 8) = MK4(pa[4], pa[5], pa[6], pa[7]);
    *(u32x4*)(oa + 1024) = MK4(pb[0], pb[1], pb[2], pb[3]);
    *(u32x4*)(oa + 1032) = MK4(pb[4], pb[5], pb[6], pb[7]);
  }
}

__device__ __forceinline__ void phase_final(const Params& p, char* smem) {
  const int bid_ = opaque_bid();
  const int t = opaque_tid(smem), lane = t & 63, w = t >> 6;
  for (int row = bid_ * 4 + w; row < 2 * NTOKG; row += gridDim.x * 4) {
    float* hp = p.out + (size_t)row * 1024;
    fl4 v[4];
    float s = 0.f;
#pragma unroll
    for (int j = 0; j < 4; ++j) {
      v[j] = *(const fl4*)(hp + j * 256 + lane * 4);
      s += v[j].x * v[j].x + v[j].y * v[j].y + v[j].z * v[j].z + v[j].w * v[j].w;
    }
    s += shx<1>(s, lane); s += shx<2>(s, lane); s += shx<4>(s, lane);
    s += shx<8>(s, lane); s += shx<16>(s, lane); s += shx<32>(s, lane);
    const float rs = rsqrtf(s * (1.f / 1024.f) + 1e-6f);
#pragma unroll
    for (int j = 0; j < 4; ++j) {
      const fl4 gn = *(const fl4*)(p.final_norm + j * 256 + lane * 4);
      fl4 o = MKF4(v[j].x * rs * gn.x, v[j].y * rs * gn.y, v[j].z * rs * gn.z, v[j].w * rs * gn.w);
      *(fl4*)(hp + j * 256 + lane * 4) = o;
    }
  }
}

__device__ __forceinline__ void phase_xcvt(const Params& p, int g, char* smem) {
  const int bid_ = opaque_bid();
  const int t = opaque_tid(smem), lane = t & 63, w = t >> 6;
  for (int row = bid_ * 4 + w; row < MROWS; row += gridDim.x * 4) {
    const float* src = row < NTOKG ? p.x[g] + (size_t)row * 1024 : p.hmeta + ((size_t)g * 128 + (row - NTOKG)) * 1024;
    float ssq = 0.f;
#pragma unroll
    for (int j = 0; j < 2; ++j) {
      const int c8 = j * 64 + lane;
      const fl4 a = *(const fl4*)(src + c8 * 8), b = *(const fl4*)(src + c8 * 8 + 4);
      ssq += a.x * a.x + a.y * a.y + a.z * a.z + a.w * a.w + b.x * b.x + b.y * b.y + b.z * b.z + b.w * b.w;
      *(u32x4*)(p.HB + tiled_off((size_t)row, c8 * 8, 1024)) = MK4(pack2(a.x, a.y), pack2(a.z, a.w), pack2(b.x, b.y), pack2(b.z, b.w));
    }
    ssq += shx<1>(ssq, lane); ssq += shx<2>(ssq, lane); ssq += shx<4>(ssq, lane);
    ssq += shx<8>(ssq, lane); ssq += shx<16>(ssq, lane); ssq += shx<32>(ssq, lane);
    if (lane == 0) p.RSA[row] = ssq;
  }
}

__device__ __forceinline__ void run_phase(const Params& p, int ph, char* smem) {
  if (ph == 0) { phase_init(p, smem); return; }
  if (ph == NPHASES - 1) { phase_final(p, smem); return; }
  const int q = ph - 1;
  const int g = q / 23, r = q % 23;
  if (r == 0) { phase_xcvt(p, g, smem); return; }
  const int l = (r - 1) / 11, st = (r - 1) % 11;
  switch (st) {
    case 0: gemm_phase<EPI_G1A>(p, l, g, smem); break;
    case 1: scan_phase<0, 1>(p, l, g, smem); break;
    case 2: scan_phase<0, 3>(p, l, g, smem); break;
    case 3: gemm_phase<EPI_G1B>(p, l, g, smem); break;
    case 4: scan_phase<1, 1>(p, l, g, smem); break;
    case 5: scan_phase<1, 3>(p, l, g, smem); break;
    case 6: phase_hn(p, l, smem); break;
    case 7: gemm_phase<EPI_GATES>(p, l, g, smem); break;
    case 8: gemm_phase<EPI_WOUT>(p, l, g, smem); break;
    case 9: gemm_phase<EPI_UP>(p, l, g, smem); break;
    default: gemm_phase<EPI_DOWN>(p, l, g, smem); break;
  }
}

template <int ST>
__global__ void __launch_bounds__(256, 2) pk(Params p, int l, int g) {
  extern __shared__ __attribute__((aligned(16))) char smem[];
  if (ST == 100) phase_init(p, smem);
  else if (ST == 101) phase_final(p, smem);
  else if (ST == 102) phase_xcvt(p, g, smem);
  else if (ST == 0) gemm_phase<EPI_G1A>(p, l, g, smem);
  else if (ST == 1) scan_phase<0, 1>(p, l, g, smem);
  else if (ST == 2) scan_phase<0, 3>(p, l, g, smem);
  else if (ST == 3) gemm_phase<EPI_G1B>(p, l, g, smem);
  else if (ST == 4) scan_phase<1, 1>(p, l, g, smem);
  else if (ST == 5) scan_phase<1, 3>(p, l, g, smem);
  else if (ST == 6) phase_hn(p, l, smem);
  else if (ST == 7) gemm_phase<EPI_GATES>(p, l, g, smem);
  else if (ST == 8) gemm_phase<EPI_WOUT>(p, l, g, smem);
  else if (ST == 9) gemm_phase<EPI_UP>(p, l, g, smem);
  else gemm_phase<EPI_DOWN>(p, l, g, smem);
}


#define XB_TMO      128
#define XB_XCNT(j)  (256  + 64 * (j))
#define XB_XSUB(j)  (1280 + 64 * (j))
#define XB_XGEN(j)  (2304 + 64 * (j))
#define XB_TOP      3328
#define XB_TOPGEN   3392
#define XCD_BAR_WORDS 3456
#define XB_SPIN_CAP (1u << 22)
#define LAS __attribute__((address_space(3)))
__device__ __forceinline__ unsigned xb_ld(unsigned* p)              { return __hip_atomic_load(p, __ATOMIC_RELAXED, __HIP_MEMORY_SCOPE_AGENT); }
__device__ __forceinline__ unsigned xb_add(unsigned* p, unsigned v) { return __hip_atomic_fetch_add(p, v, __ATOMIC_RELAXED, __HIP_MEMORY_SCOPE_AGENT); }
__device__ __forceinline__ unsigned xb_xcc_id() { return (unsigned)__builtin_amdgcn_s_getreg((3 << 11) | 20) & 0xFu; }
#define XB_SPIN(cond, bar) do { unsigned _sp = 0; while (cond) { __builtin_amdgcn_s_sleep(1); \
    if ((++_sp & 255u) == 0u) { if (xb_ld(&(bar)[XB_TMO])) break; if (_sp > XB_SPIN_CAP) { atomicAdd(&(bar)[XB_TMO], 1u); break; } } } } while (0)

__device__ __forceinline__ void xcd_barrier_complete(unsigned* bar, unsigned x, unsigned& nloc, unsigned& nx) {
  const unsigned G = gridDim.x * gridDim.y * gridDim.z;
  unsigned sum, cnt, mine, sp = 0u;
  for (;;) {
    sum = 0u; cnt = 0u; mine = 0u;
#pragma unroll
    for (unsigned j = 0; j < 16; ++j) { const unsigned c = xb_ld(&bar[XB_XCNT(j)]); sum += c; cnt += (c > 0u) ? 1u : 0u; mine = (j == x) ? c : mine; }
    if (sum == G) break;
    __builtin_amdgcn_s_sleep(1);
    if ((++sp & 255u) == 0u) { if (xb_ld(&bar[XB_TMO])) break; if (sp > XB_SPIN_CAP) { atomicAdd(&bar[XB_TMO], 1u); break; } }
  }
  nloc = mine > 0u ? mine : 1u; nx = cnt > 0u ? cnt : 1u;
}

__device__ __forceinline__ void xcd_barrier(unsigned* bar, volatile LAS unsigned* st, bool leader_thread) {
  asm volatile("s_waitcnt vmcnt(0)" ::: "memory");
  __syncthreads();
  if (leader_thread) {
    const unsigned x = xb_xcc_id();
    __builtin_amdgcn_s_waitcnt(0);
    unsigned nloc = st[0], nx = st[1];
    if (nloc == 0u) { xcd_barrier_complete(bar, x, nloc, nx); st[0] = nloc; st[1] = nx; }
    const unsigned old = xb_add(&bar[XB_XSUB(x)], 1u);
    const unsigned gen = old / nloc;
    if (old + 1u == (gen + 1u) * nloc) {
      __builtin_amdgcn_fence(__ATOMIC_RELEASE, "agent");
      asm volatile("s_waitcnt vmcnt(0)" ::: "memory");
      const unsigned og = xb_add(&bar[XB_TOP], 1u);
      const unsigned tg = og / nx;
      if (og + 1u == (tg + 1u) * nx) xb_add(&bar[XB_TOPGEN], 1u);
      else XB_SPIN(xb_ld(&bar[XB_TOPGEN]) == tg, bar);
      __builtin_amdgcn_fence(__ATOMIC_ACQUIRE, "agent");
      xb_add(&bar[XB_XGEN(x)], 1u);
      asm volatile("s_waitcnt vmcnt(0)" ::: "memory");
    } else {
      XB_SPIN(xb_ld(&bar[XB_XGEN(x)]) == gen, bar);
      __builtin_amdgcn_fence(__ATOMIC_ACQUIRE, "agent");
      asm volatile("s_waitcnt vmcnt(0)" ::: "memory");
    }
  }
  __syncthreads();
}

#ifndef MULTI_LAUNCH
__global__ void __launch_bounds__(256, 2) mega(Params p, int plo, int phi, int coop) {
  extern __shared__ __attribute__((aligned(16))) char smem[];
  volatile LAS unsigned* st = (volatile LAS unsigned*)(smem + LDS_BYTES + 16);
  {
    const int t0 = opaque_tid(smem);
    if (t0 == 0) { st[0] = 0u; st[1] = 0u; (void)xb_add(&p.bar[XB_XCNT(xb_xcc_id())], 1u); }
    __syncthreads();
  }
  for (int ph = plo; ph < phi; ++ph) {
    run_phase(p, ph, smem);
    if (coop && ph + 1 < phi) {
      if (ph == 0) cg::this_grid().sync();
      else { const int tb = opaque_tid(smem); xcd_barrier(p.bar, st, tb == 0); }
    }
  }
}

#endif

static inline size_t align_up(size_t x) { return (x + 255) & ~(size_t)255; }

extern "C" void kernel_launch(void* const* d_in, const int* in_sizes, int n_in,
                              void* d_out, int out_size, void* d_ws, size_t ws_size,
                              hipStream_t stream) {
  Params p{};
  p.x[0] = (const float*)d_in[0];
  p.x[1] = (const float*)d_in[1];
  p.meta = (const float*)d_in[2];
  p.attn_norm = (const float*)d_in[3];
  p.w_in = (const float*)d_in[4];
  p.lb_logits = (const float*)d_in[5];
  p.w_gate = (const float*)d_in[6];
  p.b_gate = (const float*)d_in[7];
  p.norm_a = (const float*)d_in[8];
  p.norm_b = (const float*)d_in[9];
  p.w_out = (const float*)d_in[10];
  p.mlp_norm = (const float*)d_in[11];
  p.w_up = (const float*)d_in[12];
  p.w_down = (const float*)d_in[13];
  p.final_norm = (const float*)d_in[14];
  p.out = (float*)d_out;
  char* ws = (char*)d_ws;
  size_t off = 0;
  p.W = (bf16_t*)(ws + off); off = align_up(off + (size_t)2 * LSTRIDE * 2);
  p.X = (bf16_t*)(ws + off); off = align_up(off + (size_t)MROWS * 4096 * 2);
  p.R = (bf16_t*)(ws + off); off = align_up(off + (size_t)MROWS * 32 * 2);
  p.O = (bf16_t*)(ws + off); off = align_up(off + (size_t)MROWS * 2048 * 2);
  p.HB = (bf16_t*)(ws + off); off = align_up(off + (size_t)MROWS * 1024 * 2);
  p.RSA = (float*)(ws + off); off = align_up(off + (size_t)MROWS * 4);
  p.RSB = (float*)(ws + off); off = align_up(off + (size_t)MROWS * 4);
  p.ST = (bf16_t*)(ws + off); off = align_up(off + (size_t)512 * 8192 * 2);
  p.GD = (float*)(ws + off); off = align_up(off + (size_t)16 * 8 * 2 * 128 * 4);
  p.hmeta = (float*)(ws + off); off = align_up(off + (size_t)2 * 128 * 1024 * 4);
  p.bar = (unsigned*)(ws + off); off = align_up(off + (size_t)XCD_BAR_WORDS * 4);
  if (off > ws_size) { fprintf(stderr, "workspace too small: need %zu have %zu\n", off, ws_size); return; }

#ifdef MULTI_LAUNCH
#define LAUNCH_PK(ST, l, g) do { \
    static bool attr_set_##ST = false; \
    if (!attr_set_##ST) { (void)hipFuncSetAttribute((const void*)pk<ST>, hipFuncAttributeMaxDynamicSharedMemorySize, LDS_BYTES + 32); attr_set_##ST = true; } \
    hipLaunchKernelGGL(pk<ST>, dim3(512), dim3(256), LDS_BYTES + 32, stream, p, l, g); } while (0)
  LAUNCH_PK(100, 0, 0);
  for (int g = 0; g < 2; ++g)
    for (int l = 0; l < 2; ++l) {
      if (l == 0) LAUNCH_PK(102, l, g);
      LAUNCH_PK(0, l, g); LAUNCH_PK(1, l, g); LAUNCH_PK(2, l, g); LAUNCH_PK(3, l, g); LAUNCH_PK(4, l, g); LAUNCH_PK(5, l, g);
      LAUNCH_PK(6, l, g); LAUNCH_PK(7, l, g); LAUNCH_PK(8, l, g); LAUNCH_PK(9, l, g); LAUNCH_PK(10, l, g);
    }
  LAUNCH_PK(101, 0, 0);
#else
  static int grid_blocks = 0;
  if (!grid_blocks) {
    (void)hipFuncSetAttribute((const void*)mega, hipFuncAttributeMaxDynamicSharedMemorySize, LDS_BYTES + 32);
    int dev = 0, cus = 0, per_cu = 0;
    (void)hipGetDevice(&dev);
    (void)hipDeviceGetAttribute(&cus, hipDeviceAttributeMultiprocessorCount, dev);
    (void)hipOccupancyMaxActiveBlocksPerMultiprocessor(&per_cu, (const void*)mega, 256, LDS_BYTES + 32);
    if (per_cu < 1) per_cu = 1;
    if (per_cu > 2) per_cu = 2;
    grid_blocks = cus * per_cu;
  }
  (void)hipMemsetAsync(p.bar, 0, (size_t)XCD_BAR_WORDS * 4, stream);
  int plo = 0, phi = NPHASES, coop = 1;
  void* args[] = {&p, &plo, &phi, &coop};
  hipError_t e = hipLaunchCooperativeKernel((const void*)mega, dim3(grid_blocks), dim3(256), args, LDS_BYTES + 32, stream);
  if (e != hipSuccess) fprintf(stderr, "cooperative launch failed: %s (grid %d)\n", hipGetErrorString(e), grid_blocks);
#endif
}
```

```cpp
#include <hip/hip_runtime.h>
#include <hip/hip_cooperative_groups.h>
#include <stdint.h>
#include <stdio.h>
namespace cg = cooperative_groups;

typedef __attribute__((ext_vector_type(8))) short bf16x8;
typedef __attribute__((ext_vector_type(4))) float f32x4;
typedef unsigned short bf16_t;
typedef uint32_t u32x4 __attribute__((ext_vector_type(4)));
typedef uint32_t u32x2 __attribute__((ext_vector_type(2)));
typedef float fl4 __attribute__((ext_vector_type(4)));
#define MK4(a,b,c,d) ((u32x4){(uint32_t)(a),(uint32_t)(b),(uint32_t)(c),(uint32_t)(d)})
#define MK2(a,b) ((u32x2){(uint32_t)(a),(uint32_t)(b)})
#define MKF4(a,b,c,d) ((fl4){(a),(b),(c),(d)})

#define NTOKG 16384
#define MROWS 16512
#define MTILES 129
#define LSTRIDE 20185088
#define WOFF_A 0
#define WOFF_B (4096 * 1024)
#define WOFF_G (6400 * 1024)
#define WOFF_O (10496 * 1024)
#define WOFF_U (11520 * 1024)
#define WOFF_D (15616 * 1024)
#define LDS_BYTES 80896
#define NPHASES 48

struct Params {
  const float* x[2];
  const float* meta;
  const float* attn_norm;
  const float* w_in;
  const float* lb_logits;
  const float* w_gate;
  const float* b_gate;
  const float* norm_a;
  const float* norm_b;
  const float* w_out;
  const float* mlp_norm;
  const float* w_up;
  const float* w_down;
  const float* final_norm;
  float* out;
  bf16_t* W;
  bf16_t* X;
  bf16_t* R;
  bf16_t* O;
  bf16_t* HB;
  float* RSA;
  float* RSB;
  bf16_t* ST;
  float* GD;
  float* hmeta;
  unsigned* bar;
};

__device__ __forceinline__ uint32_t pack2(float a, float b) {
  uint32_t r;
  asm("v_cvt_pk_bf16_f32 %0, %1, %2" : "=v"(r) : "v"(a), "v"(b));
  return r;
}
__device__ __forceinline__ bf16_t f2bf(float f) { return (bf16_t)(pack2(f, f) & 0xffffu); }
__device__ __forceinline__ int opaque_tid(char* smem) {
  int lane;
  asm volatile("v_mbcnt_lo_u32_b32 %0, -1, 0\n\tv_mbcnt_hi_u32_b32 %0, -1, %0" : "=v"(lane));
  int* cnt = (int*)(smem + LDS_BYTES);
  int w = 0;
  if (lane == 0) w = atomicAdd(cnt, 1);
  w = __builtin_amdgcn_readfirstlane(w) & 3;
  __syncthreads();
  return w * 64 + lane;
}
__device__ __forceinline__ int opaque_bid() { int b = blockIdx.x; asm volatile("" : "+s"(b)); return b; }
template <int M>
__device__ __forceinline__ float shx(float v, int lane) {
  if (M < 32) return __builtin_bit_cast(float, __builtin_amdgcn_ds_swizzle(__builtin_bit_cast(int, v), 0x1f | (M << 10)));
  return __builtin_bit_cast(float, __builtin_amdgcn_ds_bpermute((lane ^ M) << 2, __builtin_bit_cast(int, v)));
}
__device__ __forceinline__ float bf2f(bf16_t b) { return __uint_as_float(((uint32_t)b) << 16); }
__device__ __forceinline__ size_t tiled_off(size_t row, int col, int K) {
  return (((row >> 7) * (size_t)(K >> 5) + (size_t)(col >> 5)) * 128 + (row & 127)) * 32 + (size_t)(col & 31);
}
__device__ __forceinline__ float sigmoidf_(float x) { return __builtin_amdgcn_rcpf(1.f + __builtin_amdgcn_exp2f(x * -1.4426950408889634f)); }

__device__ __forceinline__ int w_in_col(int R, float& scale) {
  scale = 1.f;
  if (R < 4096) return R;
  if (R < 6400) {
    int n = R - 4096;
    if (n >= 2080) return -1;
    if (n < 512) scale = 0.08838834764831845f;
    return 5120 + n;
  }
  int n = R - 6400;
  int tt = n >> 8, wv = n & 255;
  int wn = wv >> 7, nl = wv & 127;
  int qd = nl >> 5, ni = (nl >> 2) & 7, r = nl & 3;
  int grp = ni >> 2, seg = ni & 3;
  int ucol = tt * 64 + wn * 32 + qd * 8 + grp * 4 + r;
  int base = seg == 0 ? 4096 : seg == 1 ? 8224 : seg == 2 ? 7200 : 9248;
  return base + ucol;
}

__device__ __forceinline__ void phase_init(const Params& p, char* smem) {
  const int t = opaque_tid(smem);
  const int bid_ = opaque_bid();
  for (int idx = bid_ * 256 + t; idx < 2 * 128 * 256; idx += gridDim.x * 256) {
    int g = idx / (128 * 256), r = (idx / 256) % 128, c4 = idx % 256;
    int nvalid = g == 0 ? 16 : 64;
    fl4 v = MKF4(0.f, 0.f, 0.f, 0.f);
    if (r < nvalid) v = *(const fl4*)(p.meta + (size_t)(r & 15) * 1024 + c4 * 4);
    *(fl4*)(p.hmeta + ((size_t)g * 128 + r) * 1024 + c4 * 4) = v;
  }
  float* tile = (float*)smem;
  const int per_layer = 3904 + 1024;
  for (int id = bid_; id < 2 * per_layer; id += gridDim.x) {
    int l = id / per_layer, r = id % per_layer;
    const float* src; int ld; const float* gain = nullptr; int K, n0, k0;
    bf16_t* dst;
    int kind;
    int cbase = 0;
    if (r < 3904) {
      int rt = r >> 4, kt = r & 15;
      n0 = rt * 64; k0 = kt * 64; K = 1024;
      dst = p.W + (size_t)l * LSTRIDE;
      if (n0 < 10496) { kind = 0; src = p.w_in + (size_t)l * 1024 * 10272; ld = 10272; gain = p.attn_norm + l * 1024; }
      else if (n0 < 11520) { kind = 1; src = p.w_out + (size_t)l * 1024 * 1024; ld = 1024; cbase = n0 - 10496; }
      else { kind = 1; src = p.w_up + (size_t)l * 1024 * 4096; ld = 4096; cbase = n0 - 11520; gain = p.mlp_norm + l * 1024; }
    } else {
      int r2 = r - 3904;
      int rt = r2 >> 6, kt = r2 & 63;
      n0 = rt * 64; k0 = kt * 64; K = 4096;
      dst = p.W + (size_t)l * LSTRIDE + WOFF_D;
      kind = 1; src = p.w_down + (size_t)l * 4096 * 1024; ld = 1024; cbase = n0;
    }
    {
      int n = t & 63;
      float scale = 1.f; int col;
      if (kind == 0) col = w_in_col(n0 + n, scale); else col = cbase + n;
#pragma unroll 4
      for (int i = 0; i < 16; ++i) {
        int kk = (t >> 6) + 4 * i;
        float v = 0.f;
        if (col >= 0) {
          v = src[(size_t)(k0 + kk) * ld + col] * scale;
          if (gain) v *= gain[k0 + kk];
        }
        tile[kk * 65 + n] = v;
      }
    }
    __syncthreads();
    {
      int n = t >> 2, piece = t & 3;
      uint32_t pk[8];
#pragma unroll
      for (int e = 0; e < 8; ++e) {
        float a = tile[(piece * 16 + 2 * e) * 65 + n];
        float b = tile[(piece * 16 + 2 * e + 1) * 65 + n];
        pk[e] = pack2(a, b);
      }
      const int Rr = n0 + n, kk = k0 + piece * 16;
      u32x4* d = (u32x4*)(dst + ((size_t)((Rr >> 8) * (K >> 5) + (kk >> 5)) * 256 + (Rr & 255)) * 32 + (kk & 31));
      d[0] = MK4(pk[0], pk[1], pk[2], pk[3]);
      d[1] = MK4(pk[4], pk[5], pk[6], pk[7]);
    }
    __syncthreads();
  }
}

template <int NT>
__device__ __forceinline__ void tile_to_mn(int tile, int& mt, int& nt) {
  if ((NT == 16 || NT == 4) && tile < 128 * NT) {
    const int round = tile >> 9, s_ = tile & 511;
    const int xcd = s_ & 7, j = s_ >> 3;
    mt = round * (512 / NT) + (j / NT) * 8 + xcd;
    nt = j % NT;
  } else { mt = tile / NT; nt = tile % NT; }
}

enum { EPI_G1A = 0, EPI_G1B, EPI_GATES, EPI_WOUT, EPI_UP, EPI_DOWN };

template <int EPI>
__device__ __forceinline__ void gemm_phase(const Params& p, int l, int g, char* smem) {
  constexpr bool NORM = (EPI == EPI_G1A || EPI == EPI_G1B || EPI == EPI_GATES || EPI == EPI_UP);
  constexpr int K = (EPI == EPI_DOWN) ? 4096 : 1024;
  constexpr int NT = EPI == EPI_G1A ? 16 : EPI == EPI_G1B ? 9 : EPI == EPI_GATES ? 16 : EPI == EPI_WOUT ? 4 : EPI == EPI_UP ? 16 : 4;
  constexpr int WOFF = EPI == EPI_G1A ? WOFF_A : EPI == EPI_G1B ? WOFF_B : EPI == EPI_GATES ? WOFF_G : EPI == EPI_WOUT ? WOFF_O : EPI == EPI_UP ? WOFF_U : WOFF_D;
  constexpr int NK = K / 32;
  const bf16_t* Wl = p.W + (size_t)l * LSTRIDE + WOFF;
  bf16_t* As = (bf16_t*)smem;
  bf16_t* Bs = As + 2 * 128 * 32;
  float* rss = (float*)(Bs + 2 * 256 * 32);
  const int bid_ = opaque_bid();
  const int t = opaque_tid(smem), lane = t & 63, w = t >> 6, wm = w >> 1, wn = w & 1;
  const int quad = lane >> 4, l15 = lane & 15;
  const int nvalid_meta = g == 0 ? 16 : 64;

  if (EPI == EPI_G1A) for (int i = bid_ * 256 + t; i < MROWS; i += gridDim.x * 256) p.RSB[i] = 0.f;
  if (EPI == EPI_UP) for (int i = bid_ * 256 + t; i < MROWS; i += gridDim.x * 256) p.RSA[i] = 0.f;
  bool pre = false;
  for (int tile = bid_; tile < MTILES * NT; tile += gridDim.x) {
    int mt, nt; tile_to_mn<NT>(tile, mt, nt);
    const bf16_t* Ab = NORM ? p.HB + (size_t)mt * 128 * 1024 : p.X + (size_t)mt * 128 * K;
    const bf16_t* Bg = Wl + (size_t)nt * 256 * K;
    const bool do_mma = !(mt == 128 && wm == 1) && !(EPI == EPI_G1B && nt == 8 && wn == 1);

    f32x4 acc[4][8];
#pragma unroll
    for (int a = 0; a < 4; ++a)
#pragma unroll
      for (int b = 0; b < 8; ++b) acc[a][b] = (f32x4){0.f, 0.f, 0.f, 0.f};
    int t_l = t;
    asm volatile("" : "+v"(t_l));
    const uint32_t voffA = (uint32_t)((t_l >> 2) * 64 + (((t_l & 3) ^ (((t_l >> 5) & 1) << 1)) * 16));
    const uint32_t voffB0 = (uint32_t)((t_l >> 2) * 64 + ((t_l & 3) * 16));
    const uint32_t voffB1 = (uint32_t)((t_l >> 2) * 64 + (((t_l & 3) ^ 2) * 16));
    const char* Abase = (const char*)Ab;
    const char* Bbase = (const char*)Bg;
    const int rpiece = quad ^ (((l15 >> 3) & 1) << 1);
    const int w_s = __builtin_amdgcn_readfirstlane(t_l >> 6);
#define GLDS(gp, lp) __builtin_amdgcn_global_load_lds((const __attribute__((address_space(1))) void*)(gp), (__attribute__((address_space(3))) void*)(lp), 16, 0, 0)
#define G_DMA(KT, BUF) G_DMA2(Abase, Bbase, KT, BUF)
#define G_DMA2(AB_, BB_, KT, BUF) do { \
      const char* ua = (AB_) + (size_t)(KT) * 8192; const char* ub = (BB_) + (size_t)(KT) * 16384; \
      asm volatile("" : "+s"(ua), "+s"(ub));     \
      char* la = (char*)(As + (BUF) * 4096) + w_s * 1024; char* lb = (char*)(Bs + (BUF) * 8192) + w_s * 1024;     \
      _Pragma("unroll") for (int i = 0; i < 2; ++i) GLDS(ua + i * 4096 + voffA, la + i * 4096); \
      _Pragma("unroll") for (int i = 0; i < 4; ++i) GLDS(ub + i * 4096 + ((i & 1) ? voffB1 : voffB0), lb + i * 4096); } while (0)
#define G_COMPUTE(BUF) do { \
      if (do_mma) { \
      const bf16_t* Aw = As + (BUF) * 4096; const bf16_t* Bw = Bs + (BUF) * 8192; \
      bf16x8 af[4], bfr[8]; \
      _Pragma("unroll") for (int mi = 0; mi < 4; ++mi) af[mi] = *(const bf16x8*)(Aw + (wm * 64 + mi * 16 + l15) * 32 + rpiece * 8); \
      _Pragma("unroll") for (int ni = 0; ni < 8; ++ni) bfr[ni] = *(const bf16x8*)(Bw + (wn * 128 + (l15 >> 2) * 32 + ni * 4 + (l15 & 3)) * 32 + rpiece * 8); \
      __builtin_amdgcn_s_setprio(1); \
      _Pragma("unroll") for (int ni = 0; ni < 8; ++ni) \
        _Pragma("unroll") for (int mi = 0; mi < 4; ++mi) \
          acc[mi][ni] = __builtin_amdgcn_mfma_f32_16x16x32_bf16(bfr[ni], af[mi], acc[mi][ni], 0, 0, 0); \
      __builtin_amdgcn_s_setprio(0); } } while (0)

    if (!pre) G_DMA(0, 0);
#pragma unroll 1
    for (int kt = 0; kt < NK; kt += 2) {
      asm volatile("s_waitcnt vmcnt(0)" ::: "memory");
      __syncthreads();
      G_DMA(kt + 1, 1);
      G_COMPUTE(0);
      asm volatile("s_waitcnt vmcnt(0)" ::: "memory");
      __syncthreads();
      { const int kn = (kt + 2 < NK) ? kt + 2 : NK - 1; G_DMA(kn, 0); }
      G_COMPUTE(1);
    }
    asm volatile("s_waitcnt vmcnt(0)" ::: "memory");
    __syncthreads();
    {
      const int tile2 = tile + (int)gridDim.x;
      pre = tile2 < MTILES * NT;
      if (pre) {
        int mt2, nt2; tile_to_mn<NT>(tile2, mt2, nt2);
        const char* Ab2 = (const char*)(NORM ? p.HB + (size_t)mt2 * 128 * 1024 : p.X + (size_t)mt2 * 128 * K);
        const char* Bg2 = (const char*)(Wl + (size_t)nt2 * 256 * K);
        G_DMA2(Ab2, Bg2, 0, 0);
      }
    }
#undef GLDS
#undef G_DMA
#undef G_DMA2
#undef G_COMPUTE

    int quad_e = quad, l15_e = l15, t_e = t;
    asm volatile("" : "+v"(quad_e), "+v"(l15_e), "+v"(t_e));
    if (do_mma) {
#pragma unroll
    for (int mi = 0; mi < 4; ++mi) {
      __builtin_amdgcn_sched_barrier(0);
      const int rl = wm * 64 + mi * 16 + l15_e;
      const size_t grow = (size_t)mt * 128 + rl;
      const float rs = NORM ? rsqrtf((EPI == EPI_UP ? p.RSB : p.RSA)[grow] * (1.f / 1024.f) + 1e-6f) : 1.f;
      const int cw = wn * 128 + quad_e * 32;
      if (EPI == EPI_G1A) {
        const int region = nt >> 2;
        bf16_t* xp = p.X + grow * 4096 + nt * 256 + cw;
#pragma unroll
        for (int c = 0; c < 4; ++c) {
          float v[8];
#pragma unroll
          for (int e = 0; e < 8; ++e) v[e] = acc[mi][2 * c + (e >> 2)][e & 3] * rs;
          if (region == 1 || region == 2) {
            float lb[8] = {0.f, 0.f, 0.f, 0.f, 0.f, 0.f, 0.f, 0.f};
            if (l == 1) {
              const float* l0p = p.lb_logits + (region - 1) * 1024 + ((nt * 256 + cw + c * 8) & 1023);
              const fl4 a0 = *(const fl4*)l0p, a1 = *(const fl4*)(l0p + 4);
              const fl4 b0 = *(const fl4*)(l0p + 2048), b1 = *(const fl4*)(l0p + 2052);
              lb[0] = sigmoidf_(b0.x - a0.x); lb[1] = sigmoidf_(b0.y - a0.y);
              lb[2] = sigmoidf_(b0.z - a0.z); lb[3] = sigmoidf_(b0.w - a0.w);
              lb[4] = sigmoidf_(b1.x - a1.x); lb[5] = sigmoidf_(b1.y - a1.y);
              lb[6] = sigmoidf_(b1.z - a1.z); lb[7] = sigmoidf_(b1.w - a1.w);
            }
#pragma unroll
            for (int e = 0; e < 8; ++e) {
              const float f = fmaxf(lb[e], 1e-30f) + (1.f - lb[e]) * sigmoidf_(v[e]);
              v[e] = __builtin_amdgcn_logf(f);
            }
          }
          *(u32x4*)(xp + c * 8) = MK4(pack2(v[0], v[1]), pack2(v[2], v[3]), pack2(v[4], v[5]), pack2(v[6], v[7]));
        }
      } else if (EPI == EPI_G1B) {
        if (nt < 8) {
          bf16_t* xp = p.X + grow * 2048 + nt * 256 + cw;
#pragma unroll
          for (int c = 0; c < 4; ++c)
            *(u32x4*)(xp + c * 8) = MK4(pack2(acc[mi][2 * c][0] * rs, acc[mi][2 * c][1] * rs), pack2(acc[mi][2 * c][2] * rs, acc[mi][2 * c][3] * rs),
                                        pack2(acc[mi][2 * c + 1][0] * rs, acc[mi][2 * c + 1][1] * rs), pack2(acc[mi][2 * c + 1][2] * rs, acc[mi][2 * c + 1][3] * rs));
        } else if (cw == 0) {
          bf16_t* rp = p.R + grow * 32;
#pragma unroll
          for (int c = 0; c < 4; ++c)
            *(u32x4*)(rp + c * 8) = MK4(pack2(acc[mi][2 * c][0] * rs, acc[mi][2 * c][1] * rs), pack2(acc[mi][2 * c][2] * rs, acc[mi][2 * c][3] * rs),
                                        pack2(acc[mi][2 * c + 1][0] * rs, acc[mi][2 * c + 1][1] * rs), pack2(acc[mi][2 * c + 1][2] * rs, acc[mi][2 * c + 1][3] * rs));
        }
      } else if (EPI == EPI_GATES) {
        const int uc = nt * 64 + wn * 32 + quad_e * 8;
        const u32x4 oa = *(const u32x4*)(p.O + grow * 2048 + uc);
        const u32x4 ob = *(const u32x4*)(p.O + grow * 2048 + 1024 + uc);
        const uint32_t oau[4] = {oa.x, oa.y, oa.z, oa.w}, obu[4] = {ob.x, ob.y, ob.z, ob.w};
        float u[8];
#pragma unroll
        for (int grp = 0; grp < 2; ++grp)
#pragma unroll
          for (int r = 0; r < 4; ++r) {
            const int idx = grp * 4 + r;
            const float ga = acc[mi][grp * 4 + 0][r] * rs, ma = acc[mi][grp * 4 + 1][r] * rs;
            const float gb = acc[mi][grp * 4 + 2][r] * rs, mb = acc[mi][grp * 4 + 3][r] * rs;
            const float ona = (idx & 1) ? __uint_as_float(oau[idx >> 1] & 0xffff0000u) : __uint_as_float(oau[idx >> 1] << 16);
            const float onb = (idx & 1) ? __uint_as_float(obu[idx >> 1] & 0xffff0000u) : __uint_as_float(obu[idx >> 1] << 16);
            u[idx] = sigmoidf_(ma) * (ga * sigmoidf_(ga)) * ona + sigmoidf_(mb) * (gb * sigmoidf_(gb)) * onb;
          }
        *(u32x4*)(p.X + tiled_off(grow, uc, 1024)) = MK4(pack2(u[0], u[1]), pack2(u[2], u[3]), pack2(u[4], u[5]), pack2(u[6], u[7]));
      } else if (EPI == EPI_WOUT || EPI == EPI_DOWN) {
        const bool meta = (mt == 128);
        float hsq = 0.f;
        if (!meta || rl < nvalid_meta) {
          const float* hin; float* hout;
          if (meta) { hout = p.hmeta + ((size_t)g * 128 + rl) * 1024; hin = hout; }
          else {
            const size_t trow = (size_t)mt * 128 + rl;
            hout = p.out + ((size_t)g * NTOKG + trow) * 1024;
            hin = (EPI == EPI_WOUT && l == 0) ? p.x[g] + trow * 1024 : hout;
          }
          const int col0 = nt * 256 + cw;
          bf16_t* hb = p.HB + tiled_off(grow, col0, 1024);
#pragma unroll
          for (int c = 0; c < 4; ++c) {
            const fl4 h0 = *(const fl4*)(hin + col0 + c * 8), h1 = *(const fl4*)(hin + col0 + c * 8 + 4);
            const fl4 o0 = MKF4(h0.x + acc[mi][2 * c][0], h0.y + acc[mi][2 * c][1], h0.z + acc[mi][2 * c][2], h0.w + acc[mi][2 * c][3]);
            const fl4 o1 = MKF4(h1.x + acc[mi][2 * c + 1][0], h1.y + acc[mi][2 * c + 1][1], h1.z + acc[mi][2 * c + 1][2], h1.w + acc[mi][2 * c + 1][3]);
            *(fl4*)(hout + col0 + c * 8) = o0;
            *(fl4*)(hout + col0 + c * 8 + 4) = o1;
            *(u32x4*)(hb + c * 8) = MK4(pack2(o0.x, o0.y), pack2(o0.z, o0.w), pack2(o1.x, o1.y), pack2(o1.z, o1.w));
            hsq += o0.x * o0.x + o0.y * o0.y + o0.z * o0.z + o0.w * o0.w + o1.x * o1.x + o1.y * o1.y + o1.z * o1.z + o1.w * o1.w;
          }
        }
        hsq += shx<16>(hsq, lane); hsq += shx<32>(hsq, lane);
        if (quad_e == 0 && (!meta || rl < nvalid_meta)) atomicAdd((EPI == EPI_WOUT ? p.RSB : p.RSA) + grow, hsq);
      } else if (EPI == EPI_UP) {
        bf16_t* xp = p.X + tiled_off(grow, nt * 256 + cw, 4096);
#pragma unroll
        for (int c = 0; c < 4; ++c) {
          float v[8];
#pragma unroll
          for (int e = 0; e < 8; ++e) { const float a = fmaxf(acc[mi][2 * c + (e >> 2)][e & 3] * rs, 0.f); v[e] = a * a; }
          *(u32x4*)(xp + c * 8) = MK4(pack2(v[0], v[1]), pack2(v[2], v[3]), pack2(v[4], v[5]), pack2(v[6], v[7]));
        }
      }
    }
    }
  }
}

template <int MIX, int PASS>
__device__ __forceinline__ void scan_phase(const Params& p, int l, int g, char* smem) {
  constexpr int NH = MIX ? 4 : 8;
  constexpr int NDV = MIX ? 4 : 2;
  constexpr int XLD = MIX ? 2048 : 4096;
  bf16_t* QS = (bf16_t*)smem;
  bf16_t* KS = QS + 64 * 136;
  bf16_t* KT = KS + 64 * 136;
  bf16_t* LG = KT;
  bf16_t* Pm = QS;
  bf16_t* SmT = KS;
  bf16_t* VT = KT + 128 * 72;
  bf16_t* RS = VT + 64 * 72;
  float* em = (float*)(RS + 64 * 24);
  float* el = em + 128;
  float* tot = el + 128;
  const int bid_ = opaque_bid();
  const int t_outer = opaque_tid(smem);
  const int sps = g == 0 ? 16 : 4;
  constexpr bool do_out = (PASS == 3);
  const bf16_t* Xg = p.X;

  for (int item = bid_; item < 512; item += gridDim.x) {
    int t = t_outer;
    asm volatile("" : "+v"(t));
    const int lane = t & 63, w = t >> 6, quad = lane >> 4, l15 = lane & 15;
    const int dir = item & 1;
    const int dvb = (item >> 1) % NDV;
    const int head = ((item >> 1) / NDV) % NH;
    const int seg = item >> 5;
    const int seq = seg / sps;
    const bool first = (seg % sps) == 0;
    const int nsteps = 16 + (first ? 1 : 0);
    int qcol, kcol, vcol;
    bf16_t* Og; int OLD;
    if (MIX == 0) {
      qcol = head * 128; kcol = 1024 + dir * 1024 + head * 128; vcol = 3072 + head * 128 + dvb * 64;
      Og = p.O + dir * 1024 + head * 128 + dvb * 64; OLD = 2048;
    } else {
      qcol = head * 128; kcol = 512 + head * 128; vcol = 1024 + head * 256 + dvb * 64;
      Og = p.X + (size_t)MROWS * 2048 + (size_t)dir * MROWS * 1024 + head * 256 + dvb * 64; OLD = 1024;
    }
    bf16x8 wgf[2]; float bgv[2][4];
    if (MIX == 1) {
#pragma unroll
      for (int ct = 0; ct < 2; ++ct) {
        const int cc = 16 * (2 * w + ct) + l15;
        bf16x8 v = (bf16x8){0, 0, 0, 0, 0, 0, 0, 0};
        if (quad < 2) {
#pragma unroll
          for (int e = 0; e < 8; ++e)
            v[e] = (short)f2bf(p.w_gate[((size_t)(l * 2 + dir) * 16 + quad * 8 + e) * 512 + head * 128 + cc]);
        }
        wgf[ct] = v;
#pragma unroll
        for (int r = 0; r < 4; ++r) bgv[ct][r] = p.b_gate[(l * 2 + dir) * 512 + head * 128 + 16 * (2 * w + ct) + quad * 4 + r];
      }
    }
    f32x4 S[8];
#pragma unroll
    for (int a = 0; a < 8; ++a) S[a] = (f32x4){0.f, 0.f, 0.f, 0.f};
    if (do_out) {
      int s2 = dir == 0 ? seq * sps : seq * sps + sps - 1;
      const int stp = dir == 0 ? 1 : -1;
      for (; s2 != seg; s2 += stp) {
        const int item2 = ((s2 * NH + head) * NDV + dvb) * 2 + dir;
        const bf16_t* L = p.ST + (size_t)item2 * 8192;
        const float* G = p.GD + ((s2 * 8 + head) * 2 + dir) * 128;
#pragma unroll
        for (int a = 0; a < 8; ++a)
#pragma unroll
          for (int r = 0; r < 4; ++r) {
            const int k = 16 * (2 * w + (a >> 2)) + quad * 4 + r;
            S[a][r] = __builtin_amdgcn_exp2f(G[k]) * S[a][r] + bf2f(L[(a * 4 + r) * 256 + t]);
          }
      }
    }
    float gacc0 = 0.f, gacc1 = 0.f;

    u32x4 qr[4], kr[4], vr[2], rr;
    auto step_rows = [&](int s, int& rowbase, int& nv) {
      bool meta;
      if (dir == 0) { meta = first && s == 0; rowbase = (seg * 16 + s - (first ? 1 : 0)) * 64; }
      else { meta = (s == 16); rowbase = (seg * 16 + 15 - s) * 64; }
      if (meta) { rowbase = NTOKG + seq * 16; nv = 16; } else nv = 64;
    };
    const char* Xq = (const char*)(Xg + qcol);
    const char* Xk = (const char*)(Xg + kcol);
    const char* Xv = (const char*)(Xg + vcol);
    const char* Rb = (const char*)(p.R + dir * 16);
    auto gload = [&](int s) {
      int rowbase, nv; step_rows(s, rowbase, nv);
#pragma unroll
      for (int j = 0; j < 4; ++j) {
        const int i = (t >> 4) + 16 * j;
        const int mr = dir ? rowbase + nv - 1 - i : rowbase + i;
        u32x4 z = MK4(0, 0, 0, 0);
        if (i < nv) {
          const uint32_t vo = (uint32_t)(mr * XLD + (t & 15) * 8) * 2u;
          qr[j] = do_out ? *(const u32x4*)(Xq + vo) : z;
          kr[j] = *(const u32x4*)(Xk + vo);
        } else { qr[j] = z; kr[j] = z; }
      }
      {
        const int i = t >> 2;
        const int mr = dir ? rowbase + nv - 1 - i : rowbase + i;
        vr[0] = MK4(0, 0, 0, 0); vr[1] = vr[0];
        if (i < nv) {
          const uint32_t vo = (uint32_t)(mr * XLD + (t & 3) * 16) * 2u;
          vr[0] = *(const u32x4*)(Xv + vo); vr[1] = *(const u32x4*)(Xv + vo + 16);
        }
      }
      if (MIX == 1) {
        rr = MK4(0, 0, 0, 0);
        if (t < 128) {
          const int i = t >> 1;
          const int mr = dir ? rowbase + nv - 1 - i : rowbase + i;
          if (i < nv) rr = *(const u32x4*)(Rb + (uint32_t)(mr * 32 + (t & 1) * 8) * 2u);
        }
      }
    };
    gload(0);

    for (int s = 0; s < nsteps; ++s) {
      int rowbase, nv; step_rows(s, rowbase, nv);
#pragma unroll
      for (int j = 0; j < 4; ++j) {
        const int i = (t >> 4) + 16 * j;
        if (do_out) *(u32x4*)(QS + i * 136 + (t & 15) * 8) = qr[j];
        *(u32x4*)(KS + i * 136 + (t & 15) * 8) = kr[j];
      }
      {
        const int i = t >> 2, piece = t & 3;
        uint32_t vv[8] = {vr[0].x, vr[0].y, vr[0].z, vr[0].w, vr[1].x, vr[1].y, vr[1].z, vr[1].w};
        bf16_t* vtw = VT + piece * 16 * 72 + i;
#pragma unroll
        for (int e = 0; e < 16; ++e) vtw[e * 72] = (bf16_t)((vv[e >> 1] >> ((e & 1) * 16)) & 0xffffu);
      }
      if (MIX == 1 && t < 128) *(u32x4*)(RS + (t >> 1) * 24 + (t & 1) * 8) = rr;
      if (s + 1 < nsteps) gload(s + 1);
      __syncthreads();
      if (MIX == 1) {
        bf16x8 af[4];
#pragma unroll
        for (int it = 0; it < 4; ++it) {
          af[it] = (bf16x8){0, 0, 0, 0, 0, 0, 0, 0};
          if (quad < 2) af[it] = *(const bf16x8*)(RS + (16 * it + l15) * 24 + quad * 8);
        }
#pragma unroll
        for (int ct = 0; ct < 2; ++ct)
#pragma unroll
          for (int it = 0; it < 4; ++it) {
            f32x4 z = __builtin_amdgcn_mfma_f32_16x16x32_bf16(wgf[ct], af[it], (f32x4){0.f, 0.f, 0.f, 0.f}, 0, 0, 0);
            float ls[4];
#pragma unroll
            for (int r = 0; r < 4; ++r) {
              const float zz = fmaxf(z[r] + bgv[ct][r], -80.f);
              ls[r] = __builtin_amdgcn_logf(1.f + __builtin_amdgcn_exp2f(zz * -1.4426950408889634f)) * -0.0625f;
            }
            *(u32x2*)(LG + (16 * it + l15) * 128 + 16 * (2 * w + ct) + quad * 4) = MK2(pack2(ls[0], ls[1]), pack2(ls[2], ls[3]));
          }
        __syncthreads();
      }
      const int cp = t & 63, rg = t >> 6;
      const int nvl = nv - 16 * rg;
      float p0[16], p1[16];
      {
        float run0 = 0.f, run1 = 0.f;
        constexpr int LFS32 = (MIX == 0) ? 68 : 64;
        const uint32_t* lfp = (const uint32_t*)((MIX == 0) ? (KS + 16 * rg * 136) : (LG + 16 * rg * 128)) + cp;
#pragma unroll
        for (int ii = 0; ii < 16; ++ii) {
          if ((ii & 7) == 0) __builtin_amdgcn_sched_barrier(0);
          const uint32_t u = lfp[ii * LFS32];
          float l0 = __uint_as_float(u << 16), l1 = __uint_as_float(u & 0xffff0000u);
          if (ii >= nvl) { l0 = 0.f; l1 = 0.f; }
          run0 += l0; run1 += l1;
          p0[ii] = run0; p1[ii] = run1;
        }
        *(float2*)(tot + rg * 128 + 2 * cp) = make_float2(run0, run1);
      }
      __syncthreads();
      {
        const float2 ta = *(const float2*)(tot + 2 * cp), tb = *(const float2*)(tot + 128 + 2 * cp);
        const float2 tc = *(const float2*)(tot + 256 + 2 * cp), td = *(const float2*)(tot + 384 + 2 * cp);
        const float m0 = ta.x + tb.x, m1 = ta.y + tb.y;
        const float base0 = (rg > 0 ? ta.x : 0.f) + (rg > 1 ? tb.x : 0.f) + (rg > 2 ? tc.x : 0.f);
        const float base1 = (rg > 0 ? ta.y : 0.f) + (rg > 1 ? tb.y : 0.f) + (rg > 2 ? tc.y : 0.f);
        uint32_t* qp = (uint32_t*)(QS + 16 * rg * 136) + cp;
        uint32_t* kp = (uint32_t*)(KS + 16 * rg * 136) + cp;
        float skp0 = __builtin_amdgcn_exp2f(-fminf(fmaxf(base0 - m0, -115.f), 115.f));
        float skp1 = __builtin_amdgcn_exp2f(-fminf(fmaxf(base1 - m1, -115.f), 115.f));
        uint32_t kt0[8], kt1[8], kkprev = 0;
#pragma unroll
        for (int ii = 0; ii < 16; ++ii) {
          if ((ii & 3) == 0) __builtin_amdgcn_sched_barrier(0);
          const float e0 = fminf(fmaxf(base0 + p0[ii] - m0, -115.f), 115.f);
          const float e1 = fminf(fmaxf(base1 + p1[ii] - m1, -115.f), 115.f);
          const float sq0 = __builtin_amdgcn_exp2f(e0), sq1 = __builtin_amdgcn_exp2f(e1);
          const float sk0 = __builtin_amdgcn_rcpf(sq0), sk1 = __builtin_amdgcn_rcpf(sq1);
          if (do_out) {
            const uint32_t uq = qp[ii * 68];
            qp[ii * 68] = pack2(__uint_as_float(uq << 16) * sq0, __uint_as_float(uq & 0xffff0000u) * sq1);
          }
          float k0, k1;
          if (MIX == 0) { k0 = 1.f - sq0 * skp0; k1 = 1.f - sq1 * skp1; skp0 = sk0; skp1 = sk1; }
          else { const uint32_t uk = kp[ii * 68]; k0 = __uint_as_float(uk << 16); k1 = __uint_as_float(uk & 0xffff0000u); }
          const uint32_t kk = pack2(k0 * sk0, k1 * sk1);
          if (do_out) kp[ii * 68] = kk;
          if (ii & 1) {
            kt0[ii >> 1] = __builtin_amdgcn_perm(kk, kkprev, 0x05040100u);
            kt1[ii >> 1] = __builtin_amdgcn_perm(kk, kkprev, 0x07060302u);
          } else kkprev = kk;
        }
        u32x4* kd0 = (u32x4*)(KT + (2 * cp) * 72 + 16 * rg);
        u32x4* kd1 = (u32x4*)(KT + (2 * cp + 1) * 72 + 16 * rg);
        kd0[0] = MK4(kt0[0], kt0[1], kt0[2], kt0[3]); kd0[1] = MK4(kt0[4], kt0[5], kt0[6], kt0[7]);
        kd1[0] = MK4(kt1[0], kt1[1], kt1[2], kt1[3]); kd1[1] = MK4(kt1[4], kt1[5], kt1[6], kt1[7]);
        if (rg == 0) {
          *(float2*)(em + 2 * cp) = make_float2(__builtin_amdgcn_exp2f(m0), __builtin_amdgcn_exp2f(m1));
          *(float2*)(el + 2 * cp) = make_float2(__builtin_amdgcn_exp2f(tc.x + td.x), __builtin_amdgcn_exp2f(tc.y + td.y));
        }
        gacc0 += m0 + tc.x + td.x; gacc1 += m1 + tc.y + td.y;
      }
      __syncthreads();
      if (do_out) {
        bf16x8 qf[4];
#pragma unroll
        for (int ks = 0; ks < 4; ++ks) qf[ks] = *(const bf16x8*)(QS + (16 * w + l15) * 136 + ks * 32 + quad * 8);
        f32x4 pa[4];
#pragma unroll
        for (int jt = 0; jt < 4; ++jt) {
          pa[jt] = (f32x4){0.f, 0.f, 0.f, 0.f};
          if (jt <= w) {
#pragma unroll
            for (int ks = 0; ks < 4; ++ks) {
              bf16x8 kf = *(const bf16x8*)(KS + (16 * jt + l15) * 136 + ks * 32 + quad * 8);
              pa[jt] = __builtin_amdgcn_mfma_f32_16x16x32_bf16(kf, qf[ks], pa[jt], 0, 0, 0);
            }
          }
        }
        __syncthreads();
        {
          const int i = 16 * w + l15;
          bf16_t* pw = Pm + i * 72 + quad * 4;
#pragma unroll
          for (int jt = 0; jt < 4; ++jt) {
            const int j0 = 16 * jt + quad * 4;
            float pv[4];
#pragma unroll
            for (int r = 0; r < 4; ++r) pv[r] = (jt <= w && j0 + r <= i) ? pa[jt][r] : 0.f;
            *(u32x2*)(pw + 16 * jt) = MK2(pack2(pv[0], pv[1]), pack2(pv[2], pv[3]));
          }
        }
#pragma unroll
        for (int a = 0; a < 8; ++a) {
          const int k0 = 16 * (2 * w + (a >> 2)) + quad * 4;
          const int v = 16 * (a & 3) + l15;
          const fl4 e = *(const fl4*)(em + k0);
          S[a][0] *= e.x; S[a][1] *= e.y; S[a][2] *= e.z; S[a][3] *= e.w;
          *(u32x2*)(SmT + v * 136 + k0) = MK2(pack2(S[a][0], S[a][1]), pack2(S[a][2], S[a][3]));
        }
        __syncthreads();
        f32x4 oa[4];
#pragma unroll
        for (int vt = 0; vt < 4; ++vt) {
          oa[vt] = (f32x4){0.f, 0.f, 0.f, 0.f};
#pragma unroll
          for (int ks = 0; ks < 4; ++ks) {
            bf16x8 sf = *(const bf16x8*)(SmT + (16 * vt + l15) * 136 + ks * 32 + quad * 8);
            oa[vt] = __builtin_amdgcn_mfma_f32_16x16x32_bf16(sf, qf[ks], oa[vt], 0, 0, 0);
          }
        }
#pragma unroll
        for (int js = 0; js < 2; ++js) {
          bf16x8 pfr = *(const bf16x8*)(Pm + (16 * w + l15) * 72 + js * 32 + quad * 8);
#pragma unroll
          for (int vt = 0; vt < 4; ++vt) {
            bf16x8 vf = *(const bf16x8*)(VT + (16 * vt + l15) * 72 + js * 32 + quad * 8);
            oa[vt] = __builtin_amdgcn_mfma_f32_16x16x32_bf16(vf, pfr, oa[vt], 0, 0, 0);
          }
        }
        {
          const int i = 16 * w + l15;
          if (i < nv) {
            const int mr = dir ? rowbase + nv - 1 - i : rowbase + i;
            bf16_t* op = (bf16_t*)((char*)Og + (uint32_t)(mr * OLD + quad * 4) * 2u);
#pragma unroll
            for (int vt = 0; vt < 4; ++vt) *(u32x2*)(op + 16 * vt) = MK2(pack2(oa[vt][0], oa[vt][1]), pack2(oa[vt][2], oa[vt][3]));
          }
        }
      } else {
#pragma unroll
        for (int a = 0; a < 8; ++a) {
          const int k0 = 16 * (2 * w + (a >> 2)) + quad * 4;
          const fl4 e = *(const fl4*)(em + k0);
          S[a][0] *= e.x; S[a][1] *= e.y; S[a][2] *= e.z; S[a][3] *= e.w;
        }
      }
#pragma unroll
      for (int js = 0; js < 2; ++js) {
        bf16x8 kf[2];
#pragma unroll
        for (int ktl = 0; ktl < 2; ++ktl) kf[ktl] = *(const bf16x8*)(KT + (16 * (2 * w + ktl) + l15) * 72 + js * 32 + quad * 8);
#pragma unroll
        for (int vt = 0; vt < 4; ++vt) {
          bf16x8 vf = *(const bf16x8*)(VT + (16 * vt + l15) * 72 + js * 32 + quad * 8);
#pragma unroll
          for (int ktl = 0; ktl < 2; ++ktl)
            S[ktl * 4 + vt] = __builtin_amdgcn_mfma_f32_16x16x32_bf16(kf[ktl], vf, S[ktl * 4 + vt], 0, 0, 0);
        }
      }
#pragma unroll
      for (int a = 0; a < 8; ++a) {
        const int k0 = 16 * (2 * w + (a >> 2)) + quad * 4;
        const fl4 e = *(const fl4*)(el + k0);
        S[a][0] *= e.x; S[a][1] *= e.y; S[a][2] *= e.z; S[a][3] *= e.w;
      }
      __syncthreads();
    }
    if (!do_out) {
      bf16_t* L = p.ST + (size_t)item * 8192;
#pragma unroll
      for (int a = 0; a < 8; ++a)
#pragma unroll
        for (int r = 0; r < 4; ++r) L[(a * 4 + r) * 256 + t] = f2bf(S[a][r]);
      if (dvb == 0 && t < 64) *(float2*)(p.GD + ((seg * 8 + head) * 2 + dir) * 128 + 2 * t) = make_float2(gacc0, gacc1);
    }
  }
}

__device__ __forceinline__ void phase_hn(const Params& p, int l, char* smem) {
  const int bid_ = opaque_bid();
  const int t = opaque_tid(smem), lane = t & 63, w = t >> 6;
  const bf16_t* Y1 = p.X + (size_t)MROWS * 2048;
  const bf16_t* Y2 = Y1 + (size_t)MROWS * 1024;
  for (int row = bid_ * 4 + w; row < MROWS; row += gridDim.x * 4) {
    bf16_t* oa = p.O + (size_t)row * 2048 + lane * 16;
    float xa[16], xb[16];
    {
      u32x4 a0 = *(const u32x4*)(oa), a1 = *(const u32x4*)(oa + 8);
      u32x4 b0 = *(const u32x4*)(oa + 1024), b1 = *(const u32x4*)(oa + 1032);
      uint32_t ua[8] = {a0.x, a0.y, a0.z, a0.w, a1.x, a1.y, a1.z, a1.w};
      uint32_t ub[8] = {b0.x, b0.y, b0.z, b0.w, b1.x, b1.y, b1.z, b1.w};
#pragma unroll
      for (int e = 0; e < 8; ++e) {
        xa[2 * e] = __uint_as_float(ua[e] << 16) + __uint_as_float(ub[e] << 16);
        xa[2 * e + 1] = __uint_as_float(ua[e] & 0xffff0000u) + __uint_as_float(ub[e] & 0xffff0000u);
      }
      const bf16_t* y1 = Y1 + (size_t)row * 1024 + lane * 16;
      const bf16_t* y2 = Y2 + (size_t)row * 1024 + lane * 16;
      u32x4 c0 = *(const u32x4*)(y1), c1 = *(const u32x4*)(y1 + 8);
      u32x4 d0 = *(const u32x4*)(y2), d1 = *(const u32x4*)(y2 + 8);
      uint32_t uc[8] = {c0.x, c0.y, c0.z, c0.w, c1.x, c1.y, c1.z, c1.w};
      uint32_t ud[8] = {d0.x, d0.y, d0.z, d0.w, d1.x, d1.y, d1.z, d1.w};
#pragma unroll
      for (int e = 0; e < 8; ++e) {
        xb[2 * e] = __uint_as_float(uc[e] << 16) + __uint_as_float(ud[e] << 16);
        xb[2 * e + 1] = __uint_as_float(uc[e] & 0xffff0000u) + __uint_as_float(ud[e] & 0xffff0000u);
      }
    }
    float sa = 0.f, sb = 0.f;
#pragma unroll
    for (int e = 0; e < 16; ++e) { sa += xa[e] * xa[e]; sb += xb[e] * xb[e]; }
    sa += shx<1>(sa, lane); sa += shx<2>(sa, lane); sa += shx<4>(sa, lane);
    sb += shx<1>(sb, lane); sb += shx<2>(sb, lane); sb += shx<4>(sb, lane); sb += shx<8>(sb, lane);
    const float ra = rsqrtf(sa * (1.f / 128.f) + 1e-6f);
    const float rb = rsqrtf(sb * (1.f / 256.f) + 1e-6f);
    const float* na = p.norm_a + l * 1024 + lane * 16;
    const float* nb = p.norm_b + l * 1024 + lane * 16;
    uint32_t pa[8], pb[8];
#pragma unroll
    for (int e = 0; e < 8; ++e) {
      pa[e] = pack2(xa[2 * e] * ra * na[2 * e], xa[2 * e + 1] * ra * na[2 * e + 1]);
      pb[e] = pack2(xb[2 * e] * rb * nb[2 * e], xb[2 * e + 1] * rb * nb[2 * e + 1]);
    }
    *(u32x4*)(oa) = MK4(pa[0], pa[1], pa[2], pa[3]);
    *(u32x4*)(oa + 8) = MK4(pa[4], pa[5], pa[6], pa[7]);
    *(u32x4*)(oa + 1024) = MK4(pb[0], pb[1], pb[2], pb[3]);
    *(u32x4*)(oa + 1032) = MK4(pb[4], pb[5], pb[6], pb[7]);
  }
}

__device__ __forceinline__ void phase_final(const Params& p, char* smem) {
  const int bid_ = opaque_bid();
  const int t = opaque_tid(smem), lane = t & 63, w = t >> 6;
  for (int row = bid_ * 4 + w; row < 2 * NTOKG; row += gridDim.x * 4) {
    float* hp = p.out + (size_t)row * 1024;
    fl4 v[4];
    float s = 0.f;
#pragma unroll
    for (int j = 0; j < 4; ++j) {
      v[j] = *(const fl4*)(hp + j * 256 + lane * 4);
      s += v[j].x * v[j].x + v[j].y * v[j].y + v[j].z * v[j].z + v[j].w * v[j].w;
    }
    s += shx<1>(s, lane); s += shx<2>(s, lane); s += shx<4>(s, lane);
    s += shx<8>(s, lane); s += shx<16>(s, lane); s += shx<32>(s, lane);
    const float rs = rsqrtf(s * (1.f / 1024.f) + 1e-6f);
#pragma unroll
    for (int j = 0; j < 4; ++j) {
      const fl4 gn = *(const fl4*)(p.final_norm + j * 256 + lane * 4);
      fl4 o = MKF4(v[j].x * rs * gn.x, v[j].y * rs * gn.y, v[j].z * rs * gn.z, v[j].w * rs * gn.w);
      *(fl4*)(hp + j * 256 + lane * 4) = o;
    }
  }
}

__device__ __forceinline__ void phase_xcvt(const Params& p, int g, char* smem) {
  const int bid_ = opaque_bid();
  const int t = opaque_tid(smem), lane = t & 63, w = t >> 6;
  for (int row = bid_ * 4 + w; row < MROWS; row += gridDim.x * 4) {
    const float* src = row < NTOKG ? p.x[g] + (size_t)row * 1024 : p.hmeta + ((size_t)g * 128 + (row - NTOKG)) * 1024;
    float ssq = 0.f;
#pragma unroll
    for (int j = 0; j < 2; ++j) {
      const int c8 = j * 64 + lane;
      const fl4 a = *(const fl4*)(src + c8 * 8), b = *(const fl4*)(src + c8 * 8 + 4);
      ssq += a.x * a.x + a.y * a.y + a.z * a.z + a.w * a.w + b.x * b.x + b.y * b.y + b.z * b.z + b.w * b.w;
      *(u32x4*)(p.HB + tiled_off((size_t)row, c8 * 8, 1024)) = MK4(pack2(a.x, a.y), pack2(a.z, a.w), pack2(b.x, b.y), pack2(b.z, b.w));
    }
    ssq += shx<1>(ssq, lane); ssq += shx<2>(ssq, lane); ssq += shx<4>(ssq, lane);
    ssq += shx<8>(ssq, lane); ssq += shx<16>(ssq, lane); ssq += shx<32>(ssq, lane);
    if (lane == 0) p.RSA[row] = ssq;
  }
}

__device__ __forceinline__ void run_phase(const Params& p, int ph, char* smem) {
  if (ph == 0) { phase_init(p, smem); return; }
  if (ph == NPHASES - 1) { phase_final(p, smem); return; }
  const int q = ph - 1;
  const int g = q / 23, r = q % 23;
  if (r == 0) { phase_xcvt(p, g, smem); return; }
  const int l = (r - 1) / 11, st = (r - 1) % 11;
  switch (st) {
    case 0: gemm_phase<EPI_G1A>(p, l, g, smem); break;
    case 1: scan_phase<0, 1>(p, l, g, smem); break;
    case 2: scan_phase<0, 3>(p, l, g, smem); break;
    case 3: gemm_phase<EPI_G1B>(p, l, g, smem); break;
    case 4: scan_phase<1, 1>(p, l, g, smem); break;
    case 5: scan_phase<1, 3>(p, l, g, smem); break;
    case 6: phase_hn(p, l, smem); break;
    case 7: gemm_phase<EPI_GATES>(p, l, g, smem); break;
    case 8: gemm_phase<EPI_WOUT>(p, l, g, smem); break;
    case 9: gemm_phase<EPI_UP>(p, l, g, smem); break;
    default: gemm_phase<EPI_DOWN>(p, l, g, smem); break;
  }
}

template <int ST>
__global__ void __launch_bounds__(256, 2) pk(Params p, int l, int g) {
  extern __shared__ __attribute__((aligned(16))) char smem[];
  if (ST == 100) phase_init(p, smem);
  else if (ST == 101) phase_final(p, smem);
  else if (ST == 102) phase_xcvt(p, g, smem);
  else if (ST == 0) gemm_phase<EPI_G1A>(p, l, g, smem);
  else if (ST == 1) scan_phase<0, 1>(p, l, g, smem);
  else if (ST == 2) scan_phase<0, 3>(p, l, g, smem);
  else if (ST == 3) gemm_phase<EPI_G1B>(p, l, g, smem);
  else if (ST == 4) scan_phase<1, 1>(p, l, g, smem);
  else if (ST == 5) scan_phase<1, 3>(p, l, g, smem);
  else if (ST == 6) phase_hn(p, l, smem);
  else if (ST == 7) gemm_phase<EPI_GATES>(p, l, g, smem);
  else if (ST == 8) gemm_phase<EPI_WOUT>(p, l, g, smem);
  else if (ST == 9) gemm_phase<EPI_UP>(p, l, g, smem);
  else gemm_phase<EPI_DOWN>(p, l, g, smem);
}


#define XB_TMO      128
#define XB_XCNT(j)  (256  + 64 * (j))
#define XB_XSUB(j)  (1280 + 64 * (j))
#define XB_XGEN(j)  (2304 + 64 * (j))
#define XB_TOP      3328
#define XB_TOPGEN   3392
#define XCD_BAR_WORDS 3456
#define XB_SPIN_CAP (1u << 22)
#define LAS __attribute__((address_space(3)))
__device__ __forceinline__ unsigned xb_ld(unsigned* p)              { return __hip_atomic_load(p, __ATOMIC_RELAXED, __HIP_MEMORY_SCOPE_AGENT); }
__device__ __forceinline__ unsigned xb_add(unsigned* p, unsigned v) { return __hip_atomic_fetch_add(p, v, __ATOMIC_RELAXED, __HIP_MEMORY_SCOPE_AGENT); }
__device__ __forceinline__ unsigned xb_xcc_id() { return (unsigned)__builtin_amdgcn_s_getreg((3 << 11) | 20) & 0xFu; }
#define XB_SPIN(cond, bar) do { unsigned _sp = 0; while (cond) { __builtin_amdgcn_s_sleep(1); \
    if ((++_sp & 255u) == 0u) { if (xb_ld(&(bar)[XB_TMO])) break; if (_sp > XB_SPIN_CAP) { atomicAdd(&(bar)[XB_TMO], 1u); break; } } } } while (0)

__device__ __forceinline__ void xcd_barrier_complete(unsigned* bar, unsigned x, unsigned& nloc, unsigned& nx) {
  const unsigned G = gridDim.x * gridDim.y * gridDim.z;
  unsigned sum, cnt, mine, sp = 0u;
  for (;;) {
    sum = 0u; cnt = 0u; mine = 0u;
#pragma unroll
    for (unsigned j = 0; j < 16; ++j) { const unsigned c = xb_ld(&bar[XB_XCNT(j)]); sum += c; cnt += (c > 0u) ? 1u : 0u; mine = (j == x) ? c : mine; }
    if (sum == G) break;
    __builtin_amdgcn_s_sleep(1);
    if ((++sp & 255u) == 0u) { if (xb_ld(&bar[XB_TMO])) break; if (sp > XB_SPIN_CAP) { atomicAdd(&bar[XB_TMO], 1u); break; } }
  }
  nloc = mine > 0u ? mine : 1u; nx = cnt > 0u ? cnt : 1u;
}

__device__ __forceinline__ void xcd_barrier(unsigned* bar, volatile LAS unsigned* st, bool leader_thread) {
  asm volatile("s_waitcnt vmcnt(0)" ::: "memory");
  __syncthreads();
  if (leader_thread) {
    const unsigned x = xb_xcc_id();
    __builtin_amdgcn_s_waitcnt(0);
    unsigned nloc = st[0], nx = st[1];
    if (nloc == 0u) { xcd_barrier_complete(bar, x, nloc, nx); st[0] = nloc; st[1] = nx; }
    const unsigned old = xb_add(&bar[XB_XSUB(x)], 1u);
    const unsigned gen = old / nloc;
    if (old + 1u == (gen + 1u) * nloc) {
      __builtin_amdgcn_fence(__ATOMIC_RELEASE, "agent");
      asm volatile("s_waitcnt vmcnt(0)" ::: "memory");
      const unsigned og = xb_add(&bar[XB_TOP], 1u);
      const unsigned tg = og / nx;
      if (og + 1u == (tg + 1u) * nx) xb_add(&bar[XB_TOPGEN], 1u);
      else XB_SPIN(xb_ld(&bar[XB_TOPGEN]) == tg, bar);
      __builtin_amdgcn_fence(__ATOMIC_ACQUIRE, "agent");
      xb_add(&bar[XB_XGEN(x)], 1u);
      asm volatile("s_waitcnt vmcnt(0)" ::: "memory");
    } else {
      XB_SPIN(xb_ld(&bar[XB_XGEN(x)]) == gen, bar);
      __builtin_amdgcn_fence(__ATOMIC_ACQUIRE, "agent");
      asm volatile("s_waitcnt vmcnt(0)" ::: "memory");
    }
  }
  __syncthreads();
}

#ifndef MULTI_LAUNCH
__global__ void __launch_bounds__(256, 2) mega(Params p, int plo, int phi, int coop) {
  extern __shared__ __attribute__((aligned(16))) char smem[];
  volatile LAS unsigned* st = (volatile LAS unsigned*)(smem + LDS_BYTES + 16);
  {
    const int t0 = opaque_tid(smem);
    if (t0 == 0) { st[0] = 0u; st[1] = 0u; (void)xb_add(&p.bar[XB_XCNT(xb_xcc_id())], 1u); }
    __syncthreads();
  }
  for (int ph = plo; ph < phi; ++ph) {
    run_phase(p, ph, smem);
    if (coop && ph + 1 < phi) {
      if (ph == 0) cg::this_grid().sync();
      else { const int tb = opaque_tid(smem); xcd_barrier(p.bar, st, tb == 0); }
    }
  }
}

#endif

static inline size_t align_up(size_t x) { return (x + 255) & ~(size_t)255; }

extern "C" void kernel_launch(void* const* d_in, const int* in_sizes, int n_in,
                              void* d_out, int out_size, void* d_ws, size_t ws_size,
                              hipStream_t stream) {
  Params p{};
  p.x[0] = (const float*)d_in[0];
  p.x[1] = (const float*)d_in[1];
  p.meta = (const float*)d_in[2];
  p.attn_norm = (const float*)d_in[3];
  p.w_in = (const float*)d_in[4];
  p.lb_logits = (const float*)d_in[5];
  p.w_gate = (const float*)d_in[6];
  p.b_gate = (const float*)d_in[7];
  p.norm_a = (const float*)d_in[8];
  p.norm_b = (const float*)d_in[9];
  p.w_out = (const float*)d_in[10];
  p.mlp_norm = (const float*)d_in[11];
  p.w_up = (const float*)d_in[12];
  p.w_down = (const float*)d_in[13];
  p.final_norm = (const float*)d_in[14];
  p.out = (float*)d_out;
  char* ws = (char*)d_ws;
  size_t off = 0;
  p.W = (bf16_t*)(ws + off); off = align_up(off + (size_t)2 * LSTRIDE * 2);
  p.X = (bf16_t*)(ws + off); off = align_up(off + (size_t)MROWS * 4096 * 2);
  p.R = (bf16_t*)(ws + off); off = align_up(off + (size_t)MROWS * 32 * 2);
  p.O = (bf16_t*)(ws + off); off = align_up(off + (size_t)MROWS * 2048 * 2);
  p.HB = (bf16_t*)(ws + off); off = align_up(off + (size_t)MROWS * 1024 * 2);
  p.RSA = (float*)(ws + off); off = align_up(off + (size_t)MROWS * 4);
  p.RSB = (float*)(ws + off); off = align_up(off + (size_t)MROWS * 4);
  p.ST = (bf16_t*)(ws + off); off = align_up(off + (size_t)512 * 8192 * 2);
  p.GD = (float*)(ws + off); off = align_up(off + (size_t)16 * 8 * 2 * 128 * 4);
  p.hmeta = (float*)(ws + off); off = align_up(off + (size_t)2 * 128 * 1024 * 4);
  p.bar = (unsigned*)(ws + off); off = align_up(off + (size_t)XCD_BAR_WORDS * 4);
  if (off > ws_size) { fprintf(stderr, "workspace too small: need %zu have %zu\n", off, ws_size); return; }

#ifdef MULTI_LAUNCH
#define LAUNCH_PK(ST, l, g) do { \
    static bool attr_set_##ST = false; \
    if (!attr_set_##ST) { (void)hipFuncSetAttribute((const void*)pk<ST>, hipFuncAttributeMaxDynamicSharedMemorySize, LDS_BYTES + 32); attr_set_##ST = true; } \
    hipLaunchKernelGGL(pk<ST>, dim3(512), dim3(256), LDS_BYTES + 32, stream, p, l, g); } while (0)
  LAUNCH_PK(100, 0, 0);
  for (int g = 0; g < 2; ++g)
    for (int l = 0; l < 2; ++l) {
      if (l == 0) LAUNCH_PK(102, l, g);
      LAUNCH_PK(0, l, g); LAUNCH_PK(1, l, g); LAUNCH_PK(2, l, g); LAUNCH_PK(3, l, g); LAUNCH_PK(4, l, g); LAUNCH_PK(5, l, g);
      LAUNCH_PK(6, l, g); LAUNCH_PK(7, l, g); LAUNCH_PK(8, l, g); LAUNCH_PK(9, l, g); LAUNCH_PK(10, l, g);
    }
  LAUNCH_PK(101, 0, 0);
#else
  static int grid_blocks = 0;
  if (!grid_blocks) {
    (void)hipFuncSetAttribute((const void*)mega, hipFuncAttributeMaxDynamicSharedMemorySize, LDS_BYTES + 32);
    int dev = 0, cus = 0, per_cu = 0;
    (void)hipGetDevice(&dev);
    (void)hipDeviceGetAttribute(&cus, hipDeviceAttributeMultiprocessorCount, dev);
    (void)hipOccupancyMaxActiveBlocksPerMultiprocessor(&per_cu, (const void*)mega, 256, LDS_BYTES + 32);
    if (per_cu < 1) per_cu = 1;
    if (per_cu > 2) per_cu = 2;
    grid_blocks = cus * per_cu;
  }
  (void)hipMemsetAsync(p.bar, 0, (size_t)XCD_BAR_WORDS * 4, stream);
  int plo = 0, phi = NPHASES, coop = 1;
  void* args[] = {&p, &plo, &phi, &coop};
  hipError_t e = hipLaunchCooperativeKernel((const void*)mega, dim3(grid_blocks), dim3(256), args, LDS_BYTES + 32, stream);
  if (e != hipSuccess) fprintf(stderr, "cooperative launch failed: %s (grid %d)\n", hipGetErrorString(e), grid_blocks);
#endif
}
```

```cpp
#include <hip/hip_runtime.h>
#include <hip/hip_cooperative_groups.h>
#include <stdint.h>
#include <stdio.h>
namespace cg = cooperative_groups;

typedef __attribute__((ext_vector_type(8))) short bf16x8;
typedef __attribute__((ext_vector_type(4))) float f32x4;
typedef unsigned short bf16_t;
typedef uint32_t u32x4 __attribute__((ext_vector_type(4)));
typedef uint32_t u32x2 __attribute__((ext_vector_type(2)));
typedef float fl4 __attribute__((ext_vector_type(4)));
#define MK4(a,b,c,d) ((u32x4){(uint32_t)(a),(uint32_t)(b),(uint32_t)(c),(uint32_t)(d)})
#define MK2(a,b) ((u32x2){(uint32_t)(a),(uint32_t)(b)})
#define MKF4(a,b,c,d) ((fl4){(a),(b),(c),(d)})

#define NTOKG 16384
#define MROWS 16512
#define MTILES 129
#define LSTRIDE 20185088
#define WOFF_A 0
#define WOFF_B (4096 * 1024)
#define WOFF_G (6400 * 1024)
#define WOFF_O (10496 * 1024)
#define WOFF_U (11520 * 1024)
#define WOFF_D (15616 * 1024)
#define LDS_BYTES 80896
#define NPHASES 48

struct Params {
  const float* x[2];
  const float* meta;
  const float* attn_norm;
  const float* w_in;
  const float* lb_logits;
  const float* w_gate;
  const float* b_gate;
  const float* norm_a;
  const float* norm_b;
  const float* w_out;
  const float* mlp_norm;
  const float* w_up;
  const float* w_down;
  const float* final_norm;
  float* out;
  bf16_t* W;
  bf16_t* X;
  bf16_t* R;
  bf16_t* O;
  bf16_t* HB;
  float* RSA;
  float* RSB;
  bf16_t* ST;
  float* GD;
  float* hmeta;
  unsigned* bar;
};

__device__ __forceinline__ uint32_t pack2(float a, float b) {
  uint32_t r;
  asm("v_cvt_pk_bf16_f32 %0, %1, %2" : "=v"(r) : "v"(a), "v"(b));
  return r;
}
__device__ __forceinline__ bf16_t f2bf(float f) { return (bf16_t)(pack2(f, f) & 0xffffu); }
__device__ __forceinline__ int opaque_tid(char* smem) {
  int lane;
  asm volatile("v_mbcnt_lo_u32_b32 %0, -1, 0\n\tv_mbcnt_hi_u32_b32 %0, -1, %0" : "=v"(lane));
  int* cnt = (int*)(smem + LDS_BYTES);
  int w = 0;
  if (lane == 0) w = atomicAdd(cnt, 1);
  w = __builtin_amdgcn_readfirstlane(w) & 3;
  __syncthreads();
  return w * 64 + lane;
}
__device__ __forceinline__ int opaque_bid() { int b = blockIdx.x; asm volatile("" : "+s"(b)); return b; }
template <int M>
__device__ __forceinline__ float shx(float v, int lane) {
  if (M < 32) return __builtin_bit_cast(float, __builtin_amdgcn_ds_swizzle(__builtin_bit_cast(int, v), 0x1f | (M << 10)));
  return __builtin_bit_cast(float, __builtin_amdgcn_ds_bpermute((lane ^ M) << 2, __builtin_bit_cast(int, v)));
}
__device__ __forceinline__ float bf2f(bf16_t b) { return __uint_as_float(((uint32_t)b) << 16); }
__device__ __forceinline__ size_t tiled_off(size_t row, int col, int K) {
  return (((row >> 7) * (size_t)(K >> 5) + (size_t)(col >> 5)) * 128 + (row & 127)) * 32 + (size_t)(col & 31);
}
__device__ __forceinline__ float sigmoidf_(float x) { return __builtin_amdgcn_rcpf(1.f + __builtin_amdgcn_exp2f(x * -1.4426950408889634f)); }

__device__ __forceinline__ int w_in_col(int R, float& scale) {
  scale = 1.f;
  if (R < 4096) return R;
  if (R < 6400) {
    int n = R - 4096;
    if (n >= 2080) return -1;
    if (n < 512) scale = 0.08838834764831845f;
    return 5120 + n;
  }
  int n = R - 6400;
  int tt = n >> 8, wv = n & 255;
  int wn = wv >> 7, nl = wv & 127;
  int qd = nl >> 5, ni = (nl >> 2) & 7, r = nl & 3;
  int grp = ni >> 2, seg = ni & 3;
  int ucol = tt * 64 + wn * 32 + qd * 8 + grp * 4 + r;
  int base = seg == 0 ? 4096 : seg == 1 ? 8224 : seg == 2 ? 7200 : 9248;
  return base + ucol;
}

__device__ __forceinline__ void phase_init(const Params& p, char* smem) {
  const int t = opaque_tid(smem);
  const int bid_ = opaque_bid();
  for (int idx = bid_ * 256 + t; idx < 2 * 128 * 256; idx += gridDim.x * 256) {
    int g = idx / (128 * 256), r = (idx / 256) % 128, c4 = idx % 256;
    int nvalid = g == 0 ? 16 : 64;
    fl4 v = MKF4(0.f, 0.f, 0.f, 0.f);
    if (r < nvalid) v = *(const fl4*)(p.meta + (size_t)(r & 15) * 1024 + c4 * 4);
    *(fl4*)(p.hmeta + ((size_t)g * 128 + r) * 1024 + c4 * 4) = v;
  }
  float* tile = (float*)smem;
  const int per_layer = 3904 + 1024;
  for (int id = bid_; id < 2 * per_layer; id += gridDim.x) {
    int l = id / per_layer, r = id % per_layer;
    const float* src; int ld; const float* gain = nullptr; int K, n0, k0;
    bf16_t* dst;
    int kind;
    int cbase = 0;
    if (r < 3904) {
      int rt = r >> 4, kt = r & 15;
      n0 = rt * 64; k0 = kt * 64; K = 1024;
      dst = p.W + (size_t)l * LSTRIDE;
      if (n0 < 10496) { kind = 0; src = p.w_in + (size_t)l * 1024 * 10272; ld = 10272; gain = p.attn_norm + l * 1024; }
      else if (n0 < 11520) { kind = 1; src = p.w_out + (size_t)l * 1024 * 1024; ld = 1024; cbase = n0 - 10496; }
      else { kind = 1; src = p.w_up + (size_t)l * 1024 * 4096; ld = 4096; cbase = n0 - 11520; gain = p.mlp_norm + l * 1024; }
    } else {
      int r2 = r - 3904;
      int rt = r2 >> 6, kt = r2 & 63;
      n0 = rt * 64; k0 = kt * 64; K = 4096;
      dst = p.W + (size_t)l * LSTRIDE + WOFF_D;
      kind = 1; src = p.w_down + (size_t)l * 4096 * 1024; ld = 1024; cbase = n0;
    }
    {
      int n = t & 63;
      float scale = 1.f; int col;
      if (kind == 0) col = w_in_col(n0 + n, scale); else col = cbase + n;
#pragma unroll 4
      for (int i = 0; i < 16; ++i) {
        int kk = (t >> 6) + 4 * i;
        float v = 0.f;
        if (col >= 0) {
          v = src[(size_t)(k0 + kk) * ld + col] * scale;
          if (gain) v *= gain[k0 + kk];
        }
        tile[kk * 65 + n] = v;
      }
    }
    __syncthreads();
    {
      int n = t >> 2, piece = t & 3;
      uint32_t pk[8];
#pragma unroll
      for (int e = 0; e < 8; ++e) {
        float a = tile[(piece * 16 + 2 * e) * 65 + n];
        float b = tile[(piece * 16 + 2 * e + 1) * 65 + n];
        pk[e] = pack2(a, b);
      }
      const int Rr = n0 + n, kk = k0 + piece * 16;
      u32x4* d = (u32x4*)(dst + ((size_t)((Rr >> 8) * (K >> 5) + (kk >> 5)) * 256 + (Rr & 255)) * 32 + (kk & 31));
      d[0] = MK4(pk[0], pk[1], pk[2], pk[3]);
      d[1] = MK4(pk[4], pk[5], pk[6], pk[7]);
    }
    __syncthreads();
  }
}

template <int NT>
__device__ __forceinline__ void tile_to_mn(int tile, int& mt, int& nt) {
  if ((NT == 16 || NT == 4) && tile < 128 * NT) {
    const int round = tile >> 9, s_ = tile & 511;
    const int xcd = s_ & 7, j = s_ >> 3;
    mt = round * (512 / NT) + (j / NT) * 8 + xcd;
    nt = j % NT;
  } else { mt = tile / NT; nt = tile % NT; }
}

enum { EPI_G1A = 0, EPI_G1B, EPI_GATES, EPI_WOUT, EPI_UP, EPI_DOWN };

template <int EPI>
__device__ __forceinline__ void gemm_phase(const Params& p, int l, int g, char* smem) {
  constexpr bool NORM = (EPI == EPI_G1A || EPI == EPI_G1B || EPI == EPI_GATES || EPI == EPI_UP);
  constexpr int K = (EPI == EPI_DOWN) ? 4096 : 1024;
  constexpr int NT = EPI == EPI_G1A ? 16 : EPI == EPI_G1B ? 9 : EPI == EPI_GATES ? 16 : EPI == EPI_WOUT ? 4 : EPI == EPI_UP ? 16 : 4;
  constexpr int WOFF = EPI == EPI_G1A ? WOFF_A : EPI == EPI_G1B ? WOFF_B : EPI == EPI_GATES ? WOFF_G : EPI == EPI_WOUT ? WOFF_O : EPI == EPI_UP ? WOFF_U : WOFF_D;
  constexpr int NK = K / 32;
  const bf16_t* Wl = p.W + (size_t)l * LSTRIDE + WOFF;
  bf16_t* As = (bf16_t*)smem;
  bf16_t* Bs = As + 3 * 128 * 32;
  const int bid_ = opaque_bid();
  const int t = opaque_tid(smem), lane = t & 63, w = t >> 6, wm = w >> 1, wn = w & 1;
  const int quad = lane >> 4, l15 = lane & 15;
  const int nvalid_meta = g == 0 ? 16 : 64;

  if (EPI == EPI_G1A) for (int i = bid_ * 256 + t; i < MROWS; i += gridDim.x * 256) p.RSB[i] = 0.f;
  if (EPI == EPI_UP) for (int i = bid_ * 256 + t; i < MROWS; i += gridDim.x * 256) p.RSA[i] = 0.f;
  bool pre = false;
  for (int tile = bid_; tile < MTILES * NT; tile += gridDim.x) {
    int mt, nt; tile_to_mn<NT>(tile, mt, nt);
    const bf16_t* Ab = NORM ? p.HB + (size_t)mt * 128 * 1024 : p.X + (size_t)mt * 128 * K;
    const bf16_t* Bg = Wl + (size_t)nt * 256 * K;
    const bool do_mma = !(mt == 128 && wm == 1) && !(EPI == EPI_G1B && nt == 8 && wn == 1);

    f32x4 acc[4][8];
#pragma unroll
    for (int a = 0; a < 4; ++a)
#pragma unroll
      for (int b = 0; b < 8; ++b) acc[a][b] = (f32x4){0.f, 0.f, 0.f, 0.f};
    int t_l = t;
    asm volatile("" : "+v"(t_l));
    const uint32_t voffA = (uint32_t)((t_l >> 2) * 64 + (((t_l & 3) ^ (((t_l >> 5) & 1) << 1)) * 16));
    const uint32_t voffB0 = (uint32_t)((t_l >> 2) * 64 + ((t_l & 3) * 16));
    const uint32_t voffB1 = (uint32_t)((t_l >> 2) * 64 + (((t_l & 3) ^ 2) * 16));
    const char* Abase = (const char*)Ab;
    const char* Bbase = (const char*)Bg;
    const int rpiece = quad ^ (((l15 >> 3) & 1) << 1);
    const int w_s = __builtin_amdgcn_readfirstlane(t_l >> 6);
#define GLDS(gp, lp) __builtin_amdgcn_global_load_lds((const __attribute__((address_space(1))) void*)(gp), (__attribute__((address_space(3))) void*)(lp), 16, 0, 0)
#define G_DMA(KT, BUF) G_DMA2(Abase, Bbase, KT, BUF)
#define G_DMA2(AB_, BB_, KT, BUF) do { \
      const char* ua = (AB_) + (size_t)(KT) * 8192; const char* ub = (BB_) + (size_t)(KT) * 16384; \
      asm volatile("" : "+s"(ua), "+s"(ub));     \
      char* la = (char*)(As + (BUF) * 4096) + w_s * 1024; char* lb = (char*)(Bs + (BUF) * 8192) + w_s * 1024;     \
      _Pragma("unroll") for (int i = 0; i < 2; ++i) GLDS(ua + i * 4096 + voffA, la + i * 4096); \
      _Pragma("unroll") for (int i = 0; i < 4; ++i) GLDS(ub + i * 4096 + ((i & 1) ? voffB1 : voffB0), lb + i * 4096); } while (0)
#define G_COMPUTE(BUF) do { \
      if (do_mma) { \
      const bf16_t* Aw = As + (BUF) * 4096; const bf16_t* Bw = Bs + (BUF) * 8192; \
      bf16x8 af[4], bfr[8]; \
      _Pragma("unroll") for (int mi = 0; mi < 4; ++mi) af[mi] = *(const bf16x8*)(Aw + (wm * 64 + mi * 16 + l15) * 32 + rpiece * 8); \
      _Pragma("unroll") for (int ni = 0; ni < 8; ++ni) bfr[ni] = *(const bf16x8*)(Bw + (wn * 128 + (l15 >> 2) * 32 + ni * 4 + (l15 & 3)) * 32 + rpiece * 8); \
      __builtin_amdgcn_s_setprio(1); \
      _Pragma("unroll") for (int ni = 0; ni < 8; ++ni) \
        _Pragma("unroll") for (int mi = 0; mi < 4; ++mi) \
          acc[mi][ni] = __builtin_amdgcn_mfma_f32_16x16x32_bf16(bfr[ni], af[mi], acc[mi][ni], 0, 0, 0); \
      __builtin_amdgcn_s_setprio(0); } } while (0)

    if (!pre) { G_DMA(0, 0); G_DMA(1, 1); }
    asm volatile("s_waitcnt vmcnt(0)" ::: "memory");
#define G_STEP3(CUR, NXT, KN) do { \
      asm volatile("s_waitcnt vmcnt(6)\n\ts_waitcnt lgkmcnt(0)" ::: "memory"); \
      __builtin_amdgcn_s_barrier(); \
      asm volatile("" ::: "memory"); \
      G_DMA(KN, NXT); \
      G_COMPUTE(CUR); } while (0)
#pragma unroll 1
    for (int kt = 0; kt < NK - 2; kt += 3) {
      G_STEP3(0, 2, kt + 2);
      G_STEP3(1, 0, kt + 3);
      G_STEP3(2, 1, kt + 4);
    }
    G_STEP3(0, 2, NK - 1);
    G_STEP3(1, 0, NK - 1);
#undef G_STEP3
    asm volatile("s_waitcnt vmcnt(0)" ::: "memory");
    __syncthreads();
    {
      const int tile2 = tile + (int)gridDim.x;
      pre = tile2 < MTILES * NT;
      if (pre) {
        int mt2, nt2; tile_to_mn<NT>(tile2, mt2, nt2);
        const char* Ab2 = (const char*)(NORM ? p.HB + (size_t)mt2 * 128 * 1024 : p.X + (size_t)mt2 * 128 * K);
        const char* Bg2 = (const char*)(Wl + (size_t)nt2 * 256 * K);
        G_DMA2(Ab2, Bg2, 0, 0);
        G_DMA2(Ab2, Bg2, 1, 1);
      }
    }
#undef GLDS
#undef G_DMA
#undef G_DMA2
#undef G_COMPUTE

    int quad_e = quad, l15_e = l15, t_e = t;
    asm volatile("" : "+v"(quad_e), "+v"(l15_e), "+v"(t_e));
    if (do_mma) {
#pragma unroll
    for (int mi = 0; mi < 4; ++mi) {
      __builtin_amdgcn_sched_barrier(0);
      const int rl = wm * 64 + mi * 16 + l15_e;
      const size_t grow = (size_t)mt * 128 + rl;
      const float rs = NORM ? rsqrtf((EPI == EPI_UP ? p.RSB : p.RSA)[grow] * (1.f / 1024.f) + 1e-6f) : 1.f;
      const int cw = wn * 128 + quad_e * 32;
      if (EPI == EPI_G1A) {
        const int region = nt >> 2;
        bf16_t* xp = p.X + grow * 4096 + nt * 256 + cw;
#pragma unroll
        for (int c = 0; c < 4; ++c) {
          float v[8];
#pragma unroll
          for (int e = 0; e < 8; ++e) v[e] = acc[mi][2 * c + (e >> 2)][e & 3] * rs;
          if (region == 1 || region == 2) {
            float lb[8] = {0.f, 0.f, 0.f, 0.f, 0.f, 0.f, 0.f, 0.f};
            if (l == 1) {
              const float* l0p = p.lb_logits + (region - 1) * 1024 + ((nt * 256 + cw + c * 8) & 1023);
              const fl4 a0 = *(const fl4*)l0p, a1 = *(const fl4*)(l0p + 4);
              const fl4 b0 = *(const fl4*)(l0p + 2048), b1 = *(const fl4*)(l0p + 2052);
              lb[0] = sigmoidf_(b0.x - a0.x); lb[1] = sigmoidf_(b0.y - a0.y);
              lb[2] = sigmoidf_(b0.z - a0.z); lb[3] = sigmoidf_(b0.w - a0.w);
              lb[4] = sigmoidf_(b1.x - a1.x); lb[5] = sigmoidf_(b1.y - a1.y);
              lb[6] = sigmoidf_(b1.z - a1.z); lb[7] = sigmoidf_(b1.w - a1.w);
            }
#pragma unroll
            for (int e = 0; e < 8; ++e) {
              const float f = fmaxf(lb[e], 1e-30f) + (1.f - lb[e]) * sigmoidf_(v[e]);
              v[e] = __builtin_amdgcn_logf(f);
            }
          }
          *(u32x4*)(xp + c * 8) = MK4(pack2(v[0], v[1]), pack2(v[2], v[3]), pack2(v[4], v[5]), pack2(v[6], v[7]));
        }
      } else if (EPI == EPI_G1B) {
        if (nt < 8) {
          bf16_t* xp = p.X + grow * 2048 + nt * 256 + cw;
#pragma unroll
          for (int c = 0; c < 4; ++c)
            *(u32x4*)(xp + c * 8) = MK4(pack2(acc[mi][2 * c][0] * rs, acc[mi][2 * c][1] * rs), pack2(acc[mi][2 * c][2] * rs, acc[mi][2 * c][3] * rs),
                                        pack2(acc[mi][2 * c + 1][0] * rs, acc[mi][2 * c + 1][1] * rs), pack2(acc[mi][2 * c + 1][2] * rs, acc[mi][2 * c + 1][3] * rs));
        } else if (cw == 0) {
          bf16_t* rp = p.R + grow * 32;
#pragma unroll
          for (int c = 0; c < 4; ++c)
            *(u32x4*)(rp + c * 8) = MK4(pack2(acc[mi][2 * c][0] * rs, acc[mi][2 * c][1] * rs), pack2(acc[mi][2 * c][2] * rs, acc[mi][2 * c][3] * rs),
                                        pack2(acc[mi][2 * c + 1][0] * rs, acc[mi][2 * c + 1][1] * rs), pack2(acc[mi][2 * c + 1][2] * rs, acc[mi][2 * c + 1][3] * rs));
        }
      } else if (EPI == EPI_GATES) {
        const int uc = nt * 64 + wn * 32 + quad_e * 8;
        const u32x4 oa = *(const u32x4*)(p.O + grow * 2048 + uc);
        const u32x4 ob = *(const u32x4*)(p.O + grow * 2048 + 1024 + uc);
        const uint32_t oau[4] = {oa.x, oa.y, oa.z, oa.w}, obu[4] = {ob.x, ob.y, ob.z, ob.w};
        float u[8];
#pragma unroll
        for (int grp = 0; grp < 2; ++grp)
#pragma unroll
          for (int r = 0; r < 4; ++r) {
            const int idx = grp * 4 + r;
            const float ga = acc[mi][grp * 4 + 0][r] * rs, ma = acc[mi][grp * 4 + 1][r] * rs;
            const float gb = acc[mi][grp * 4 + 2][r] * rs, mb = acc[mi][grp * 4 + 3][r] * rs;
            const float ona = (idx & 1) ? __uint_as_float(oau[idx >> 1] & 0xffff0000u) : __uint_as_float(oau[idx >> 1] << 16);
            const float onb = (idx & 1) ? __uint_as_float(obu[idx >> 1] & 0xffff0000u) : __uint_as_float(obu[idx >> 1] << 16);
            u[idx] = sigmoidf_(ma) * (ga * sigmoidf_(ga)) * ona + sigmoidf_(mb) * (gb * sigmoidf_(gb)) * onb;
          }
        *(u32x4*)(p.X + tiled_off(grow, uc, 1024)) = MK4(pack2(u[0], u[1]), pack2(u[2], u[3]), pack2(u[4], u[5]), pack2(u[6], u[7]));
      } else if (EPI == EPI_WOUT || EPI == EPI_DOWN) {
        const bool meta = (mt == 128);
        float hsq = 0.f;
        if (!meta || rl < nvalid_meta) {
          const float* hin; float* hout;
          if (meta) { hout = p.hmeta + ((size_t)g * 128 + rl) * 1024; hin = hout; }
          else {
            const size_t trow = (size_t)mt * 128 + rl;
            hout = p.out + ((size_t)g * NTOKG + trow) * 1024;
            hin = (EPI == EPI_WOUT && l == 0) ? p.x[g] + trow * 1024 : hout;
          }
          const int col0 = nt * 256 + cw;
          bf16_t* hb = p.HB + tiled_off(grow, col0, 1024);
#pragma unroll
          for (int c = 0; c < 4; ++c) {
            const fl4 h0 = *(const fl4*)(hin + col0 + c * 8), h1 = *(const fl4*)(hin + col0 + c * 8 + 4);
            const fl4 o0 = MKF4(h0.x + acc[mi][2 * c][0], h0.y + acc[mi][2 * c][1], h0.z + acc[mi][2 * c][2], h0.w + acc[mi][2 * c][3]);
            const fl4 o1 = MKF4(h1.x + acc[mi][2 * c + 1][0], h1.y + acc[mi][2 * c + 1][1], h1.z + acc[mi][2 * c + 1][2], h1.w + acc[mi][2 * c + 1][3]);
            *(fl4*)(hout + col0 + c * 8) = o0;
            *(fl4*)(hout + col0 + c * 8 + 4) = o1;
            *(u32x4*)(hb + c * 8) = MK4(pack2(o0.x, o0.y), pack2(o0.z, o0.w), pack2(o1.x, o1.y), pack2(o1.z, o1.w));
            hsq += o0.x * o0.x + o0.y * o0.y + o0.z * o0.z + o0.w * o0.w + o1.x * o1.x + o1.y * o1.y + o1.z * o1.z + o1.w * o1.w;
          }
        }
        hsq += shx<16>(hsq, lane); hsq += shx<32>(hsq, lane);
        if (quad_e == 0 && (!meta || rl < nvalid_meta)) atomicAdd((EPI == EPI_WOUT ? p.RSB : p.RSA) + grow, hsq);
      } else if (EPI == EPI_UP) {
        bf16_t* xp = p.X + tiled_off(grow, nt * 256 + cw, 4096);
#pragma unroll
        for (int c = 0; c < 4; ++c) {
          float v[8];
#pragma unroll
          for (int e = 0; e < 8; ++e) { const float a = fmaxf(acc[mi][2 * c + (e >> 2)][e & 3] * rs, 0.f); v[e] = a * a; }
          *(u32x4*)(xp + c * 8) = MK4(pack2(v[0], v[1]), pack2(v[2], v[3]), pack2(v[4], v[5]), pack2(v[6], v[7]));
        }
      }
    }
    }
  }
}

template <int MIX, int PASS>
__device__ __forceinline__ void scan_phase(const Params& p, int l, int g, char* smem) {
  constexpr int NH = MIX ? 4 : 8;
  constexpr int NDV = MIX ? 4 : 2;
  constexpr int XLD = MIX ? 2048 : 4096;
  bf16_t* QS = (bf16_t*)smem;
  bf16_t* KS = QS + 64 * 136;
  bf16_t* KT = KS + 64 * 136;
  bf16_t* LG = KT;
  bf16_t* Pm = QS;
  bf16_t* SmT = KS;
  bf16_t* VT = KT + 128 * 72;
  bf16_t* RS = VT + 64 * 72;
  float* em = (float*)(RS + 64 * 24);
  float* el = em + 128;
  float* tot = el + 128;
  const int bid_ = opaque_bid();
  const int t_outer = opaque_tid(smem);
  const int sps = g == 0 ? 16 : 4;
  constexpr bool do_out = (PASS == 3);
  const bf16_t* Xg = p.X;

  for (int item = bid_; item < 512; item += gridDim.x) {
    int t = t_outer;
    asm volatile("" : "+v"(t));
    const int lane = t & 63, w = t >> 6, quad = lane >> 4, l15 = lane & 15;
    const int dir = item & 1;
    const int dvb = (item >> 1) % NDV;
    const int head = ((item >> 1) / NDV) % NH;
    const int seg = item >> 5;
    const int seq = seg / sps;
    const bool first = (seg % sps) == 0;
    const int nsteps = 16 + (first ? 1 : 0);
    int qcol, kcol, vcol;
    bf16_t* Og; int OLD;
    if (MIX == 0) {
      qcol = head * 128; kcol = 1024 + dir * 1024 + head * 128; vcol = 3072 + head * 128 + dvb * 64;
      Og = p.O + dir * 1024 + head * 128 + dvb * 64; OLD = 2048;
    } else {
      qcol = head * 128; kcol = 512 + head * 128; vcol = 1024 + head * 256 + dvb * 64;
      Og = p.X + (size_t)MROWS * 2048 + (size_t)dir * MROWS * 1024 + head * 256 + dvb * 64; OLD = 1024;
    }
    bf16x8 wgf[2]; float bgv[2][4];
    if (MIX == 1) {
#pragma unroll
      for (int ct = 0; ct < 2; ++ct) {
        const int cc = 16 * (2 * w + ct) + l15;
        bf16x8 v = (bf16x8){0, 0, 0, 0, 0, 0, 0, 0};
        if (quad < 2) {
#pragma unroll
          for (int e = 0; e < 8; ++e)
            v[e] = (short)f2bf(p.w_gate[((size_t)(l * 2 + dir) * 16 + quad * 8 + e) * 512 + head * 128 + cc]);
        }
        wgf[ct] = v;
#pragma unroll
        for (int r = 0; r < 4; ++r) bgv[ct][r] = p.b_gate[(l * 2 + dir) * 512 + head * 128 + 16 * (2 * w + ct) + quad * 4 + r];
      }
    }
    f32x4 S[8];
#pragma unroll
    for (int a = 0; a < 8; ++a) S[a] = (f32x4){0.f, 0.f, 0.f, 0.f};
    if (do_out) {
      int s2 = dir == 0 ? seq * sps : seq * sps + sps - 1;
      const int stp = dir == 0 ? 1 : -1;
      for (; s2 != seg; s2 += stp) {
        const int item2 = ((s2 * NH + head) * NDV + dvb) * 2 + dir;
        const bf16_t* L = p.ST + (size_t)item2 * 8192;
        const float* G = p.GD + ((s2 * 8 + head) * 2 + dir) * 128;
#pragma unroll
        for (int a = 0; a < 8; ++a)
#pragma unroll
          for (int r = 0; r < 4; ++r) {
            const int k = 16 * (2 * w + (a >> 2)) + quad * 4 + r;
            S[a][r] = __builtin_amdgcn_exp2f(G[k]) * S[a][r] + bf2f(L[(a * 4 + r) * 256 + t]);
          }
      }
    }
    float gacc0 = 0.f, gacc1 = 0.f;

    u32x4 qr[4], kr[4], vr[2], rr;
    auto step_rows = [&](int s, int& rowbase, int& nv) {
      bool meta;
      if (dir == 0) { meta = first && s == 0; rowbase = (seg * 16 + s - (first ? 1 : 0)) * 64; }
      else { meta = (s == 16); rowbase = (seg * 16 + 15 - s) * 64; }
      if (meta) { rowbase = NTOKG + seq * 16; nv = 16; } else nv = 64;
    };
    const char* Xq = (const char*)(Xg + qcol);
    const char* Xk = (const char*)(Xg + kcol);
    const char* Xv = (const char*)(Xg + vcol);
    const char* Rb = (const char*)(p.R + dir * 16);
    auto gload = [&](int s) {
      int rowbase, nv; step_rows(s, rowbase, nv);
#pragma unroll
      for (int j = 0; j < 4; ++j) {
        const int i = (t >> 4) + 16 * j;
        const int mr = dir ? rowbase + nv - 1 - i : rowbase + i;
        u32x4 z = MK4(0, 0, 0, 0);
        if (i < nv) {
          const uint32_t vo = (uint32_t)(mr * XLD + (t & 15) * 8) * 2u;
          qr[j] = do_out ? *(const u32x4*)(Xq + vo) : z;
          kr[j] = *(const u32x4*)(Xk + vo);
        } else { qr[j] = z; kr[j] = z; }
      }
      {
        const int i = t >> 2;
        const int mr = dir ? rowbase + nv - 1 - i : rowbase + i;
        vr[0] = MK4(0, 0, 0, 0); vr[1] = vr[0];
        if (i < nv) {
          const uint32_t vo = (uint32_t)(mr * XLD + (t & 3) * 16) * 2u;
          vr[0] = *(const u32x4*)(Xv + vo); vr[1] = *(const u32x4*)(Xv + vo + 16);
        }
      }
      if (MIX == 1) {
        rr = MK4(0, 0, 0, 0);
        if (t < 128) {
          const int i = t >> 1;
          const int mr = dir ? rowbase + nv - 1 - i : rowbase + i;
          if (i < nv) rr = *(const u32x4*)(Rb + (uint32_t)(mr * 32 + (t & 1) * 8) * 2u);
        }
      }
    };
    gload(0);

    for (int s = 0; s < nsteps; ++s) {
      int rowbase, nv; step_rows(s, rowbase, nv);
#pragma unroll
      for (int j = 0; j < 4; ++j) {
        const int i = (t >> 4) + 16 * j;
        if (do_out) *(u32x4*)(QS + i * 136 + (t & 15) * 8) = qr[j];
        *(u32x4*)(KS + i * 136 + (t & 15) * 8) = kr[j];
      }
      {
        const int i = t >> 2, piece = t & 3;
        uint32_t vv[8] = {vr[0].x, vr[0].y, vr[0].z, vr[0].w, vr[1].x, vr[1].y, vr[1].z, vr[1].w};
        bf16_t* vtw = VT + piece * 16 * 72 + i;
#pragma unroll
        for (int e = 0; e < 16; ++e) vtw[e * 72] = (bf16_t)((vv[e >> 1] >> ((e & 1) * 16)) & 0xffffu);
      }
      if (MIX == 1 && t < 128) *(u32x4*)(RS + (t >> 1) * 24 + (t & 1) * 8) = rr;
      if (s + 1 < nsteps) gload(s + 1);
      __syncthreads();
      if (MIX == 1) {
        bf16x8 af[4];
#pragma unroll
        for (int it = 0; it < 4; ++it) {
          af[it] = (bf16x8){0, 0, 0, 0, 0, 0, 0, 0};
          if (quad < 2) af[it] = *(const bf16x8*)(RS + (16 * it + l15) * 24 + quad * 8);
        }
#pragma unroll
        for (int ct = 0; ct < 2; ++ct)
#pragma unroll
          for (int it = 0; it < 4; ++it) {
            f32x4 z = __builtin_amdgcn_mfma_f32_16x16x32_bf16(wgf[ct], af[it], (f32x4){0.f, 0.f, 0.f, 0.f}, 0, 0, 0);
            float ls[4];
#pragma unroll
            for (int r = 0; r < 4; ++r) {
              const float zz = fmaxf(z[r] + bgv[ct][r], -80.f);
              ls[r] = __builtin_amdgcn_logf(1.f + __builtin_amdgcn_exp2f(zz * -1.4426950408889634f)) * -0.0625f;
            }
            *(u32x2*)(LG + (16 * it + l15) * 128 + 16 * (2 * w + ct) + quad * 4) = MK2(pack2(ls[0], ls[1]), pack2(ls[2], ls[3]));
          }
        __syncthreads();
      }
      const int cp = t & 63, rg = t >> 6;
      const int nvl = nv - 16 * rg;
      float p0[16], p1[16];
      {
        float run0 = 0.f, run1 = 0.f;
        constexpr int LFS32 = (MIX == 0) ? 68 : 64;
        const uint32_t* lfp = (const uint32_t*)((MIX == 0) ? (KS + 16 * rg * 136) : (LG + 16 * rg * 128)) + cp;
#pragma unroll
        for (int ii = 0; ii < 16; ++ii) {
          if ((ii & 7) == 0) __builtin_amdgcn_sched_barrier(0);
          const uint32_t u = lfp[ii * LFS32];
          float l0 = __uint_as_float(u << 16), l1 = __uint_as_float(u & 0xffff0000u);
          if (ii >= nvl) { l0 = 0.f; l1 = 0.f; }
          run0 += l0; run1 += l1;
          p0[ii] = run0; p1[ii] = run1;
        }
        *(float2*)(tot + rg * 128 + 2 * cp) = make_float2(run0, run1);
      }
      __syncthreads();
      {
        const float2 ta = *(const float2*)(tot + 2 * cp), tb = *(const float2*)(tot + 128 + 2 * cp);
        const float2 tc = *(const float2*)(tot + 256 + 2 * cp), td = *(const float2*)(tot + 384 + 2 * cp);
        const float m0 = ta.x + tb.x, m1 = ta.y + tb.y;
        const float base0 = (rg > 0 ? ta.x : 0.f) + (rg > 1 ? tb.x : 0.f) + (rg > 2 ? tc.x : 0.f);
        const float base1 = (rg > 0 ? ta.y : 0.f) + (rg > 1 ? tb.y : 0.f) + (rg > 2 ? tc.y : 0.f);
        uint32_t* qp = (uint32_t*)(QS + 16 * rg * 136) + cp;
        uint32_t* kp = (uint32_t*)(KS + 16 * rg * 136) + cp;
        float skp0 = __builtin_amdgcn_exp2f(-fminf(fmaxf(base0 - m0, -115.f), 115.f));
        float skp1 = __builtin_amdgcn_exp2f(-fminf(fmaxf(base1 - m1, -115.f), 115.f));
        uint32_t kt0[8], kt1[8], kkprev = 0;
#pragma unroll
        for (int ii = 0; ii < 16; ++ii) {
          if ((ii & 3) == 0) __builtin_amdgcn_sched_barrier(0);
          const float e0 = fminf(fmaxf(base0 + p0[ii] - m0, -115.f), 115.f);
          const float e1 = fminf(fmaxf(base1 + p1[ii] - m1, -115.f), 115.f);
          const float sq0 = __builtin_amdgcn_exp2f(e0), sq1 = __builtin_amdgcn_exp2f(e1);
          const float sk0 = __builtin_amdgcn_rcpf(sq0), sk1 = __builtin_amdgcn_rcpf(sq1);
          if (do_out) {
            const uint32_t uq = qp[ii * 68];
            qp[ii * 68] = pack2(__uint_as_float(uq << 16) * sq0, __uint_as_float(uq & 0xffff0000u) * sq1);
          }
          float k0, k1;
          if (MIX == 0) { k0 = 1.f - sq0 * skp0; k1 = 1.f - sq1 * skp1; skp0 = sk0; skp1 = sk1; }
          else { const uint32_t uk = kp[ii * 68]; k0 = __uint_as_float(uk << 16); k1 = __uint_as_float(uk & 0xffff0000u); }
          const uint32_t kk = pack2(k0 * sk0, k1 * sk1);
          if (do_out) kp[ii * 68] = kk;
          if (ii & 1) {
            kt0[ii >> 1] = __builtin_amdgcn_perm(kk, kkprev, 0x05040100u);
            kt1[ii >> 1] = __builtin_amdgcn_perm(kk, kkprev, 0x07060302u);
          } else kkprev = kk;
        }
        u32x4* kd0 = (u32x4*)(KT + (2 * cp) * 72 + 16 * rg);
        u32x4* kd1 = (u32x4*)(KT + (2 * cp + 1) * 72 + 16 * rg);
        kd0[0] = MK4(kt0[0], kt0[1], kt0[2], kt0[3]); kd0[1] = MK4(kt0[4], kt0[5], kt0[6], kt0[7]);
        kd1[0] = MK4(kt1[0], kt1[1], kt1[2], kt1[3]); kd1[1] = MK4(kt1[4], kt1[5], kt1[6], kt1[7]);
        if (rg == 0) {
          *(float2*)(em + 2 * cp) = make_float2(__builtin_amdgcn_exp2f(m0), __builtin_amdgcn_exp2f(m1));
          *(float2*)(el + 2 * cp) = make_float2(__builtin_amdgcn_exp2f(tc.x + td.x), __builtin_amdgcn_exp2f(tc.y + td.y));
        }
        gacc0 += m0 + tc.x + td.x; gacc1 += m1 + tc.y + td.y;
      }
      __syncthreads();
      if (do_out) {
        bf16x8 qf[4];
#pragma unroll
        for (int ks = 0; ks < 4; ++ks) qf[ks] = *(const bf16x8*)(QS + (16 * w + l15) * 136 + ks * 32 + quad * 8);
        f32x4 pa[4];
#pragma unroll
        for (int jt = 0; jt < 4; ++jt) {
          pa[jt] = (f32x4){0.f, 0.f, 0.f, 0.f};
          if (jt <= w) {
#pragma unroll
            for (int ks = 0; ks < 4; ++ks) {
              bf16x8 kf = *(const bf16x8*)(KS + (16 * jt + l15) * 136 + ks * 32 + quad * 8);
              pa[jt] = __builtin_amdgcn_mfma_f32_16x16x32_bf16(kf, qf[ks], pa[jt], 0, 0, 0);
            }
          }
        }
        __syncthreads();
        {
          const int i = 16 * w + l15;
          bf16_t* pw = Pm + i * 72 + quad * 4;
#pragma unroll
          for (int jt = 0; jt < 4; ++jt) {
            const int j0 = 16 * jt + quad * 4;
            float pv[4];
#pragma unroll
            for (int r = 0; r < 4; ++r) pv[r] = (jt <= w && j0 + r <= i) ? pa[jt][r] : 0.f;
            *(u32x2*)(pw + 16 * jt) = MK2(pack2(pv[0], pv[1]), pack2(pv[2], pv[3]));
          }
        }
#pragma unroll
        for (int a = 0; a < 8; ++a) {
          const int k0 = 16 * (2 * w + (a >> 2)) + quad * 4;
          const int v = 16 * (a & 3) + l15;
          const fl4 e = *(const fl4*)(em + k0);
          S[a][0] *= e.x; S[a][1] *= e.y; S[a][2] *= e.z; S[a][3] *= e.w;
          *(u32x2*)(SmT + v * 136 + k0) = MK2(pack2(S[a][0], S[a][1]), pack2(S[a][2], S[a][3]));
        }
        __syncthreads();
        f32x4 oa[4];
#pragma unroll
        for (int vt = 0; vt < 4; ++vt) {
          oa[vt] = (f32x4){0.f, 0.f, 0.f, 0.f};
#pragma unroll
          for (int ks = 0; ks < 4; ++ks) {
            bf16x8 sf = *(const bf16x8*)(SmT + (16 * vt + l15) * 136 + ks * 32 + quad * 8);
            oa[vt] = __builtin_amdgcn_mfma_f32_16x16x32_bf16(sf, qf[ks], oa[vt], 0, 0, 0);
          }
        }
#pragma unroll
        for (int js = 0; js < 2; ++js) {
          bf16x8 pfr = *(const bf16x8*)(Pm + (16 * w + l15) * 72 + js * 32 + quad * 8);
#pragma unroll
          for (int vt = 0; vt < 4; ++vt) {
            bf16x8 vf = *(const bf16x8*)(VT + (16 * vt + l15) * 72 + js * 32 + quad * 8);
            oa[vt] = __builtin_amdgcn_mfma_f32_16x16x32_bf16(vf, pfr, oa[vt], 0, 0, 0);
          }
        }
        {
          const int i = 16 * w + l15;
          if (i < nv) {
            const int mr = dir ? rowbase + nv - 1 - i : rowbase + i;
            bf16_t* op = (bf16_t*)((char*)Og + (uint32_t)(mr * OLD + quad * 4) * 2u);
#pragma unroll
            for (int vt = 0; vt < 4; ++vt) *(u32x2*)(op + 16 * vt) = MK2(pack2(oa[vt][0], oa[vt][1]), pack2(oa[vt][2], oa[vt][3]));
          }
        }
      } else {
#pragma unroll
        for (int a = 0; a < 8; ++a) {
          const int k0 = 16 * (2 * w + (a >> 2)) + quad * 4;
          const fl4 e = *(const fl4*)(em + k0);
          S[a][0] *= e.x; S[a][1] *= e.y; S[a][2] *= e.z; S[a][3] *= e.w;
        }
      }
#pragma unroll
      for (int js = 0; js < 2; ++js) {
        bf16x8 kf[2];
#pragma unroll
        for (int ktl = 0; ktl < 2; ++ktl) kf[ktl] = *(const bf16x8*)(KT + (16 * (2 * w + ktl) + l15) * 72 + js * 32 + quad * 8);
#pragma unroll
        for (int vt = 0; vt < 4; ++vt) {
          bf16x8 vf = *(const bf16x8*)(VT + (16 * vt + l15) * 72 + js * 32 + quad * 8);
#pragma unroll
          for (int ktl = 0; ktl < 2; ++ktl)
            S[ktl * 4 + vt] = __builtin_amdgcn_mfma_f32_16x16x32_bf16(kf[ktl], vf, S[ktl * 4 + vt], 0, 0, 0);
        }
      }
#pragma unroll
      for (int a = 0; a < 8; ++a) {
        const int k0 = 16 * (2 * w + (a >> 2)) + quad * 4;
        const fl4 e = *(const fl4*)(el + k0);
        S[a][0] *= e.x; S[a][1] *= e.y; S[a][2] *= e.z; S[a][3] *= e.w;
      }
      __syncthreads();
    }
    if (!do_out) {
      bf16_t* L = p.ST + (size_t)item * 8192;
#pragma unroll
      for (int a = 0; a < 8; ++a)
#pragma unroll
        for (int r = 0; r < 4; ++r) L[(a * 4 + r) * 256 + t] = f2bf(S[a][r]);
      if (dvb == 0 && t < 64) *(float2*)(p.GD + ((seg * 8 + head) * 2 + dir) * 128 + 2 * t) = make_float2(gacc0, gacc1);
    }
  }
}

__device__ __forceinline__ void phase_hn(const Params& p, int l, char* smem) {
  const int bid_ = opaque_bid();
  const int t = opaque_tid(smem), lane = t & 63, w = t >> 6;
  const bf16_t* Y1 = p.X + (size_t)MROWS * 2048;
  const bf16_t* Y2 = Y1 + (size_t)MROWS * 1024;
  for (int row = bid_ * 4 + w; row < MROWS; row += gridDim.x * 4) {
    bf16_t* oa = p.O + (size_t)row * 2048 + lane * 16;
    float xa[16], xb[16];
    {
      u32x4 a0 = *(const u32x4*)(oa), a1 = *(const u32x4*)(oa + 8);
      u32x4 b0 = *(const u32x4*)(oa + 1024), b1 = *(const u32x4*)(oa + 1032);
      uint32_t ua[8] = {a0.x, a0.y, a0.z, a0.w, a1.x, a1.y, a1.z, a1.w};
      uint32_t ub[8] = {b0.x, b0.y, b0.z, b0.w, b1.x, b1.y, b1.z, b1.w};
#pragma unroll
      for (int e = 0; e < 8; ++e) {
        xa[2 * e] = __uint_as_float(ua[e] << 16) + __uint_as_float(ub[e] << 16);
        xa[2 * e + 1] = __uint_as_float(ua[e] & 0xffff0000u) + __uint_as_float(ub[e] & 0xffff0000u);
      }
      const bf16_t* y1 = Y1 + (size_t)row * 1024 + lane * 16;
      const bf16_t* y2 = Y2 + (size_t)row * 1024 + lane * 16;
      u32x4 c0 = *(const u32x4*)(y1), c1 = *(const u32x4*)(y1 + 8);
      u32x4 d0 = *(const u32x4*)(y2), d1 = *(const u32x4*)(y2 + 8);
      uint32_t uc[8] = {c0.x, c0.y, c0.z, c0.w, c1.x, c1.y, c1.z, c1.w};
      uint32_t ud[8] = {d0.x, d0.y, d0.z, d0.w, d1.x, d1.y, d1.z, d1.w};
#pragma unroll
      for (int e = 0; e < 8; ++e) {
        xb[2 * e] = __uint_as_float(uc[e] << 16) + __uint_as_float(ud[e] << 16);
        xb[2 * e + 1] = __uint_as_float(uc[e] & 0xffff0000u) + __uint_as_float(ud[e] & 0xffff0000u);
      }
    }
    float sa = 0.f, sb = 0.f;
#pragma unroll
    for (int e = 0; e < 16; ++e) { sa += xa[e] * xa[e]; sb += xb[e] * xb[e]; }
    sa += shx<1>(sa, lane); sa += shx<2>(sa, lane); sa += shx<4>(sa, lane);
    sb += shx<1>(sb, lane); sb += shx<2>(sb, lane); sb += shx<4>(sb, lane); sb += shx<8>(sb, lane);
    const float ra = rsqrtf(sa * (1.f / 128.f) + 1e-6f);
    const float rb = rsqrtf(sb * (1.f / 256.f) + 1e-6f);
    const float* na = p.norm_a + l * 1024 + lane * 16;
    const float* nb = p.norm_b + l * 1024 + lane * 16;
    uint32_t pa[8], pb[8];
#pragma unroll
    for (int e = 0; e < 8; ++e) {
      pa[e] = pack2(xa[2 * e] * ra * na[2 * e], xa[2 * e + 1] * ra * na[2 * e + 1]);
      pb[e] = pack2(xb[2 * e] * rb * nb[2 * e], xb[2 * e + 1] * rb * nb[2 * e + 1]);
    }
    *(u32x4*)(oa) = MK4(pa[0], pa[1], pa[2], pa[3]);
    *(u32x4*)(oa + 8) = MK4(pa[4], pa[5], pa[6], pa[7]);
    *(u32x4*)(oa + 1024) = MK4(pb[0], pb[1], pb[2], pb[3]);
    *(u32x4*)(oa + 1032) = MK4(pb[4], pb[5], pb[6], pb[7]);
  }
}

__device__ __forceinline__ void phase_final(const Params& p, char* smem) {
  const int bid_ = opaque_bid();
  const int t = opaque_tid(smem), lane = t & 63, w = t >> 6;
  for (int row = bid_ * 4 + w; row < 2 * NTOKG; row += gridDim.x * 4) {
    float* hp = p.out + (size_t)row * 1024;
    fl4 v[4];
    float s = 0.f;
#pragma unroll
    for (int j = 0; j < 4; ++j) {
      v[j] = *(const fl4*)(hp + j * 256 + lane * 4);
      s += v[j].x * v[j].x + v[j].y * v[j].y + v[j].z * v[j].z + v[j].w * v[j].w;
    }
    s += shx<1>(s, lane); s += shx<2>(s, lane); s += shx<4>(s, lane);
    s += shx<8>(s, lane); s += shx<16>(s, lane); s += shx<32>(s, lane);
    const float rs = rsqrtf(s * (1.f / 1024.f) + 1e-6f);
#pragma unroll
    for (int j = 0; j < 4; ++j) {
      const fl4 gn = *(const fl4*)(p.final_norm + j * 256 + lane * 4);
      fl4 o = MKF4(v[j].x * rs * gn.x, v[j].y * rs * gn.y, v[j].z * rs * gn.z, v[j].w * rs * gn.w);
      *(fl4*)(hp + j * 256 + lane * 4) = o;
    }
  }
}

__device__ __forceinline__ void phase_xcvt(const Params& p, int g, char* smem) {
  const int bid_ = opaque_bid();
  const int t = opaque_tid(smem), lane = t & 63, w = t >> 6;
  for (int row = bid_ * 4 + w; row < MROWS; row += gridDim.x * 4) {
    const float* src = row < NTOKG ? p.x[g] + (size_t)row * 1024 : p.hmeta + ((size_t)g * 128 + (row - NTOKG)) * 1024;
    float ssq = 0.f;
#pragma unroll
    for (int j = 0; j < 2; ++j) {
      const int c8 = j * 64 + lane;
      const fl4 a = *(const fl4*)(src + c8 * 8), b = *(const fl4*)(src + c8 * 8 + 4);
      ssq += a.x * a.x + a.y * a.y + a.z * a.z + a.w * a.w + b.x * b.x + b.y * b.y + b.z * b.z + b.w * b.w;
      *(u32x4*)(p.HB + tiled_off((size_t)row, c8 * 8, 1024)) = MK4(pack2(a.x, a.y), pack2(a.z, a.w), pack2(b.x, b.y), pack2(b.z, b.w));
    }
    ssq += shx<1>(ssq, lane); ssq += shx<2>(ssq, lane); ssq += shx<4>(ssq, lane);
    ssq += shx<8>(ssq, lane); ssq += shx<16>(ssq, lane); ssq += shx<32>(ssq, lane);
    if (lane == 0) p.RSA[row] = ssq;
  }
}

__device__ __forceinline__ void run_phase(const Params& p, int ph, char* smem) {
  if (ph == 0) { phase_init(p, smem); return; }
  if (ph == NPHASES - 1) { phase_final(p, smem); return; }
  const int q = ph - 1;
  const int g = q / 23, r = q % 23;
  if (r == 0) { phase_xcvt(p, g, smem); return; }
  const int l = (r - 1) / 11, st = (r - 1) % 11;
  switch (st) {
    case 0: gemm_phase<EPI_G1A>(p, l, g, smem); break;
    case 1: scan_phase<0, 1>(p, l, g, smem); break;
    case 2: scan_phase<0, 3>(p, l, g, smem); break;
    case 3: gemm_phase<EPI_G1B>(p, l, g, smem); break;
    case 4: scan_phase<1, 1>(p, l, g, smem); break;
    case 5: scan_phase<1, 3>(p, l, g, smem); break;
    case 6: phase_hn(p, l, smem); break;
    case 7: gemm_phase<EPI_GATES>(p, l, g, smem); break;
    case 8: gemm_phase<EPI_WOUT>(p, l, g, smem); break;
    case 9: gemm_phase<EPI_UP>(p, l, g, smem); break;
    default: gemm_phase<EPI_DOWN>(p, l, g, smem); break;
  }
}

template <int ST>
__global__ void __launch_bounds__(256, 2) pk(Params p, int l, int g) {
  extern __shared__ __attribute__((aligned(16))) char smem[];
  if (ST == 100) phase_init(p, smem);
  else if (ST == 101) phase_final(p, smem);
  else if (ST == 102) phase_xcvt(p, g, smem);
  else if (ST == 0) gemm_phase<EPI_G1A>(p, l, g, smem);
  else if (ST == 1) scan_phase<0, 1>(p, l, g, smem);
  else if (ST == 2) scan_phase<0, 3>(p, l, g, smem);
  else if (ST == 3) gemm_phase<EPI_G1B>(p, l, g, smem);
  else if (ST == 4) scan_phase<1, 1>(p, l, g, smem);
  else if (ST == 5) scan_phase<1, 3>(p, l, g, smem);
  else if (ST == 6) phase_hn(p, l, smem);
  else if (ST == 7) gemm_phase<EPI_GATES>(p, l, g, smem);
  else if (ST == 8) gemm_phase<EPI_WOUT>(p, l, g, smem);
  else if (ST == 9) gemm_phase<EPI_UP>(p, l, g, smem);
  else gemm_phase<EPI_DOWN>(p, l, g, smem);
}


#define XB_TMO      128
#define XB_XCNT(j)  (256  + 64 * (j))
#define XB_XSUB(j)  (1280 + 64 * (j))
#define XB_XGEN(j)  (2304 + 64 * (j))
#define XB_TOP      3328
#define XB_TOPGEN   3392
#define XCD_BAR_WORDS 3456
#define XB_SPIN_CAP (1u << 22)
#define LAS __attribute__((address_space(3)))
__device__ __forceinline__ unsigned xb_ld(unsigned* p)              { return __hip_atomic_load(p, __ATOMIC_RELAXED, __HIP_MEMORY_SCOPE_AGENT); }
__device__ __forceinline__ unsigned xb_add(unsigned* p, unsigned v) { return __hip_atomic_fetch_add(p, v, __ATOMIC_RELAXED, __HIP_MEMORY_SCOPE_AGENT); }
__device__ __forceinline__ unsigned xb_xcc_id() { return (unsigned)__builtin_amdgcn_s_getreg((3 << 11) | 20) & 0xFu; }
#define XB_SPIN(cond, bar) do { unsigned _sp = 0; while (cond) { __builtin_amdgcn_s_sleep(1); \
    if ((++_sp & 255u) == 0u) { if (xb_ld(&(bar)[XB_TMO])) break; if (_sp > XB_SPIN_CAP) { atomicAdd(&(bar)[XB_TMO], 1u); break; } } } } while (0)

__device__ __forceinline__ void xcd_barrier_complete(unsigned* bar, unsigned x, unsigned& nloc, unsigned& nx) {
  const unsigned G = gridDim.x * gridDim.y * gridDim.z;
  unsigned sum, cnt, mine, sp = 0u;
  for (;;) {
    sum = 0u; cnt = 0u; mine = 0u;
#pragma unroll
    for (unsigned j = 0; j < 16; ++j) { const unsigned c = xb_ld(&bar[XB_XCNT(j)]); sum += c; cnt += (c > 0u) ? 1u : 0u; mine = (j == x) ? c : mine; }
    if (sum == G) break;
    __builtin_amdgcn_s_sleep(1);
    if ((++sp & 255u) == 0u) { if (xb_ld(&bar[XB_TMO])) break; if (sp > XB_SPIN_CAP) { atomicAdd(&bar[XB_TMO], 1u); break; } }
  }
  nloc = mine > 0u ? mine : 1u; nx = cnt > 0u ? cnt : 1u;
}

__device__ __forceinline__ void xcd_barrier(unsigned* bar, volatile LAS unsigned* st, bool leader_thread) {
  asm volatile("s_waitcnt vmcnt(0)" ::: "memory");
  __syncthreads();
  if (leader_thread) {
    const unsigned x = xb_xcc_id();
    __builtin_amdgcn_s_waitcnt(0);
    unsigned nloc = st[0], nx = st[1];
    if (nloc == 0u) { xcd_barrier_complete(bar, x, nloc, nx); st[0] = nloc; st[1] = nx; }
    const unsigned old = xb_add(&bar[XB_XSUB(x)], 1u);
    const unsigned gen = old / nloc;
    if (old + 1u == (gen + 1u) * nloc) {
      __builtin_amdgcn_fence(__ATOMIC_RELEASE, "agent");
      asm volatile("s_waitcnt vmcnt(0)" ::: "memory");
      const unsigned og = xb_add(&bar[XB_TOP], 1u);
      const unsigned tg = og / nx;
      if (og + 1u == (tg + 1u) * nx) xb_add(&bar[XB_TOPGEN], 1u);
      else XB_SPIN(xb_ld(&bar[XB_TOPGEN]) == tg, bar);
      __builtin_amdgcn_fence(__ATOMIC_ACQUIRE, "agent");
      xb_add(&bar[XB_XGEN(x)], 1u);
      asm volatile("s_waitcnt vmcnt(0)" ::: "memory");
    } else {
      XB_SPIN(xb_ld(&bar[XB_XGEN(x)]) == gen, bar);
      __builtin_amdgcn_fence(__ATOMIC_ACQUIRE, "agent");
      asm volatile("s_waitcnt vmcnt(0)" ::: "memory");
    }
  }
  __syncthreads();
}

#ifndef MULTI_LAUNCH
__global__ void __launch_bounds__(256, 2) mega(Params p, int plo, int phi, int coop) {
  extern __shared__ __attribute__((aligned(16))) char smem[];
  volatile LAS unsigned* st = (volatile LAS unsigned*)(smem + LDS_BYTES + 16);
  {
    const int t0 = opaque_tid(smem);
    if (t0 == 0) { st[0] = 0u; st[1] = 0u; (void)xb_add(&p.bar[XB_XCNT(xb_xcc_id())], 1u); }
    __syncthreads();
  }
  for (int ph = plo; ph < phi; ++ph) {
    run_phase(p, ph, smem);
    if (coop && ph + 1 < phi) {
      if (ph == 0) cg::this_grid().sync();
      else { const int tb = opaque_tid(smem); xcd_barrier(p.bar, st, tb == 0); }
    }
  }
}

#endif

static inline size_t align_up(size_t x) { return (x + 255) & ~(size_t)255; }

extern "C" void kernel_launch(void* const* d_in, const int* in_sizes, int n_in,
                              void* d_out, int out_size, void* d_ws, size_t ws_size,
                              hipStream_t stream) {
  Params p{};
  p.x[0] = (const float*)d_in[0];
  p.x[1] = (const float*)d_in[1];
  p.meta = (const float*)d_in[2];
  p.attn_norm = (const float*)d_in[3];
  p.w_in = (const float*)d_in[4];
  p.lb_logits = (const float*)d_in[5];
  p.w_gate = (const float*)d_in[6];
  p.b_gate = (const float*)d_in[7];
  p.norm_a = (const float*)d_in[8];
  p.norm_b = (const float*)d_in[9];
  p.w_out = (const float*)d_in[10];
  p.mlp_norm = (const float*)d_in[11];
  p.w_up = (const float*)d_in[12];
  p.w_down = (const float*)d_in[13];
  p.final_norm = (const float*)d_in[14];
  p.out = (float*)d_out;
  char* ws = (char*)d_ws;
  size_t off = 0;
  p.W = (bf16_t*)(ws + off); off = align_up(off + (size_t)2 * LSTRIDE * 2);
  p.X = (bf16_t*)(ws + off); off = align_up(off + (size_t)MROWS * 4096 * 2);
  p.R = (bf16_t*)(ws + off); off = align_up(off + (size_t)MROWS * 32 * 2);
  p.O = (bf16_t*)(ws + off); off = align_up(off + (size_t)MROWS * 2048 * 2);
  p.HB = (bf16_t*)(ws + off); off = align_up(off + (size_t)MROWS * 1024 * 2);
  p.RSA = (float*)(ws + off); off = align_up(off + (size_t)MROWS * 4);
  p.RSB = (float*)(ws + off); off = align_up(off + (size_t)MROWS * 4);
  p.ST = (bf16_t*)(ws + off); off = align_up(off + (size_t)512 * 8192 * 2);
  p.GD = (float*)(ws + off); off = align_up(off + (size_t)16 * 8 * 2 * 128 * 4);
  p.hmeta = (float*)(ws + off); off = align_up(off + (size_t)2 * 128 * 1024 * 4);
  p.bar = (unsigned*)(ws + off); off = align_up(off + (size_t)XCD_BAR_WORDS * 4);
  if (off > ws_size) { fprintf(stderr, "workspace too small: need %zu have %zu\n", off, ws_size); return; }

#ifdef MULTI_LAUNCH
#define LAUNCH_PK(ST, l, g) do { \
    static bool attr_set_##ST = false; \
    if (!attr_set_##ST) { (void)hipFuncSetAttribute((const void*)pk<ST>, hipFuncAttributeMaxDynamicSharedMemorySize, LDS_BYTES + 32); attr_set_##ST = true; } \
    hipLaunchKernelGGL(pk<ST>, dim3(512), dim3(256), LDS_BYTES + 32, stream, p, l, g); } while (0)
  LAUNCH_PK(100, 0, 0);
  for (int g = 0; g < 2; ++g)
    for (int l = 0; l < 2; ++l) {
      if (l == 0) LAUNCH_PK(102, l, g);
      LAUNCH_PK(0, l, g); LAUNCH_PK(1, l, g); LAUNCH_PK(2, l, g); LAUNCH_PK(3, l, g); LAUNCH_PK(4, l, g); LAUNCH_PK(5, l, g);
      LAUNCH_PK(6, l, g); LAUNCH_PK(7, l, g); LAUNCH_PK(8, l, g); LAUNCH_PK(9, l, g); LAUNCH_PK(10, l, g);
    }
  LAUNCH_PK(101, 0, 0);
#else
  static int grid_blocks = 0;
  if (!grid_blocks) {
    (void)hipFuncSetAttribute((const void*)mega, hipFuncAttributeMaxDynamicSharedMemorySize, LDS_BYTES + 32);
    int dev = 0, cus = 0, per_cu = 0;
    (void)hipGetDevice(&dev);
    (void)hipDeviceGetAttribute(&cus, hipDeviceAttributeMultiprocessorCount, dev);
    (void)hipOccupancyMaxActiveBlocksPerMultiprocessor(&per_cu, (const void*)mega, 256, LDS_BYTES + 32);
    if (per_cu < 1) per_cu = 1;
    if (per_cu > 2) per_cu = 2;
    grid_blocks = cus * per_cu;
  }
  (void)hipMemsetAsync(p.bar, 0, (size_t)XCD_BAR_WORDS * 4, stream);
  int plo = 0, phi = NPHASES, coop = 1;
  void* args[] = {&p, &plo, &phi, &coop};
  hipError_t e = hipLaunchCooperativeKernel((const void*)mega, dim3(grid_blocks), dim3(256), args, LDS_BYTES + 32, stream);
  if (e != hipSuccess) fprintf(stderr, "cooperative launch failed: %s (grid %d)\n", hipGetErrorString(e), grid_blocks);
#endif
}
```

```cpp
#include <hip/hip_runtime.h>
#include <hip/hip_cooperative_groups.h>
#include <stdint.h>
#include <stdio.h>
namespace cg = cooperative_groups;

typedef __attribute__((ext_vector_type(8))) short bf16x8;
typedef __attribute__((ext_vector_type(4))) float f32x4;
typedef unsigned short bf16_t;
typedef uint32_t u32x4 __attribute__((ext_vector_type(4)));
typedef uint32_t u32x2 __attribute__((ext_vector_type(2)));
typedef float fl4 __attribute__((ext_vector_type(4)));
#define MK4(a,b,c,d) ((u32x4){(uint32_t)(a),(uint32_t)(b),(uint32_t)(c),(uint32_t)(d)})
#define MK2(a,b) ((u32x2){(uint32_t)(a),(uint32_t)(b)})
#define MKF4(a,b,c,d) ((fl4){(a),(b),(c),(d)})

#define NTOKG 16384
#define MROWS 16512
#define MTILES 129
#define LSTRIDE 20185088
#define WOFF_A 0
#define WOFF_B (4096 * 1024)
#define WOFF_G (6400 * 1024)
#define WOFF_O (10496 * 1024)
#define WOFF_U (11520 * 1024)
#define WOFF_D (15616 * 1024)
#define LDS_BYTES 80896
#define NPHASES 48

struct Params {
  const float* x[2];
  const float* meta;
  const float* attn_norm;
  const float* w_in;
  const float* lb_logits;
  const float* w_gate;
  const float* b_gate;
  const float* norm_a;
  const float* norm_b;
  const float* w_out;
  const float* mlp_norm;
  const float* w_up;
  const float* w_down;
  const float* final_norm;
  float* out;
  bf16_t* W;
  bf16_t* X;
  bf16_t* R;
  bf16_t* O;
  bf16_t* HB;
  float* RSA;
  float* RSB;
  bf16_t* ST;
  float* GD;
  float* hmeta;
  unsigned* bar;
};

__device__ __forceinline__ uint32_t pack2(float a, float b) {
  uint32_t r;
  asm("v_cvt_pk_bf16_f32 %0, %1, %2" : "=v"(r) : "v"(a), "v"(b));
  return r;
}
__device__ __forceinline__ bf16_t f2bf(float f) { return (bf16_t)(pack2(f, f) & 0xffffu); }
__device__ __forceinline__ int opaque_tid(char* smem) {
  int lane;
  asm volatile("v_mbcnt_lo_u32_b32 %0, -1, 0\n\tv_mbcnt_hi_u32_b32 %0, -1, %0" : "=v"(lane));
  int* cnt = (int*)(smem + LDS_BYTES);
  int w = 0;
  if (lane == 0) w = atomicAdd(cnt, 1);
  w = __builtin_amdgcn_readfirstlane(w) & 3;
  __syncthreads();
  return w * 64 + lane;
}
__device__ __forceinline__ int opaque_bid() { int b = blockIdx.x; asm volatile("" : "+s"(b)); return b; }
template <int M>
__device__ __forceinline__ float shx(float v, int lane) {
  if (M < 32) return __builtin_bit_cast(float, __builtin_amdgcn_ds_swizzle(__builtin_bit_cast(int, v), 0x1f | (M << 10)));
  return __builtin_bit_cast(float, __builtin_amdgcn_ds_bpermute((lane ^ M) << 2, __builtin_bit_cast(int, v)));
}
__device__ __forceinline__ float bf2f(bf16_t b) { return __uint_as_float(((uint32_t)b) << 16); }
__device__ __forceinline__ size_t tiled_off(size_t row, int col, int K) {
  return (((row >> 7) * (size_t)(K >> 5) + (size_t)(col >> 5)) * 128 + (row & 127)) * 32 + (size_t)(col & 31);
}
__device__ __forceinline__ float sigmoidf_(float x) { return __builtin_amdgcn_rcpf(1.f + __builtin_amdgcn_exp2f(x * -1.4426950408889634f)); }

__device__ __forceinline__ int w_in_col(int R, float& scale) {
  scale = 1.f;
  if (R < 4096) return R;
  if (R < 6400) {
    int n = R - 4096;
    if (n >= 2080) return -1;
    if (n < 512) scale = 0.08838834764831845f;
    return 5120 + n;
  }
  int n = R - 6400;
  int tt = n >> 8, wv = n & 255;
  int wn = wv >> 7, nl = wv & 127;
  int qd = nl >> 5, ni = (nl >> 2) & 7, r = nl & 3;
  int grp = ni >> 2, seg = ni & 3;
  int ucol = tt * 64 + wn * 32 + qd * 8 + grp * 4 + r;
  int base = seg == 0 ? 4096 : seg == 1 ? 8224 : seg == 2 ? 7200 : 9248;
  return base + ucol;
}

__device__ __forceinline__ void phase_init(const Params& p, char* smem) {
  const int t = opaque_tid(smem);
  const int bid_ = opaque_bid();
  for (int idx = bid_ * 256 + t; idx < 2 * 128 * 256; idx += gridDim.x * 256) {
    int g = idx / (128 * 256), r = (idx / 256) % 128, c4 = idx % 256;
    int nvalid = g == 0 ? 16 : 64;
    fl4 v = MKF4(0.f, 0.f, 0.f, 0.f);
    if (r < nvalid) v = *(const fl4*)(p.meta + (size_t)(r & 15) * 1024 + c4 * 4);
    *(fl4*)(p.hmeta + ((size_t)g * 128 + r) * 1024 + c4 * 4) = v;
  }
  float* tile = (float*)smem;
  const int per_layer = 3904 + 1024;
  for (int id = bid_; id < 2 * per_layer; id += gridDim.x) {
    int l = id / per_layer, r = id % per_layer;
    const float* src; int ld; const float* gain = nullptr; int K, n0, k0;
    bf16_t* dst;
    int kind;
    int cbase = 0;
    if (r < 3904) {
      int rt = r >> 4, kt = r & 15;
      n0 = rt * 64; k0 = kt * 64; K = 1024;
      dst = p.W + (size_t)l * LSTRIDE;
      if (n0 < 10496) { kind = 0; src = p.w_in + (size_t)l * 1024 * 10272; ld = 10272; gain = p.attn_norm + l * 1024; }
      else if (n0 < 11520) { kind = 1; src = p.w_out + (size_t)l * 1024 * 1024; ld = 1024; cbase = n0 - 10496; }
      else { kind = 1; src = p.w_up + (size_t)l * 1024 * 4096; ld = 4096; cbase = n0 - 11520; gain = p.mlp_norm + l * 1024; }
    } else {
      int r2 = r - 3904;
      int rt = r2 >> 6, kt = r2 & 63;
      n0 = rt * 64; k0 = kt * 64; K = 4096;
      dst = p.W + (size_t)l * LSTRIDE + WOFF_D;
      kind = 1; src = p.w_down + (size_t)l * 4096 * 1024; ld = 1024; cbase = n0;
    }
    {
      int n = t & 63;
      float scale = 1.f; int col;
      if (kind == 0) col = w_in_col(n0 + n, scale); else col = cbase + n;
#pragma unroll 4
      for (int i = 0; i < 16; ++i) {
        int kk = (t >> 6) + 4 * i;
        float v = 0.f;
        if (col >= 0) {
          v = src[(size_t)(k0 + kk) * ld + col] * scale;
          if (gain) v *= gain[k0 + kk];
        }
        tile[kk * 65 + n] = v;
      }
    }
    __syncthreads();
    {
      int n = t >> 2, piece = t & 3;
      uint32_t pk[8];
#pragma unroll
      for (int e = 0; e < 8; ++e) {
        float a = tile[(piece * 16 + 2 * e) * 65 + n];
        float b = tile[(piece * 16 + 2 * e + 1) * 65 + n];
        pk[e] = pack2(a, b);
      }
      const int Rr = n0 + n, kk = k0 + piece * 16;
      u32x4* d = (u32x4*)(dst + ((size_t)((Rr >> 8) * (K >> 5) + (kk >> 5)) * 256 + (Rr & 255)) * 32 + (kk & 31));
      d[0] = MK4(pk[0], pk[1], pk[2], pk[3]);
      d[1] = MK4(pk[4], pk[5], pk[6], pk[7]);
    }
    __syncthreads();
  }
}

template <int NT>
__device__ __forceinline__ void tile_to_mn(int tile, int& mt, int& nt) {
  if ((NT == 16 || NT == 4) && tile < 128 * NT) {
    const int round = tile >> 9, s_ = tile & 511;
    const int xcd = s_ & 7, j = s_ >> 3;
    mt = round * (512 / NT) + (j / NT) * 8 + xcd;
    nt = j % NT;
  } else if (NT == 9 && tile < 1024) {
    const int s_ = tile & 511;
    const int tl = (tile & ~511) + (s_ & 7) * 64 + (s_ >> 3);
    mt = tl / NT; nt = tl % NT;
  } else { mt = tile / NT; nt = tile % NT; }
}

enum { EPI_G1A = 0, EPI_G1B, EPI_GATES, EPI_WOUT, EPI_UP, EPI_DOWN };

template <int EPI>
__device__ __forceinline__ void gemm_phase(const Params& p, int l, int g, char* smem) {
  constexpr bool NORM = (EPI == EPI_G1A || EPI == EPI_G1B || EPI == EPI_GATES || EPI == EPI_UP);
  constexpr int K = (EPI == EPI_DOWN) ? 4096 : 1024;
  constexpr int NT = EPI == EPI_G1A ? 16 : EPI == EPI_G1B ? 9 : EPI == EPI_GATES ? 16 : EPI == EPI_WOUT ? 4 : EPI == EPI_UP ? 16 : 4;
  constexpr int WOFF = EPI == EPI_G1A ? WOFF_A : EPI == EPI_G1B ? WOFF_B : EPI == EPI_GATES ? WOFF_G : EPI == EPI_WOUT ? WOFF_O : EPI == EPI_UP ? WOFF_U : WOFF_D;
  constexpr int NK = K / 32;
  const bf16_t* Wl = p.W + (size_t)l * LSTRIDE + WOFF;
  bf16_t* As = (bf16_t*)smem;
  bf16_t* Bs = As + 3 * 128 * 32;
  const int bid_ = opaque_bid();
  const int t = opaque_tid(smem), lane = t & 63, w = t >> 6, wm = w >> 1, wn = w & 1;
  const int quad = lane >> 4, l15 = lane & 15;
  const int nvalid_meta = g == 0 ? 16 : 64;

  if (EPI == EPI_G1A) for (int i = bid_ * 256 + t; i < MROWS; i += gridDim.x * 256) p.RSB[i] = 0.f;
  if (EPI == EPI_UP) for (int i = bid_ * 256 + t; i < MROWS; i += gridDim.x * 256) p.RSA[i] = 0.f;
  bool pre = false;
  for (int tile = bid_; tile < MTILES * NT; tile += gridDim.x) {
    int mt, nt; tile_to_mn<NT>(tile, mt, nt);
    const bf16_t* Ab = NORM ? p.HB + (size_t)mt * 128 * 1024 : p.X + (size_t)mt * 128 * K;
    const bf16_t* Bg = Wl + (size_t)nt * 256 * K;
    const bool do_mma = !(mt == 128 && wm == 1) && !(EPI == EPI_G1B && nt == 8 && wn == 1);

    f32x4 acc[4][8];
#pragma unroll
    for (int a = 0; a < 4; ++a)
#pragma unroll
      for (int b = 0; b < 8; ++b) acc[a][b] = (f32x4){0.f, 0.f, 0.f, 0.f};
    int t_l = t;
    asm volatile("" : "+v"(t_l));
    const uint32_t voffA = (uint32_t)((t_l >> 2) * 64 + (((t_l & 3) ^ (((t_l >> 5) & 1) << 1)) * 16));
    const uint32_t voffB0 = (uint32_t)((t_l >> 2) * 64 + ((t_l & 3) * 16));
    const uint32_t voffB1 = (uint32_t)((t_l >> 2) * 64 + (((t_l & 3) ^ 2) * 16));
    const char* Abase = (const char*)Ab;
    const char* Bbase = (const char*)Bg;
    const int rpiece = quad ^ (((l15 >> 3) & 1) << 1);
    const int w_s = __builtin_amdgcn_readfirstlane(t_l >> 6);
#define GLDS(gp, lp) __builtin_amdgcn_global_load_lds((const __attribute__((address_space(1))) void*)(gp), (__attribute__((address_space(3))) void*)(lp), 16, 0, 0)
#define G_DMA(KT, BUF) G_DMA2(Abase, Bbase, KT, BUF)
#define G_DMA2(AB_, BB_, KT, BUF) do { \
      const char* ua = (AB_) + (size_t)(KT) * 8192; const char* ub = (BB_) + (size_t)(KT) * 16384; \
      asm volatile("" : "+s"(ua), "+s"(ub));     \
      char* la = (char*)(As + (BUF) * 4096) + w_s * 1024; char* lb = (char*)(Bs + (BUF) * 8192) + w_s * 1024;     \
      _Pragma("unroll") for (int i = 0; i < 2; ++i) GLDS(ua + i * 4096 + voffA, la + i * 4096); \
      _Pragma("unroll") for (int i = 0; i < 4; ++i) GLDS(ub + i * 4096 + ((i & 1) ? voffB1 : voffB0), lb + i * 4096); } while (0)
#define G_FRAGS(BUF) \
      const bf16_t* Aw = As + (BUF) * 4096; const bf16_t* Bw = Bs + (BUF) * 8192; \
      bf16x8 af[4], bfr[8]; \
      _Pragma("unroll") for (int mi = 0; mi < 4; ++mi) af[mi] = *(const bf16x8*)(Aw + (wm * 64 + mi * 16 + l15) * 32 + rpiece * 8); \
      _Pragma("unroll") for (int ni = 0; ni < 8; ++ni) bfr[ni] = *(const bf16x8*)(Bw + (wn * 128 + (l15 >> 2) * 32 + ni * 4 + (l15 & 3)) * 32 + rpiece * 8);
#define G_MMA() \
      if (do_mma) { \
        __builtin_amdgcn_s_setprio(1); \
        _Pragma("unroll") for (int ni = 0; ni < 8; ++ni) \
          _Pragma("unroll") for (int mi = 0; mi < 4; ++mi) \
            acc[mi][ni] = __builtin_amdgcn_mfma_f32_16x16x32_bf16(bfr[ni], af[mi], acc[mi][ni], 0, 0, 0); \
        __builtin_amdgcn_s_setprio(0); }

    if (!pre) { G_DMA(0, 0); G_DMA(1, 1); }
    asm volatile("s_waitcnt vmcnt(0)" ::: "memory");
#define G_STEP3(CUR, NXT, KN) do { \
      asm volatile("s_waitcnt vmcnt(6)\n\ts_waitcnt lgkmcnt(0)" ::: "memory"); \
      __builtin_amdgcn_s_barrier(); \
      asm volatile("" ::: "memory"); \
      G_FRAGS(CUR) \
      G_DMA(KN, NXT);     \
      G_MMA(); } while (0)
#pragma unroll 1
    for (int kt = 0; kt < NK - 2; kt += 3) {
      G_STEP3(0, 2, kt + 2);
      G_STEP3(1, 0, kt + 3);
      G_STEP3(2, 1, kt + 4);
    }
    G_STEP3(0, 2, NK - 1);
    G_STEP3(1, 0, NK - 1);
#undef G_STEP3
    asm volatile("s_waitcnt vmcnt(0)" ::: "memory");
    __syncthreads();
    {
      const int tile2 = tile + (int)gridDim.x;
      pre = tile2 < MTILES * NT;
      if (pre) {
        int mt2, nt2; tile_to_mn<NT>(tile2, mt2, nt2);
        const char* Ab2 = (const char*)(NORM ? p.HB + (size_t)mt2 * 128 * 1024 : p.X + (size_t)mt2 * 128 * K);
        const char* Bg2 = (const char*)(Wl + (size_t)nt2 * 256 * K);
        G_DMA2(Ab2, Bg2, 0, 0);
        G_DMA2(Ab2, Bg2, 1, 1);
      }
    }
#undef GLDS
#undef G_DMA
#undef G_DMA2
#undef G_FRAGS
#undef G_MMA

    int quad_e = quad, l15_e = l15, t_e = t;
    asm volatile("" : "+v"(quad_e), "+v"(l15_e), "+v"(t_e));
    if (do_mma) {
#pragma unroll
    for (int mi = 0; mi < 4; ++mi) {
      __builtin_amdgcn_sched_barrier(0);
      const int rl = wm * 64 + mi * 16 + l15_e;
      const size_t grow = (size_t)mt * 128 + rl;
      const float rs = NORM ? rsqrtf((EPI == EPI_UP ? p.RSB : p.RSA)[grow] * (1.f / 1024.f) + 1e-6f) : 1.f;
      const int cw = wn * 128 + quad_e * 32;
      if (EPI == EPI_G1A) {
        const int region = nt >> 2;
        bf16_t* xp = p.X + grow * 4096 + nt * 256 + cw;
#pragma unroll
        for (int c = 0; c < 4; ++c) {
          float v[8];
#pragma unroll
          for (int e = 0; e < 8; ++e) v[e] = acc[mi][2 * c + (e >> 2)][e & 3] * rs;
          if (region == 1 || region == 2) {
            float lb[8] = {0.f, 0.f, 0.f, 0.f, 0.f, 0.f, 0.f, 0.f};
            if (l == 1) {
              const float* l0p = p.lb_logits + (region - 1) * 1024 + ((nt * 256 + cw + c * 8) & 1023);
              const fl4 a0 = *(const fl4*)l0p, a1 = *(const fl4*)(l0p + 4);
              const fl4 b0 = *(const fl4*)(l0p + 2048), b1 = *(const fl4*)(l0p + 2052);
              lb[0] = sigmoidf_(b0.x - a0.x); lb[1] = sigmoidf_(b0.y - a0.y);
              lb[2] = sigmoidf_(b0.z - a0.z); lb[3] = sigmoidf_(b0.w - a0.w);
              lb[4] = sigmoidf_(b1.x - a1.x); lb[5] = sigmoidf_(b1.y - a1.y);
              lb[6] = sigmoidf_(b1.z - a1.z); lb[7] = sigmoidf_(b1.w - a1.w);
            }
#pragma unroll
            for (int e = 0; e < 8; ++e) {
              const float f = fmaxf(lb[e], 1e-30f) + (1.f - lb[e]) * sigmoidf_(v[e]);
              v[e] = __builtin_amdgcn_logf(f);
            }
          }
          *(u32x4*)(xp + c * 8) = MK4(pack2(v[0], v[1]), pack2(v[2], v[3]), pack2(v[4], v[5]), pack2(v[6], v[7]));
        }
      } else if (EPI == EPI_G1B) {
        if (nt < 8) {
          bf16_t* xp = p.X + grow * 2048 + nt * 256 + cw;
#pragma unroll
          for (int c = 0; c < 4; ++c)
            *(u32x4*)(xp + c * 8) = MK4(pack2(acc[mi][2 * c][0] * rs, acc[mi][2 * c][1] * rs), pack2(acc[mi][2 * c][2] * rs, acc[mi][2 * c][3] * rs),
                                        pack2(acc[mi][2 * c + 1][0] * rs, acc[mi][2 * c + 1][1] * rs), pack2(acc[mi][2 * c + 1][2] * rs, acc[mi][2 * c + 1][3] * rs));
        } else if (cw == 0) {
          bf16_t* rp = p.R + grow * 32;
#pragma unroll
          for (int c = 0; c < 4; ++c)
            *(u32x4*)(rp + c * 8) = MK4(pack2(acc[mi][2 * c][0] * rs, acc[mi][2 * c][1] * rs), pack2(acc[mi][2 * c][2] * rs, acc[mi][2 * c][3] * rs),
                                        pack2(acc[mi][2 * c + 1][0] * rs, acc[mi][2 * c + 1][1] * rs), pack2(acc[mi][2 * c + 1][2] * rs, acc[mi][2 * c + 1][3] * rs));
        }
      } else if (EPI == EPI_GATES) {
        const int uc = nt * 64 + wn * 32 + quad_e * 8;
        const u32x4 oa = *(const u32x4*)(p.O + grow * 2048 + uc);
        const u32x4 ob = *(const u32x4*)(p.O + grow * 2048 + 1024 + uc);
        const uint32_t oau[4] = {oa.x, oa.y, oa.z, oa.w}, obu[4] = {ob.x, ob.y, ob.z, ob.w};
        float u[8];
#pragma unroll
        for (int grp = 0; grp < 2; ++grp)
#pragma unroll
          for (int r = 0; r < 4; ++r) {
            const int idx = grp * 4 + r;
            const float ga = acc[mi][grp * 4 + 0][r] * rs, ma = acc[mi][grp * 4 + 1][r] * rs;
            const float gb = acc[mi][grp * 4 + 2][r] * rs, mb = acc[mi][grp * 4 + 3][r] * rs;
            const float ona = (idx & 1) ? __uint_as_float(oau[idx >> 1] & 0xffff0000u) : __uint_as_float(oau[idx >> 1] << 16);
            const float onb = (idx & 1) ? __uint_as_float(obu[idx >> 1] & 0xffff0000u) : __uint_as_float(obu[idx >> 1] << 16);
            u[idx] = sigmoidf_(ma) * (ga * sigmoidf_(ga)) * ona + sigmoidf_(mb) * (gb * sigmoidf_(gb)) * onb;
          }
        *(u32x4*)(p.X + tiled_off(grow, uc, 1024)) = MK4(pack2(u[0], u[1]), pack2(u[2], u[3]), pack2(u[4], u[5]), pack2(u[6], u[7]));
      } else if (EPI == EPI_WOUT || EPI == EPI_DOWN) {
        const bool meta = (mt == 128);
        float hsq = 0.f;
        if (!meta || rl < nvalid_meta) {
          const float* hin; float* hout;
          if (meta) { hout = p.hmeta + ((size_t)g * 128 + rl) * 1024; hin = hout; }
          else {
            const size_t trow = (size_t)mt * 128 + rl;
            hout = p.out + ((size_t)g * NTOKG + trow) * 1024;
            hin = (EPI == EPI_WOUT && l == 0) ? p.x[g] + trow * 1024 : hout;
          }
          const int col0 = nt * 256 + cw;
          bf16_t* hb = p.HB + tiled_off(grow, col0, 1024);
#pragma unroll
          for (int c = 0; c < 4; ++c) {
            const fl4 h0 = *(const fl4*)(hin + col0 + c * 8), h1 = *(const fl4*)(hin + col0 + c * 8 + 4);
            const fl4 o0 = MKF4(h0.x + acc[mi][2 * c][0], h0.y + acc[mi][2 * c][1], h0.z + acc[mi][2 * c][2], h0.w + acc[mi][2 * c][3]);
            const fl4 o1 = MKF4(h1.x + acc[mi][2 * c + 1][0], h1.y + acc[mi][2 * c + 1][1], h1.z + acc[mi][2 * c + 1][2], h1.w + acc[mi][2 * c + 1][3]);
            *(fl4*)(hout + col0 + c * 8) = o0;
            *(fl4*)(hout + col0 + c * 8 + 4) = o1;
            *(u32x4*)(hb + c * 8) = MK4(pack2(o0.x, o0.y), pack2(o0.z, o0.w), pack2(o1.x, o1.y), pack2(o1.z, o1.w));
            hsq += o0.x * o0.x + o0.y * o0.y + o0.z * o0.z + o0.w * o0.w + o1.x * o1.x + o1.y * o1.y + o1.z * o1.z + o1.w * o1.w;
          }
        }
        hsq += shx<16>(hsq, lane); hsq += shx<32>(hsq, lane);
        if (quad_e == 0 && (!meta || rl < nvalid_meta)) atomicAdd((EPI == EPI_WOUT ? p.RSB : p.RSA) + grow, hsq);
      } else if (EPI == EPI_UP) {
        bf16_t* xp = p.X + tiled_off(grow, nt * 256 + cw, 4096);
#pragma unroll
        for (int c = 0; c < 4; ++c) {
          float v[8];
#pragma unroll
          for (int e = 0; e < 8; ++e) { const float a = fmaxf(acc[mi][2 * c + (e >> 2)][e & 3] * rs, 0.f); v[e] = a * a; }
          *(u32x4*)(xp + c * 8) = MK4(pack2(v[0], v[1]), pack2(v[2], v[3]), pack2(v[4], v[5]), pack2(v[6], v[7]));
        }
      }
    }
    }
  }
}

template <int MIX, int PASS>
__device__ __forceinline__ void scan_phase(const Params& p, int l, int g, char* smem) {
  constexpr int NH = MIX ? 4 : 8;
  constexpr int NDV = MIX ? 4 : 2;
  constexpr int XLD = MIX ? 2048 : 4096;
  bf16_t* QS = (bf16_t*)smem;
  bf16_t* KS = QS + 64 * 136;
  bf16_t* KT = KS + 64 * 136;
  bf16_t* LG = KT;
  bf16_t* Pm = QS;
  bf16_t* SmT = KS;
  bf16_t* VT = KT + 128 * 72;
  bf16_t* RS = VT + 64 * 72;
  float* em = (float*)(RS + 64 * 24);
  float* el = em + 128;
  float* tot = el + 128;
  const int bid_ = opaque_bid();
  const int t_outer = opaque_tid(smem);
  const int sps = g == 0 ? 16 : 4;
  constexpr bool do_out = (PASS == 3);
  const bf16_t* Xg = p.X;

  for (int item = bid_; item < 512; item += gridDim.x) {
    int t = t_outer;
    asm volatile("" : "+v"(t));
    const int lane = t & 63, w = t >> 6, quad = lane >> 4, l15 = lane & 15;
    const int dir = item & 1;
    const int dvb = (item >> 1) % NDV;
    const int head = ((item >> 1) / NDV) % NH;
    const int seg = item >> 5;
    const int seq = seg / sps;
    const bool first = (seg % sps) == 0;
    const int nsteps = 16 + (first ? 1 : 0);
    int qcol, kcol, vcol;
    bf16_t* Og; int OLD;
    if (MIX == 0) {
      qcol = head * 128; kcol = 1024 + dir * 1024 + head * 128; vcol = 3072 + head * 128 + dvb * 64;
      Og = p.O + dir * 1024 + head * 128 + dvb * 64; OLD = 2048;
    } else {
      qcol = head * 128; kcol = 512 + head * 128; vcol = 1024 + head * 256 + dvb * 64;
      Og = p.X + (size_t)MROWS * 2048 + (size_t)dir * MROWS * 1024 + head * 256 + dvb * 64; OLD = 1024;
    }
    bf16x8 wgf[2]; float bgv[2][4];
    if (MIX == 1) {
#pragma unroll
      for (int ct = 0; ct < 2; ++ct) {
        const int cc = 16 * (2 * w + ct) + l15;
        bf16x8 v = (bf16x8){0, 0, 0, 0, 0, 0, 0, 0};
        if (quad < 2) {
#pragma unroll
          for (int e = 0; e < 8; ++e)
            v[e] = (short)f2bf(p.w_gate[((size_t)(l * 2 + dir) * 16 + quad * 8 + e) * 512 + head * 128 + cc]);
        }
        wgf[ct] = v;
#pragma unroll
        for (int r = 0; r < 4; ++r) bgv[ct][r] = p.b_gate[(l * 2 + dir) * 512 + head * 128 + 16 * (2 * w + ct) + quad * 4 + r];
      }
    }
    f32x4 S[8];
#pragma unroll
    for (int a = 0; a < 8; ++a) S[a] = (f32x4){0.f, 0.f, 0.f, 0.f};
    if (do_out) {
      int s2 = dir == 0 ? seq * sps : seq * sps + sps - 1;
      const int stp = dir == 0 ? 1 : -1;
      for (; s2 != seg; s2 += stp) {
        const int item2 = ((s2 * NH + head) * NDV + dvb) * 2 + dir;
        const bf16_t* L = p.ST + (size_t)item2 * 8192;
        const float* G = p.GD + ((s2 * 8 + head) * 2 + dir) * 128;
#pragma unroll
        for (int a = 0; a < 8; ++a)
#pragma unroll
          for (int r = 0; r < 4; ++r) {
            const int k = 16 * (2 * w + (a >> 2)) + quad * 4 + r;
            S[a][r] = __builtin_amdgcn_exp2f(G[k]) * S[a][r] + bf2f(L[(a * 4 + r) * 256 + t]);
          }
      }
    }
    float gacc0 = 0.f, gacc1 = 0.f;

    u32x4 qr[4], kr[4], vr[2], rr;
    auto step_rows = [&](int s, int& rowbase, int& nv) {
      bool meta;
      if (dir == 0) { meta = first && s == 0; rowbase = (seg * 16 + s - (first ? 1 : 0)) * 64; }
      else { meta = (s == 16); rowbase = (seg * 16 + 15 - s) * 64; }
      if (meta) { rowbase = NTOKG + seq * 16; nv = 16; } else nv = 64;
    };
    const char* Xq = (const char*)(Xg + qcol);
    const char* Xk = (const char*)(Xg + kcol);
    const char* Xv = (const char*)(Xg + vcol);
    const char* Rb = (const char*)(p.R + dir * 16);
    auto gload = [&](int s) {
      int rowbase, nv; step_rows(s, rowbase, nv);
#pragma unroll
      for (int j = 0; j < 4; ++j) {
        const int i = (t >> 4) + 16 * j;
        const int mr = dir ? rowbase + nv - 1 - i : rowbase + i;
        u32x4 z = MK4(0, 0, 0, 0);
        if (i < nv) {
          const uint32_t vo = (uint32_t)(mr * XLD + (t & 15) * 8) * 2u;
          qr[j] = do_out ? *(const u32x4*)(Xq + vo) : z;
          kr[j] = *(const u32x4*)(Xk + vo);
        } else { qr[j] = z; kr[j] = z; }
      }
      {
        const int i = t >> 2;
        const int mr = dir ? rowbase + nv - 1 - i : rowbase + i;
        vr[0] = MK4(0, 0, 0, 0); vr[1] = vr[0];
        if (i < nv) {
          const uint32_t vo = (uint32_t)(mr * XLD + (t & 3) * 16) * 2u;
          vr[0] = *(const u32x4*)(Xv + vo); vr[1] = *(const u32x4*)(Xv + vo + 16);
        }
      }
      if (MIX == 1) {
        rr = MK4(0, 0, 0, 0);
        if (t < 128) {
          const int i = t >> 1;
          const int mr = dir ? rowbase + nv - 1 - i : rowbase + i;
          if (i < nv) rr = *(const u32x4*)(Rb + (uint32_t)(mr * 32 + (t & 1) * 8) * 2u);
        }
      }
    };
    gload(0);

    for (int s = 0; s < nsteps; ++s) {
      int rowbase, nv; step_rows(s, rowbase, nv);
#pragma unroll
      for (int j = 0; j < 4; ++j) {
        const int i = (t >> 4) + 16 * j;
        if (do_out) *(u32x4*)(QS + i * 136 + (t & 15) * 8) = qr[j];
        *(u32x4*)(KS + i * 136 + (t & 15) * 8) = kr[j];
      }
      {
        const int i = t >> 2, piece = t & 3;
        uint32_t vv[8] = {vr[0].x, vr[0].y, vr[0].z, vr[0].w, vr[1].x, vr[1].y, vr[1].z, vr[1].w};
        bf16_t* vtw = VT + piece * 16 * 72 + i;
#pragma unroll
        for (int e = 0; e < 16; ++e) vtw[e * 72] = (bf16_t)((vv[e >> 1] >> ((e & 1) * 16)) & 0xffffu);
      }
      if (MIX == 1 && t < 128) *(u32x4*)(RS + (t >> 1) * 24 + (t & 1) * 8) = rr;
      if (s + 1 < nsteps) gload(s + 1);
      __syncthreads();
      if (MIX == 1) {
        bf16x8 af[4];
#pragma unroll
        for (int it = 0; it < 4; ++it) {
          af[it] = (bf16x8){0, 0, 0, 0, 0, 0, 0, 0};
          if (quad < 2) af[it] = *(const bf16x8*)(RS + (16 * it + l15) * 24 + quad * 8);
        }
#pragma unroll
        for (int ct = 0; ct < 2; ++ct)
#pragma unroll
          for (int it = 0; it < 4; ++it) {
            f32x4 z = __builtin_amdgcn_mfma_f32_16x16x32_bf16(wgf[ct], af[it], (f32x4){0.f, 0.f, 0.f, 0.f}, 0, 0, 0);
            float ls[4];
#pragma unroll
            for (int r = 0; r < 4; ++r) {
              const float zz = fmaxf(z[r] + bgv[ct][r], -80.f);
              ls[r] = __builtin_amdgcn_logf(1.f + __builtin_amdgcn_exp2f(zz * -1.4426950408889634f)) * -0.0625f;
            }
            *(u32x2*)(LG + (16 * it + l15) * 128 + 16 * (2 * w + ct) + quad * 4) = MK2(pack2(ls[0], ls[1]), pack2(ls[2], ls[3]));
          }
        __syncthreads();
      }
      const int cp = t & 63, rg = t >> 6;
      const int nvl = nv - 16 * rg;
      float p0[16], p1[16];
      {
        float run0 = 0.f, run1 = 0.f;
        constexpr int LFS32 = (MIX == 0) ? 68 : 64;
        const uint32_t* lfp = (const uint32_t*)((MIX == 0) ? (KS + 16 * rg * 136) : (LG + 16 * rg * 128)) + cp;
#pragma unroll
        for (int ii = 0; ii < 16; ++ii) {
          if ((ii & 7) == 0) __builtin_amdgcn_sched_barrier(0);
          const uint32_t u = lfp[ii * LFS32];
          float l0 = __uint_as_float(u << 16), l1 = __uint_as_float(u & 0xffff0000u);
          if (ii >= nvl) { l0 = 0.f; l1 = 0.f; }
          run0 += l0; run1 += l1;
          p0[ii] = run0; p1[ii] = run1;
        }
        *(float2*)(tot + rg * 128 + 2 * cp) = make_float2(run0, run1);
      }
      __syncthreads();
      {
        const float2 ta = *(const float2*)(tot + 2 * cp), tb = *(const float2*)(tot + 128 + 2 * cp);
        const float2 tc = *(const float2*)(tot + 256 + 2 * cp), td = *(const float2*)(tot + 384 + 2 * cp);
        const float m0 = ta.x + tb.x, m1 = ta.y + tb.y;
        const float base0 = (rg > 0 ? ta.x : 0.f) + (rg > 1 ? tb.x : 0.f) + (rg > 2 ? tc.x : 0.f);
        const float base1 = (rg > 0 ? ta.y : 0.f) + (rg > 1 ? tb.y : 0.f) + (rg > 2 ? tc.y : 0.f);
        uint32_t* qp = (uint32_t*)(QS + 16 * rg * 136) + cp;
        uint32_t* kp = (uint32_t*)(KS + 16 * rg * 136) + cp;
        float skp0 = __builtin_amdgcn_exp2f(-fminf(fmaxf(base0 - m0, -115.f), 115.f));
        float skp1 = __builtin_amdgcn_exp2f(-fminf(fmaxf(base1 - m1, -115.f), 115.f));
        uint32_t kt0[8], kt1[8], kkprev = 0;
#pragma unroll
        for (int ii = 0; ii < 16; ++ii) {
          if ((ii & 3) == 0) __builtin_amdgcn_sched_barrier(0);
          const float e0 = fminf(fmaxf(base0 + p0[ii] - m0, -115.f), 115.f);
          const float e1 = fminf(fmaxf(base1 + p1[ii] - m1, -115.f), 115.f);
          const float sq0 = __builtin_amdgcn_exp2f(e0), sq1 = __builtin_amdgcn_exp2f(e1);
          const float sk0 = __builtin_amdgcn_rcpf(sq0), sk1 = __builtin_amdgcn_rcpf(sq1);
          if (do_out) {
            const uint32_t uq = qp[ii * 68];
            qp[ii * 68] = pack2(__uint_as_float(uq << 16) * sq0, __uint_as_float(uq & 0xffff0000u) * sq1);
          }
          float k0, k1;
          if (MIX == 0) { k0 = 1.f - sq0 * skp0; k1 = 1.f - sq1 * skp1; skp0 = sk0; skp1 = sk1; }
          else { const uint32_t uk = kp[ii * 68]; k0 = __uint_as_float(uk << 16); k1 = __uint_as_float(uk & 0xffff0000u); }
          const uint32_t kk = pack2(k0 * sk0, k1 * sk1);
          if (do_out) kp[ii * 68] = kk;
          if (ii & 1) {
            kt0[ii >> 1] = __builtin_amdgcn_perm(kk, kkprev, 0x05040100u);
            kt1[ii >> 1] = __builtin_amdgcn_perm(kk, kkprev, 0x07060302u);
          } else kkprev = kk;
        }
        u32x4* kd0 = (u32x4*)(KT + (2 * cp) * 72 + 16 * rg);
        u32x4* kd1 = (u32x4*)(KT + (2 * cp + 1) * 72 + 16 * rg);
        kd0[0] = MK4(kt0[0], kt0[1], kt0[2], kt0[3]); kd0[1] = MK4(kt0[4], kt0[5], kt0[6], kt0[7]);
        kd1[0] = MK4(kt1[0], kt1[1], kt1[2], kt1[3]); kd1[1] = MK4(kt1[4], kt1[5], kt1[6], kt1[7]);
        if (rg == 0) {
          *(float2*)(em + 2 * cp) = make_float2(__builtin_amdgcn_exp2f(m0), __builtin_amdgcn_exp2f(m1));
          *(float2*)(el + 2 * cp) = make_float2(__builtin_amdgcn_exp2f(tc.x + td.x), __builtin_amdgcn_exp2f(tc.y + td.y));
        }
        gacc0 += m0 + tc.x + td.x; gacc1 += m1 + tc.y + td.y;
      }
      __syncthreads();
      if (do_out) {
        bf16x8 qf[4];
#pragma unroll
        for (int ks = 0; ks < 4; ++ks) qf[ks] = *(const bf16x8*)(QS + (16 * w + l15) * 136 + ks * 32 + quad * 8);
        f32x4 pa[4];
#pragma unroll
        for (int jt = 0; jt < 4; ++jt) {
          pa[jt] = (f32x4){0.f, 0.f, 0.f, 0.f};
          if (jt <= w) {
#pragma unroll
            for (int ks = 0; ks < 4; ++ks) {
              bf16x8 kf = *(const bf16x8*)(KS + (16 * jt + l15) * 136 + ks * 32 + quad * 8);
              pa[jt] = __builtin_amdgcn_mfma_f32_16x16x32_bf16(kf, qf[ks], pa[jt], 0, 0, 0);
            }
          }
        }
        __syncthreads();
        {
          const int i = 16 * w + l15;
          bf16_t* pw = Pm + i * 72 + quad * 4;
#pragma unroll
          for (int jt = 0; jt < 4; ++jt) {
            const int j0 = 16 * jt + quad * 4;
            float pv[4];
#pragma unroll
            for (int r = 0; r < 4; ++r) pv[r] = (jt <= w && j0 + r <= i) ? pa[jt][r] : 0.f;
            *(u32x2*)(pw + 16 * jt) = MK2(pack2(pv[0], pv[1]), pack2(pv[2], pv[3]));
          }
        }
#pragma unroll
        for (int a = 0; a < 8; ++a) {
          const int k0 = 16 * (2 * w + (a >> 2)) + quad * 4;
          const int v = 16 * (a & 3) + l15;
          const fl4 e = *(const fl4*)(em + k0);
          S[a][0] *= e.x; S[a][1] *= e.y; S[a][2] *= e.z; S[a][3] *= e.w;
          *(u32x2*)(SmT + v * 136 + k0) = MK2(pack2(S[a][0], S[a][1]), pack2(S[a][2], S[a][3]));
        }
        __syncthreads();
        f32x4 oa[4];
#pragma unroll
        for (int vt = 0; vt < 4; ++vt) {
          oa[vt] = (f32x4){0.f, 0.f, 0.f, 0.f};
#pragma unroll
          for (int ks = 0; ks < 4; ++ks) {
            bf16x8 sf = *(const bf16x8*)(SmT + (16 * vt + l15) * 136 + ks * 32 + quad * 8);
            oa[vt] = __builtin_amdgcn_mfma_f32_16x16x32_bf16(sf, qf[ks], oa[vt], 0, 0, 0);
          }
        }
#pragma unroll
        for (int js = 0; js < 2; ++js) {
          bf16x8 pfr = *(const bf16x8*)(Pm + (16 * w + l15) * 72 + js * 32 + quad * 8);
#pragma unroll
          for (int vt = 0; vt < 4; ++vt) {
            bf16x8 vf = *(const bf16x8*)(VT + (16 * vt + l15) * 72 + js * 32 + quad * 8);
            oa[vt] = __builtin_amdgcn_mfma_f32_16x16x32_bf16(vf, pfr, oa[vt], 0, 0, 0);
          }
        }
        {
          const int i = 16 * w + l15;
          if (i < nv) {
            const int mr = dir ? rowbase + nv - 1 - i : rowbase + i;
            bf16_t* op = (bf16_t*)((char*)Og + (uint32_t)(mr * OLD + quad * 4) * 2u);
#pragma unroll
            for (int vt = 0; vt < 4; ++vt) *(u32x2*)(op + 16 * vt) = MK2(pack2(oa[vt][0], oa[vt][1]), pack2(oa[vt][2], oa[vt][3]));
          }
        }
      } else {
#pragma unroll
        for (int a = 0; a < 8; ++a) {
          const int k0 = 16 * (2 * w + (a >> 2)) + quad * 4;
          const fl4 e = *(const fl4*)(em + k0);
          S[a][0] *= e.x; S[a][1] *= e.y; S[a][2] *= e.z; S[a][3] *= e.w;
        }
      }
#pragma unroll
      for (int js = 0; js < 2; ++js) {
        bf16x8 kf[2];
#pragma unroll
        for (int ktl = 0; ktl < 2; ++ktl) kf[ktl] = *(const bf16x8*)(KT + (16 * (2 * w + ktl) + l15) * 72 + js * 32 + quad * 8);
#pragma unroll
        for (int vt = 0; vt < 4; ++vt) {
          bf16x8 vf = *(const bf16x8*)(VT + (16 * vt + l15) * 72 + js * 32 + quad * 8);
#pragma unroll
          for (int ktl = 0; ktl < 2; ++ktl)
            S[ktl * 4 + vt] = __builtin_amdgcn_mfma_f32_16x16x32_bf16(kf[ktl], vf, S[ktl * 4 + vt], 0, 0, 0);
        }
      }
#pragma unroll
      for (int a = 0; a < 8; ++a) {
        const int k0 = 16 * (2 * w + (a >> 2)) + quad * 4;
        const fl4 e = *(const fl4*)(el + k0);
        S[a][0] *= e.x; S[a][1] *= e.y; S[a][2] *= e.z; S[a][3] *= e.w;
      }
      __syncthreads();
    }
    if (!do_out) {
      bf16_t* L = p.ST + (size_t)item * 8192;
#pragma unroll
      for (int a = 0; a < 8; ++a)
#pragma unroll
        for (int r = 0; r < 4; ++r) L[(a * 4 + r) * 256 + t] = f2bf(S[a][r]);
      if (dvb == 0 && t < 64) *(float2*)(p.GD + ((seg * 8 + head) * 2 + dir) * 128 + 2 * t) = make_float2(gacc0, gacc1);
    }
  }
}

__device__ __forceinline__ void phase_hn(const Params& p, int l, char* smem) {
  const int bid_ = opaque_bid();
  const int t = opaque_tid(smem), lane = t & 63, w = t >> 6;
  const bf16_t* Y1 = p.X + (size_t)MROWS * 2048;
  const bf16_t* Y2 = Y1 + (size_t)MROWS * 1024;
  for (int row = bid_ * 4 + w; row < MROWS; row += gridDim.x * 4) {
    bf16_t* oa = p.O + (size_t)row * 2048 + lane * 16;
    float xa[16], xb[16];
    {
      u32x4 a0 = *(const u32x4*)(oa), a1 = *(const u32x4*)(oa + 8);
      u32x4 b0 = *(const u32x4*)(oa + 1024), b1 = *(const u32x4*)(oa + 1032);
      uint32_t ua[8] = {a0.x, a0.y, a0.z, a0.w, a1.x, a1.y, a1.z, a1.w};
      uint32_t ub[8] = {b0.x, b0.y, b0.z, b0.w, b1.x, b1.y, b1.z, b1.w};
#pragma unroll
      for (int e = 0; e < 8; ++e) {
        xa[2 * e] = __uint_as_float(ua[e] << 16) + __uint_as_float(ub[e] << 16);
        xa[2 * e + 1] = __uint_as_float(ua[e] & 0xffff0000u) + __uint_as_float(ub[e] & 0xffff0000u);
      }
      const bf16_t* y1 = Y1 + (size_t)row * 1024 + lane * 16;
      const bf16_t* y2 = Y2 + (size_t)row * 1024 + lane * 16;
      u32x4 c0 = *(const u32x4*)(y1), c1 = *(const u32x4*)(y1 + 8);
      u32x4 d0 = *(const u32x4*)(y2), d1 = *(const u32x4*)(y2 + 8);
      uint32_t uc[8] = {c0.x, c0.y, c0.z, c0.w, c1.x, c1.y, c1.z, c1.w};
      uint32_t ud[8] = {d0.x, d0.y, d0.z, d0.w, d1.x, d1.y, d1.z, d1.w};
#pragma unroll
      for (int e = 0; e < 8; ++e) {
        xb[2 * e] = __uint_as_float(uc[e] << 16) + __uint_as_float(ud[e] << 16);
        xb[2 * e + 1] = __uint_as_float(uc[e] & 0xffff0000u) + __uint_as_float(ud[e] & 0xffff0000u);
      }
    }
    float sa = 0.f, sb = 0.f;
#pragma unroll
    for (int e = 0; e < 16; ++e) { sa += xa[e] * xa[e]; sb += xb[e] * xb[e]; }
    sa += shx<1>(sa, lane); sa += shx<2>(sa, lane); sa += shx<4>(sa, lane);
    sb += shx<1>(sb, lane); sb += shx<2>(sb, lane); sb += shx<4>(sb, lane); sb += shx<8>(sb, lane);
    const float ra = rsqrtf(sa * (1.f / 128.f) + 1e-6f);
    const float rb = rsqrtf(sb * (1.f / 256.f) + 1e-6f);
    const float* na = p.norm_a + l * 1024 + lane * 16;
    const float* nb = p.norm_b + l * 1024 + lane * 16;
    uint32_t pa[8], pb[8];
#pragma unroll
    for (int e = 0; e < 8; ++e) {
      pa[e] = pack2(xa[2 * e] * ra * na[2 * e], xa[2 * e + 1] * ra * na[2 * e + 1]);
      pb[e] = pack2(xb[2 * e] * rb * nb[2 * e], xb[2 * e + 1] * rb * nb[2 * e + 1]);
    }
    *(u32x4*)(oa) = MK4(pa[0], pa[1], pa[2], pa[3]);
    *(u32x4*)(oa + 8) = MK4(pa[4], pa[5], pa[6], pa[7]);
    *(u32x4*)(oa + 1024) = MK4(pb[0], pb[1], pb[2], pb[3]);
    *(u32x4*)(oa + 1032) = MK4(pb[4], pb[5], pb[6], pb[7]);
  }
}

__device__ __forceinline__ void phase_final(const Params& p, char* smem) {
  const int bid_ = opaque_bid();
  const int t = opaque_tid(smem), lane = t & 63, w = t >> 6;
  for (int row = bid_ * 4 + w; row < 2 * NTOKG; row += gridDim.x * 4) {
    float* hp = p.out + (size_t)row * 1024;
    fl4 v[4];
    float s = 0.f;
#pragma unroll
    for (int j = 0; j < 4; ++j) {
      v[j] = *(const fl4*)(hp + j * 256 + lane * 4);
      s += v[j].x * v[j].x + v[j].y * v[j].y + v[j].z * v[j].z + v[j].w * v[j].w;
    }
    s += shx<1>(s, lane); s += shx<2>(s, lane); s += shx<4>(s, lane);
    s += shx<8>(s, lane); s += shx<16>(s, lane); s += shx<32>(s, lane);
    const float rs = rsqrtf(s * (1.f / 1024.f) + 1e-6f);
#pragma unroll
    for (int j = 0; j < 4; ++j) {
      const fl4 gn = *(const fl4*)(p.final_norm + j * 256 + lane * 4);
      fl4 o = MKF4(v[j].x * rs * gn.x, v[j].y * rs * gn.y, v[j].z * rs * gn.z, v[j].w * rs * gn.w);
      *(fl4*)(hp + j * 256 + lane * 4) = o;
    }
  }
}

__device__ __forceinline__ void phase_xcvt(const Params& p, int g, char* smem) {
  const int bid_ = opaque_bid();
  const int t = opaque_tid(smem), lane = t & 63, w = t >> 6;
  for (int row = bid_ * 4 + w; row < MROWS; row += gridDim.x * 4) {
    const float* src = row < NTOKG ? p.x[g] + (size_t)row * 1024 : p.hmeta + ((size_t)g * 128 + (row - NTOKG)) * 1024;
    float ssq = 0.f;
#pragma unroll
    for (int j = 0; j < 2; ++j) {
      const int c8 = j * 64 + lane;
      const fl4 a = *(const fl4*)(src + c8 * 8), b = *(const fl4*)(src + c8 * 8 + 4);
      ssq += a.x * a.x + a.y * a.y + a.z * a.z + a.w * a.w + b.x * b.x + b.y * b.y + b.z * b.z + b.w * b.w;
      *(u32x4*)(p.HB + tiled_off((size_t)row, c8 * 8, 1024)) = MK4(pack2(a.x, a.y), pack2(a.z, a.w), pack2(b.x, b.y), pack2(b.z, b.w));
    }
    ssq += shx<1>(ssq, lane); ssq += shx<2>(ssq, lane); ssq += shx<4>(ssq, lane);
    ssq += shx<8>(ssq, lane); ssq += shx<16>(ssq, lane); ssq += shx<32>(ssq, lane);
    if (lane == 0) p.RSA[row] = ssq;
  }
}

__device__ __forceinline__ void run_phase(const Params& p, int ph, char* smem) {
  if (ph == 0) { phase_init(p, smem); return; }
  if (ph == NPHASES - 1) { phase_final(p, smem); return; }
  const int q = ph - 1;
  const int g = q / 23, r = q % 23;
  if (r == 0) { phase_xcvt(p, g, smem); return; }
  const int l = (r - 1) / 11, st = (r - 1) % 11;
  switch (st) {
    case 0: gemm_phase<EPI_G1A>(p, l, g, smem); break;
    case 1: scan_phase<0, 1>(p, l, g, smem); break;
    case 2: scan_phase<0, 3>(p, l, g, smem); break;
    case 3: gemm_phase<EPI_G1B>(p, l, g, smem); break;
    case 4: scan_phase<1, 1>(p, l, g, smem); break;
    case 5: scan_phase<1, 3>(p, l, g, smem); break;
    case 6: phase_hn(p, l, smem); break;
    case 7: gemm_phase<EPI_GATES>(p, l, g, smem); break;
    case 8: gemm_phase<EPI_WOUT>(p, l, g, smem); break;
    case 9: gemm_phase<EPI_UP>(p, l, g, smem); break;
    default: gemm_phase<EPI_DOWN>(p, l, g, smem); break;
  }
}

template <int ST>
__global__ void __launch_bounds__(256, 2) pk(Params p, int l, int g) {
  extern __shared__ __attribute__((aligned(16))) char smem[];
  if (ST == 100) phase_init(p, smem);
  else if (ST == 101) phase_final(p, smem);
  else if (ST == 102) phase_xcvt(p, g, smem);
  else if (ST == 0) gemm_phase<EPI_G1A>(p, l, g, smem);
  else if (ST == 1) scan_phase<0, 1>(p, l, g, smem);
  else if (ST == 2) scan_phase<0, 3>(p, l, g, smem);
  else if (ST == 3) gemm_phase<EPI_G1B>(p, l, g, smem);
  else if (ST == 4) scan_phase<1, 1>(p, l, g, smem);
  else if (ST == 5) scan_phase<1, 3>(p, l, g, smem);
  else if (ST == 6) phase_hn(p, l, smem);
  else if (ST == 7) gemm_phase<EPI_GATES>(p, l, g, smem);
  else if (ST == 8) gemm_phase<EPI_WOUT>(p, l, g, smem);
  else if (ST == 9) gemm_phase<EPI_UP>(p, l, g, smem);
  else gemm_phase<EPI_DOWN>(p, l, g, smem);
}


#define XB_TMO      128
#define XB_XCNT(j)  (256  + 64 * (j))
#define XB_XSUB(j)  (1280 + 64 * (j))
#define XB_XGEN(j)  (2304 + 64 * (j))
#define XB_TOP      3328
#define XB_TOPGEN   3392
#define XCD_BAR_WORDS 3456
#define XB_SPIN_CAP (1u << 22)
#define LAS __attribute__((address_space(3)))
__device__ __forceinline__ unsigned xb_ld(unsigned* p)              { return __hip_atomic_load(p, __ATOMIC_RELAXED, __HIP_MEMORY_SCOPE_AGENT); }
__device__ __forceinline__ unsigned xb_add(unsigned* p, unsigned v) { return __hip_atomic_fetch_add(p, v, __ATOMIC_RELAXED, __HIP_MEMORY_SCOPE_AGENT); }
__device__ __forceinline__ unsigned xb_xcc_id() { return (unsigned)__builtin_amdgcn_s_getreg((3 << 11) | 20) & 0xFu; }
#define XB_SPIN(cond, bar) do { unsigned _sp = 0; while (cond) { __builtin_amdgcn_s_sleep(1); \
    if ((++_sp & 255u) == 0u) { if (xb_ld(&(bar)[XB_TMO])) break; if (_sp > XB_SPIN_CAP) { atomicAdd(&(bar)[XB_TMO], 1u); break; } } } } while (0)

__device__ __forceinline__ void xcd_barrier_complete(unsigned* bar, unsigned x, unsigned& nloc, unsigned& nx) {
  const unsigned G = gridDim.x * gridDim.y * gridDim.z;
  unsigned sum, cnt, mine, sp = 0u;
  for (;;) {
    sum = 0u; cnt = 0u; mine = 0u;
#pragma unroll
    for (unsigned j = 0; j < 16; ++j) { const unsigned c = xb_ld(&bar[XB_XCNT(j)]); sum += c; cnt += (c > 0u) ? 1u : 0u; mine = (j == x) ? c : mine; }
    if (sum == G) break;
    __builtin_amdgcn_s_sleep(1);
    if ((++sp & 255u) == 0u) { if (xb_ld(&bar[XB_TMO])) break; if (sp > XB_SPIN_CAP) { atomicAdd(&bar[XB_TMO], 1u); break; } }
  }
  nloc = mine > 0u ? mine : 1u; nx = cnt > 0u ? cnt : 1u;
}

__device__ __forceinline__ void xcd_barrier(unsigned* bar, volatile LAS unsigned* st, bool leader_thread) {
  asm volatile("s_waitcnt vmcnt(0)" ::: "memory");
  __syncthreads();
  if (leader_thread) {
    const unsigned x = xb_xcc_id();
    __builtin_amdgcn_s_waitcnt(0);
    unsigned nloc = st[0], nx = st[1];
    if (nloc == 0u) { xcd_barrier_complete(bar, x, nloc, nx); st[0] = nloc; st[1] = nx; }
    const unsigned old = xb_add(&bar[XB_XSUB(x)], 1u);
    const unsigned gen = old / nloc;
    if (old + 1u == (gen + 1u) * nloc) {
      __builtin_amdgcn_fence(__ATOMIC_RELEASE, "agent");
      asm volatile("s_waitcnt vmcnt(0)" ::: "memory");
      const unsigned og = xb_add(&bar[XB_TOP], 1u);
      const unsigned tg = og / nx;
      if (og + 1u == (tg + 1u) * nx) xb_add(&bar[XB_TOPGEN], 1u);
      else XB_SPIN(xb_ld(&bar[XB_TOPGEN]) == tg, bar);
      __builtin_amdgcn_fence(__ATOMIC_ACQUIRE, "agent");
      xb_add(&bar[XB_XGEN(x)], 1u);
      asm volatile("s_waitcnt vmcnt(0)" ::: "memory");
    } else {
      XB_SPIN(xb_ld(&bar[XB_XGEN(x)]) == gen, bar);
      __builtin_amdgcn_fence(__ATOMIC_ACQUIRE, "agent");
      asm volatile("s_waitcnt vmcnt(0)" ::: "memory");
    }
  }
  __syncthreads();
}

#ifndef MULTI_LAUNCH
__global__ void __launch_bounds__(256, 2) mega(Params p, int plo, int phi, int coop) {
  extern __shared__ __attribute__((aligned(16))) char smem[];
  volatile LAS unsigned* st = (volatile LAS unsigned*)(smem + LDS_BYTES + 16);
  {
    const int t0 = opaque_tid(smem);
    if (t0 == 0) { st[0] = 0u; st[1] = 0u; (void)xb_add(&p.bar[XB_XCNT(xb_xcc_id())], 1u); }
    __syncthreads();
  }
  for (int ph = plo; ph < phi; ++ph) {
    run_phase(p, ph, smem);
    if (coop && ph + 1 < phi) {
      if (ph == 0) cg::this_grid().sync();
      else { const int tb = opaque_tid(smem); xcd_barrier(p.bar, st, tb == 0); }
    }
  }
}

#endif

static inline size_t align_up(size_t x) { return (x + 255) & ~(size_t)255; }

extern "C" void kernel_launch(void* const* d_in, const int* in_sizes, int n_in,
                              void* d_out, int out_size, void* d_ws, size_t ws_size,
                              hipStream_t stream) {
  Params p{};
  p.x[0] = (const float*)d_in[0];
  p.x[1] = (const float*)d_in[1];
  p.meta = (const float*)d_in[2];
  p.attn_norm = (const float*)d_in[3];
  p.w_in = (const float*)d_in[4];
  p.lb_logits = (const float*)d_in[5];
  p.w_gate = (const float*)d_in[6];
  p.b_gate = (const float*)d_in[7];
  p.norm_a = (const float*)d_in[8];
  p.norm_b = (const float*)d_in[9];
  p.w_out = (const float*)d_in[10];
  p.mlp_norm = (const float*)d_in[11];
  p.w_up = (const float*)d_in[12];
  p.w_down = (const float*)d_in[13];
  p.final_norm = (const float*)d_in[14];
  p.out = (float*)d_out;
  char* ws = (char*)d_ws;
  size_t off = 0;
  p.W = (bf16_t*)(ws + off); off = align_up(off + (size_t)2 * LSTRIDE * 2);
  p.X = (bf16_t*)(ws + off); off = align_up(off + (size_t)MROWS * 4096 * 2);
  p.R = (bf16_t*)(ws + off); off = align_up(off + (size_t)MROWS * 32 * 2);
  p.O = (bf16_t*)(ws + off); off = align_up(off + (size_t)MROWS * 2048 * 2);
  p.HB = (bf16_t*)(ws + off); off = align_up(off + (size_t)MROWS * 1024 * 2);
  p.RSA = (float*)(ws + off); off = align_up(off + (size_t)MROWS * 4);
  p.RSB = (float*)(ws + off); off = align_up(off + (size_t)MROWS * 4);
  p.ST = (bf16_t*)(ws + off); off = align_up(off + (size_t)512 * 8192 * 2);
  p.GD = (float*)(ws + off); off = align_up(off + (size_t)16 * 8 * 2 * 128 * 4);
  p.hmeta = (float*)(ws + off); off = align_up(off + (size_t)2 * 128 * 1024 * 4);
  p.bar = (unsigned*)(ws + off); off = align_up(off + (size_t)XCD_BAR_WORDS * 4);
  if (off > ws_size) { fprintf(stderr, "workspace too small: need %zu have %zu\n", off, ws_size); return; }

#ifdef MULTI_LAUNCH
#define LAUNCH_PK(ST, l, g) do { \
    static bool attr_set_##ST = false; \
    if (!attr_set_##ST) { (void)hipFuncSetAttribute((const void*)pk<ST>, hipFuncAttributeMaxDynamicSharedMemorySize, LDS_BYTES + 32); attr_set_##ST = true; } \
    hipLaunchKernelGGL(pk<ST>, dim3(512), dim3(256), LDS_BYTES + 32, stream, p, l, g); } while (0)
  LAUNCH_PK(100, 0, 0);
  for (int g = 0; g < 2; ++g)
    for (int l = 0; l < 2; ++l) {
      if (l == 0) LAUNCH_PK(102, l, g);
      LAUNCH_PK(0, l, g); LAUNCH_PK(1, l, g); LAUNCH_PK(2, l, g); LAUNCH_PK(3, l, g); LAUNCH_PK(4, l, g); LAUNCH_PK(5, l, g);
      LAUNCH_PK(6, l, g); LAUNCH_PK(7, l, g); LAUNCH_PK(8, l, g); LAUNCH_PK(9, l, g); LAUNCH_PK(10, l, g);
    }
  LAUNCH_PK(101, 0, 0);
#else
  static int grid_blocks = 0;
  if (!grid_blocks) {
    (void)hipFuncSetAttribute((const void*)mega, hipFuncAttributeMaxDynamicSharedMemorySize, LDS_BYTES + 32);
    int dev = 0, cus = 0, per_cu = 0;
    (void)hipGetDevice(&dev);
    (void)hipDeviceGetAttribute(&cus, hipDeviceAttributeMultiprocessorCount, dev);
    (void)hipOccupancyMaxActiveBlocksPerMultiprocessor(&per_cu, (const void*)mega, 256, LDS_BYTES + 32);
    if (per_cu < 1) per_cu = 1;
    if (per_cu > 2) per_cu = 2;
    grid_blocks = cus * per_cu;
  }
  (void)hipMemsetAsync(p.bar, 0, (size_t)XCD_BAR_WORDS * 4, stream);
  int plo = 0, phi = NPHASES, coop = 1;
  void* args[] = {&p, &plo, &phi, &coop};
  hipError_t e = hipLaunchCooperativeKernel((const void*)mega, dim3(grid_blocks), dim3(256), args, LDS_BYTES + 32, stream);
  if (e != hipSuccess) fprintf(stderr, "cooperative launch failed: %s (grid %d)\n", hipGetErrorString(e), grid_blocks);
#endif
}
```

```cpp
#include <hip/hip_runtime.h>
#include <hip/hip_cooperative_groups.h>
#include <stdint.h>
#include <stdio.h>
namespace cg = cooperative_groups;

typedef __attribute__((ext_vector_type(8))) short bf16x8;
typedef __attribute__((ext_vector_type(4))) float f32x4;
typedef unsigned short bf16_t;
typedef uint32_t u32x4 __attribute__((ext_vector_type(4)));
typedef uint32_t u32x2 __attribute__((ext_vector_type(2)));
typedef float fl4 __attribute__((ext_vector_type(4)));
#define MK4(a,b,c,d) ((u32x4){(uint32_t)(a),(uint32_t)(b),(uint32_t)(c),(uint32_t)(d)})
#define MK2(a,b) ((u32x2){(uint32_t)(a),(uint32_t)(b)})
#define MKF4(a,b,c,d) ((fl4){(a),(b),(c),(d)})

#define NTOKG 16384
#define MROWS 16512
#define MTILES 129
#define LSTRIDE 20185088
#define WOFF_A 0
#define WOFF_B (4096 * 1024)
#define WOFF_G (6400 * 1024)
#define WOFF_O (10496 * 1024)
#define WOFF_U (11520 * 1024)
#define WOFF_D (15616 * 1024)
#define LDS_BYTES 80896
#define NPHASES 48

struct Params {
  const float* x[2];
  const float* meta;
  const float* attn_norm;
  const float* w_in;
  const float* lb_logits;
  const float* w_gate;
  const float* b_gate;
  const float* norm_a;
  const float* norm_b;
  const float* w_out;
  const float* mlp_norm;
  const float* w_up;
  const float* w_down;
  const float* final_norm;
  float* out;
  bf16_t* W;
  bf16_t* X;
  bf16_t* R;
  bf16_t* O;
  bf16_t* HB;
  float* RSA;
  float* RSB;
  bf16_t* ST;
  float* GD;
  float* hmeta;
  unsigned* bar;
};

__device__ __forceinline__ uint32_t pack2(float a, float b) {
  uint32_t r;
  asm("v_cvt_pk_bf16_f32 %0, %1, %2" : "=v"(r) : "v"(a), "v"(b));
  return r;
}
__device__ __forceinline__ bf16_t f2bf(float f) { return (bf16_t)(pack2(f, f) & 0xffffu); }
__device__ __forceinline__ int opaque_tid(char* smem) {
  int lane;
  asm volatile("v_mbcnt_lo_u32_b32 %0, -1, 0\n\tv_mbcnt_hi_u32_b32 %0, -1, %0" : "=v"(lane));
  int* cnt = (int*)(smem + LDS_BYTES);
  int w = 0;
  if (lane == 0) w = atomicAdd(cnt, 1);
  w = __builtin_amdgcn_readfirstlane(w) & 3;
  __syncthreads();
  return w * 64 + lane;
}
__device__ __forceinline__ int opaque_bid() { int b = blockIdx.x; asm volatile("" : "+s"(b)); return b; }
template <int M>
__device__ __forceinline__ float shx(float v, int lane) {
  if (M < 32) return __builtin_bit_cast(float, __builtin_amdgcn_ds_swizzle(__builtin_bit_cast(int, v), 0x1f | (M << 10)));
  return __builtin_bit_cast(float, __builtin_amdgcn_ds_bpermute((lane ^ M) << 2, __builtin_bit_cast(int, v)));
}
__device__ __forceinline__ float bf2f(bf16_t b) { return __uint_as_float(((uint32_t)b) << 16); }
__device__ __forceinline__ size_t tiled_off(size_t row, int col, int K) {
  return (((row >> 7) * (size_t)(K >> 5) + (size_t)(col >> 5)) * 128 + (row & 127)) * 32 + (size_t)(col & 31);
}
__device__ __forceinline__ float sigmoidf_(float x) { return __builtin_amdgcn_rcpf(1.f + __builtin_amdgcn_exp2f(x * -1.4426950408889634f)); }

__device__ __forceinline__ int w_in_col(int R, float& scale) {
  scale = 1.f;
  if (R < 4096) return R;
  if (R < 6400) {
    int n = R - 4096;
    if (n >= 2080) return -1;
    if (n < 512) scale = 0.08838834764831845f;
    return 5120 + n;
  }
  int n = R - 6400;
  int tt = n >> 8, wv = n & 255;
  int wn = wv >> 7, nl = wv & 127;
  int qd = nl >> 5, ni = (nl >> 2) & 7, r = nl & 3;
  int grp = ni >> 2, seg = ni & 3;
  int ucol = tt * 64 + wn * 32 + qd * 8 + grp * 4 + r;
  int base = seg == 0 ? 4096 : seg == 1 ? 8224 : seg == 2 ? 7200 : 9248;
  return base + ucol;
}

__device__ __forceinline__ void phase_init(const Params& p, char* smem) {
  const int t = opaque_tid(smem);
  const int bid_ = opaque_bid();
  for (int idx = bid_ * 256 + t; idx < 2 * 128 * 256; idx += gridDim.x * 256) {
    int g = idx / (128 * 256), r = (idx / 256) % 128, c4 = idx % 256;
    int nvalid = g == 0 ? 16 : 64;
    fl4 v = MKF4(0.f, 0.f, 0.f, 0.f);
    if (r < nvalid) v = *(const fl4*)(p.meta + (size_t)(r & 15) * 1024 + c4 * 4);
    *(fl4*)(p.hmeta + ((size_t)g * 128 + r) * 1024 + c4 * 4) = v;
  }
  float* tile = (float*)smem;
  const int per_layer = 3904 + 1024;
  for (int id = bid_; id < 2 * per_layer; id += gridDim.x) {
    int l = id / per_layer, r = id % per_layer;
    const float* src; int ld; const float* gain = nullptr; int K, n0, k0;
    bf16_t* dst;
    int kind;
    int cbase = 0;
    if (r < 3904) {
      int rt = r >> 4, kt = r & 15;
      n0 = rt * 64; k0 = kt * 64; K = 1024;
      dst = p.W + (size_t)l * LSTRIDE;
      if (n0 < 10496) { kind = 0; src = p.w_in + (size_t)l * 1024 * 10272; ld = 10272; gain = p.attn_norm + l * 1024; }
      else if (n0 < 11520) { kind = 1; src = p.w_out + (size_t)l * 1024 * 1024; ld = 1024; cbase = n0 - 10496; }
      else { kind = 1; src = p.w_up + (size_t)l * 1024 * 4096; ld = 4096; cbase = n0 - 11520; gain = p.mlp_norm + l * 1024; }
    } else {
      int r2 = r - 3904;
      int rt = r2 >> 6, kt = r2 & 63;
      n0 = rt * 64; k0 = kt * 64; K = 4096;
      dst = p.W + (size_t)l * LSTRIDE + WOFF_D;
      kind = 1; src = p.w_down + (size_t)l * 4096 * 1024; ld = 1024; cbase = n0;
    }
    {
      int n = t & 63;
      float scale = 1.f; int col;
      if (kind == 0) col = w_in_col(n0 + n, scale); else col = cbase + n;
#pragma unroll 4
      for (int i = 0; i < 16; ++i) {
        int kk = (t >> 6) + 4 * i;
        float v = 0.f;
        if (col >= 0) {
          v = src[(size_t)(k0 + kk) * ld + col] * scale;
          if (gain) v *= gain[k0 + kk];
        }
        tile[kk * 65 + n] = v;
      }
    }
    __syncthreads();
    {
      int n = t >> 2, piece = t & 3;
      uint32_t pk[8];
#pragma unroll
      for (int e = 0; e < 8; ++e) {
        float a = tile[(piece * 16 + 2 * e) * 65 + n];
        float b = tile[(piece * 16 + 2 * e + 1) * 65 + n];
        pk[e] = pack2(a, b);
      }
      const int Rr = n0 + n, kk = k0 + piece * 16;
      u32x4* d = (u32x4*)(dst + ((size_t)((Rr >> 8) * (K >> 5) + (kk >> 5)) * 256 + (Rr & 255)) * 32 + (kk & 31));
      d[0] = MK4(pk[0], pk[1], pk[2], pk[3]);
      d[1] = MK4(pk[4], pk[5], pk[6], pk[7]);
    }
    __syncthreads();
  }
}

template <int NT>
__device__ __forceinline__ void tile_to_mn(int tile, int& mt, int& nt) {
  if ((NT == 16 || NT == 4) && tile < 128 * NT) {
    const int round = tile >> 9, s_ = tile & 511;
    const int xcd = s_ & 7, j = s_ >> 3;
    if (NT == 16) {
      mt = round * 32 + (xcd >> 1) * 8 + (j >> 3);
      nt = (xcd & 1) * 8 + (j & 7);
    } else {
      mt = round * (512 / NT) + (j / NT) * 8 + xcd;
      nt = j % NT;
    }
  } else if (NT == 9 && tile < 1024) {
    const int s_ = tile & 511;
    const int tl = (tile & ~511) + (s_ & 7) * 64 + (s_ >> 3);
    mt = tl / NT; nt = tl % NT;
  } else { mt = tile / NT; nt = tile % NT; }
}

enum { EPI_G1A = 0, EPI_G1B, EPI_GATES, EPI_WOUT, EPI_UP, EPI_DOWN };

template <int EPI>
__device__ __forceinline__ void gemm_phase(const Params& p, int l, int g, char* smem) {
  constexpr bool NORM = (EPI == EPI_G1A || EPI == EPI_G1B || EPI == EPI_GATES || EPI == EPI_UP);
  constexpr int K = (EPI == EPI_DOWN) ? 4096 : 1024;
  constexpr int NT = EPI == EPI_G1A ? 16 : EPI == EPI_G1B ? 9 : EPI == EPI_GATES ? 16 : EPI == EPI_WOUT ? 4 : EPI == EPI_UP ? 16 : 4;
  constexpr int WOFF = EPI == EPI_G1A ? WOFF_A : EPI == EPI_G1B ? WOFF_B : EPI == EPI_GATES ? WOFF_G : EPI == EPI_WOUT ? WOFF_O : EPI == EPI_UP ? WOFF_U : WOFF_D;
  constexpr int NK = K / 32;
  const bf16_t* Wl = p.W + (size_t)l * LSTRIDE + WOFF;
  bf16_t* As = (bf16_t*)smem;
  bf16_t* Bs = As + 3 * 128 * 32;
  const int bid_ = opaque_bid();
  const int t = opaque_tid(smem), lane = t & 63, w = t >> 6, wm = w >> 1, wn = w & 1;
  const int quad = lane >> 4, l15 = lane & 15;
  const int nvalid_meta = g == 0 ? 16 : 64;

  if (EPI == EPI_G1A) for (int i = bid_ * 256 + t; i < MROWS; i += gridDim.x * 256) p.RSB[i] = 0.f;
  if (EPI == EPI_UP) for (int i = bid_ * 256 + t; i < MROWS; i += gridDim.x * 256) p.RSA[i] = 0.f;
  bool pre = false;
  for (int tile = bid_; tile < MTILES * NT; tile += gridDim.x) {
    int mt, nt; tile_to_mn<NT>(tile, mt, nt);
    const bf16_t* Ab = NORM ? p.HB + (size_t)mt * 128 * 1024 : p.X + (size_t)mt * 128 * K;
    const bf16_t* Bg = Wl + (size_t)nt * 256 * K;
    const bool do_mma = !(mt == 128 && wm == 1) && !(EPI == EPI_G1B && nt == 8 && wn == 1);

    f32x4 acc[4][8];
#pragma unroll
    for (int a = 0; a < 4; ++a)
#pragma unroll
      for (int b = 0; b < 8; ++b) acc[a][b] = (f32x4){0.f, 0.f, 0.f, 0.f};
    int t_l = t;
    asm volatile("" : "+v"(t_l));
    const uint32_t voffA = (uint32_t)((t_l >> 2) * 64 + (((t_l & 3) ^ (((t_l >> 5) & 1) << 1)) * 16));
    const uint32_t voffB0 = (uint32_t)((t_l >> 2) * 64 + ((t_l & 3) * 16));
    const uint32_t voffB1 = (uint32_t)((t_l >> 2) * 64 + (((t_l & 3) ^ 2) * 16));
    const char* Abase = (const char*)Ab;
    const char* Bbase = (const char*)Bg;
    const int rpiece = quad ^ (((l15 >> 3) & 1) << 1);
    const int w_s = __builtin_amdgcn_readfirstlane(t_l >> 6);
#define GLDS(gp, lp) __builtin_amdgcn_global_load_lds((const __attribute__((address_space(1))) void*)(gp), (__attribute__((address_space(3))) void*)(lp), 16, 0, 0)
#define G_DMA(KT, BUF) G_DMA2(Abase, Bbase, KT, BUF)
#define G_DMA2(AB_, BB_, KT, BUF) do { \
      const char* ua = (AB_) + (size_t)(KT) * 8192; const char* ub = (BB_) + (size_t)(KT) * 16384; \
      asm volatile("" : "+s"(ua), "+s"(ub));     \
      char* la = (char*)(As + (BUF) * 4096) + w_s * 1024; char* lb = (char*)(Bs + (BUF) * 8192) + w_s * 1024;     \
      _Pragma("unroll") for (int i = 0; i < 2; ++i) GLDS(ua + i * 4096 + voffA, la + i * 4096); \
      _Pragma("unroll") for (int i = 0; i < 4; ++i) GLDS(ub + i * 4096 + ((i & 1) ? voffB1 : voffB0), lb + i * 4096); } while (0)
#define G_FRAGS(BUF) \
      const bf16_t* Aw = As + (BUF) * 4096; const bf16_t* Bw = Bs + (BUF) * 8192; \
      bf16x8 af[4], bfr[8]; \
      _Pragma("unroll") for (int mi = 0; mi < 4; ++mi) af[mi] = *(const bf16x8*)(Aw + (wm * 64 + mi * 16 + l15) * 32 + rpiece * 8); \
      _Pragma("unroll") for (int ni = 0; ni < 8; ++ni) bfr[ni] = *(const bf16x8*)(Bw + (wn * 128 + (l15 >> 2) * 32 + ni * 4 + (l15 & 3)) * 32 + rpiece * 8);
#define G_MMA() \
      if (do_mma) { \
        __builtin_amdgcn_s_setprio(1); \
        _Pragma("unroll") for (int ni = 0; ni < 8; ++ni) \
          _Pragma("unroll") for (int mi = 0; mi < 4; ++mi) \
            acc[mi][ni] = __builtin_amdgcn_mfma_f32_16x16x32_bf16(bfr[ni], af[mi], acc[mi][ni], 0, 0, 0); \
        __builtin_amdgcn_s_setprio(0); }

    if (!pre) { G_DMA(0, 0); G_DMA(1, 1); }
    asm volatile("s_waitcnt vmcnt(0)" ::: "memory");
#define G_STEP3(CUR, NXT, KN) do { \
      asm volatile("s_waitcnt vmcnt(6)\n\ts_waitcnt lgkmcnt(0)" ::: "memory"); \
      __builtin_amdgcn_s_barrier(); \
      asm volatile("" ::: "memory"); \
      G_FRAGS(CUR) \
      G_DMA(KN, NXT);     \
      G_MMA(); } while (0)
#pragma unroll 1
    for (int kt = 0; kt < NK - 2; kt += 3) {
      G_STEP3(0, 2, kt + 2);
      G_STEP3(1, 0, kt + 3);
      G_STEP3(2, 1, kt + 4);
    }
    G_STEP3(0, 2, NK - 1);
    G_STEP3(1, 0, NK - 1);
#undef G_STEP3
    asm volatile("s_waitcnt vmcnt(0)" ::: "memory");
    __syncthreads();
    {
      const int tile2 = tile + (int)gridDim.x;
      pre = tile2 < MTILES * NT;
      if (pre) {
        int mt2, nt2; tile_to_mn<NT>(tile2, mt2, nt2);
        const char* Ab2 = (const char*)(NORM ? p.HB + (size_t)mt2 * 128 * 1024 : p.X + (size_t)mt2 * 128 * K);
        const char* Bg2 = (const char*)(Wl + (size_t)nt2 * 256 * K);
        G_DMA2(Ab2, Bg2, 0, 0);
        G_DMA2(Ab2, Bg2, 1, 1);
      }
    }
#undef GLDS
#undef G_DMA
#undef G_DMA2
#undef G_FRAGS
#undef G_MMA

    int quad_e = quad, l15_e = l15, t_e = t;
    asm volatile("" : "+v"(quad_e), "+v"(l15_e), "+v"(t_e));
    if (do_mma) {
#pragma unroll
    for (int mi = 0; mi < 4; ++mi) {
      __builtin_amdgcn_sched_barrier(0);
      const int rl = wm * 64 + mi * 16 + l15_e;
      const size_t grow = (size_t)mt * 128 + rl;
      const float rs = NORM ? rsqrtf((EPI == EPI_UP ? p.RSB : p.RSA)[grow] * (1.f / 1024.f) + 1e-6f) : 1.f;
      const int cw = wn * 128 + quad_e * 32;
      if (EPI == EPI_G1A) {
        const int region = nt >> 2;
        bf16_t* xp = p.X + grow * 4096 + nt * 256 + cw;
#pragma unroll
        for (int c = 0; c < 4; ++c) {
          float v[8];
#pragma unroll
          for (int e = 0; e < 8; ++e) v[e] = acc[mi][2 * c + (e >> 2)][e & 3] * rs;
          if (region == 1 || region == 2) {
            float lb[8] = {0.f, 0.f, 0.f, 0.f, 0.f, 0.f, 0.f, 0.f};
            if (l == 1) {
              const float* l0p = p.lb_logits + (region - 1) * 1024 + ((nt * 256 + cw + c * 8) & 1023);
              const fl4 a0 = *(const fl4*)l0p, a1 = *(const fl4*)(l0p + 4);
              const fl4 b0 = *(const fl4*)(l0p + 2048), b1 = *(const fl4*)(l0p + 2052);
              lb[0] = sigmoidf_(b0.x - a0.x); lb[1] = sigmoidf_(b0.y - a0.y);
              lb[2] = sigmoidf_(b0.z - a0.z); lb[3] = sigmoidf_(b0.w - a0.w);
              lb[4] = sigmoidf_(b1.x - a1.x); lb[5] = sigmoidf_(b1.y - a1.y);
              lb[6] = sigmoidf_(b1.z - a1.z); lb[7] = sigmoidf_(b1.w - a1.w);
            }
#pragma unroll
            for (int e = 0; e < 8; ++e) {
              const float f = fmaxf(lb[e], 1e-30f) + (1.f - lb[e]) * sigmoidf_(v[e]);
              v[e] = __builtin_amdgcn_logf(f);
            }
          }
          *(u32x4*)(xp + c * 8) = MK4(pack2(v[0], v[1]), pack2(v[2], v[3]), pack2(v[4], v[5]), pack2(v[6], v[7]));
        }
      } else if (EPI == EPI_G1B) {
        if (nt < 8) {
          bf16_t* xp = p.X + grow * 2048 + nt * 256 + cw;
#pragma unroll
          for (int c = 0; c < 4; ++c)
            *(u32x4*)(xp + c * 8) = MK4(pack2(acc[mi][2 * c][0] * rs, acc[mi][2 * c][1] * rs), pack2(acc[mi][2 * c][2] * rs, acc[mi][2 * c][3] * rs),
                                        pack2(acc[mi][2 * c + 1][0] * rs, acc[mi][2 * c + 1][1] * rs), pack2(acc[mi][2 * c + 1][2] * rs, acc[mi][2 * c + 1][3] * rs));
        } else if (cw == 0) {
          bf16_t* rp = p.R + grow * 32;
#pragma unroll
          for (int c = 0; c < 4; ++c)
            *(u32x4*)(rp + c * 8) = MK4(pack2(acc[mi][2 * c][0] * rs, acc[mi][2 * c][1] * rs), pack2(acc[mi][2 * c][2] * rs, acc[mi][2 * c][3] * rs),
                                        pack2(acc[mi][2 * c + 1][0] * rs, acc[mi][2 * c + 1][1] * rs), pack2(acc[mi][2 * c + 1][2] * rs, acc[mi][2 * c + 1][3] * rs));
        }
      } else if (EPI == EPI_GATES) {
        const int uc = nt * 64 + wn * 32 + quad_e * 8;
        const u32x4 oa = *(const u32x4*)(p.O + grow * 2048 + uc);
        const u32x4 ob = *(const u32x4*)(p.O + grow * 2048 + 1024 + uc);
        const uint32_t oau[4] = {oa.x, oa.y, oa.z, oa.w}, obu[4] = {ob.x, ob.y, ob.z, ob.w};
        float u[8];
#pragma unroll
        for (int grp = 0; grp < 2; ++grp)
#pragma unroll
          for (int r = 0; r < 4; ++r) {
            const int idx = grp * 4 + r;
            const float ga = acc[mi][grp * 4 + 0][r] * rs, ma = acc[mi][grp * 4 + 1][r] * rs;
            const float gb = acc[mi][grp * 4 + 2][r] * rs, mb = acc[mi][grp * 4 + 3][r] * rs;
            const float ona = (idx & 1) ? __uint_as_float(oau[idx >> 1] & 0xffff0000u) : __uint_as_float(oau[idx >> 1] << 16);
            const float onb = (idx & 1) ? __uint_as_float(obu[idx >> 1] & 0xffff0000u) : __uint_as_float(obu[idx >> 1] << 16);
            u[idx] = sigmoidf_(ma) * (ga * sigmoidf_(ga)) * ona + sigmoidf_(mb) * (gb * sigmoidf_(gb)) * onb;
          }
        *(u32x4*)(p.X + tiled_off(grow, uc, 1024)) = MK4(pack2(u[0], u[1]), pack2(u[2], u[3]), pack2(u[4], u[5]), pack2(u[6], u[7]));
      } else if (EPI == EPI_WOUT || EPI == EPI_DOWN) {
        const bool meta = (mt == 128);
        float hsq = 0.f;
        if (!meta || rl < nvalid_meta) {
          const float* hin; float* hout;
          if (meta) { hout = p.hmeta + ((size_t)g * 128 + rl) * 1024; hin = hout; }
          else {
            const size_t trow = (size_t)mt * 128 + rl;
            hout = p.out + ((size_t)g * NTOKG + trow) * 1024;
            hin = (EPI == EPI_WOUT && l == 0) ? p.x[g] + trow * 1024 : hout;
          }
          const int col0 = nt * 256 + cw;
          bf16_t* hb = p.HB + tiled_off(grow, col0, 1024);
#pragma unroll
          for (int c = 0; c < 4; ++c) {
            const fl4 h0 = *(const fl4*)(hin + col0 + c * 8), h1 = *(const fl4*)(hin + col0 + c * 8 + 4);
            const fl4 o0 = MKF4(h0.x + acc[mi][2 * c][0], h0.y + acc[mi][2 * c][1], h0.z + acc[mi][2 * c][2], h0.w + acc[mi][2 * c][3]);
            const fl4 o1 = MKF4(h1.x + acc[mi][2 * c + 1][0], h1.y + acc[mi][2 * c + 1][1], h1.z + acc[mi][2 * c + 1][2], h1.w + acc[mi][2 * c + 1][3]);
            *(fl4*)(hout + col0 + c * 8) = o0;
            *(fl4*)(hout + col0 + c * 8 + 4) = o1;
            *(u32x4*)(hb + c * 8) = MK4(pack2(o0.x, o0.y), pack2(o0.z, o0.w), pack2(o1.x, o1.y), pack2(o1.z, o1.w));
            hsq += o0.x * o0.x + o0.y * o0.y + o0.z * o0.z + o0.w * o0.w + o1.x * o1.x + o1.y * o1.y + o1.z * o1.z + o1.w * o1.w;
          }
        }
        hsq += shx<16>(hsq, lane); hsq += shx<32>(hsq, lane);
        if (quad_e == 0 && (!meta || rl < nvalid_meta)) atomicAdd((EPI == EPI_WOUT ? p.RSB : p.RSA) + grow, hsq);
      } else if (EPI == EPI_UP) {
        bf16_t* xp = p.X + tiled_off(grow, nt * 256 + cw, 4096);
#pragma unroll
        for (int c = 0; c < 4; ++c) {
          float v[8];
#pragma unroll
          for (int e = 0; e < 8; ++e) { const float a = fmaxf(acc[mi][2 * c + (e >> 2)][e & 3] * rs, 0.f); v[e] = a * a; }
          *(u32x4*)(xp + c * 8) = MK4(pack2(v[0], v[1]), pack2(v[2], v[3]), pack2(v[4], v[5]), pack2(v[6], v[7]));
        }
      }
    }
    }
  }
}

template <int MIX, int PASS>
__device__ __forceinline__ void scan_phase(const Params& p, int l, int g, char* smem) {
  constexpr int NH = MIX ? 4 : 8;
  constexpr int NDV = MIX ? 4 : 2;
  constexpr int XLD = MIX ? 2048 : 4096;
  bf16_t* QS = (bf16_t*)smem;
  bf16_t* KS = QS + 64 * 136;
  bf16_t* KT = KS + 64 * 136;
  bf16_t* LG = KT;
  bf16_t* Pm = QS;
  bf16_t* SmT = KS;
  bf16_t* VT = KT + 128 * 72;
  bf16_t* RS = VT + 64 * 72;
  float* em = (float*)(RS + 64 * 24);
  float* el = em + 128;
  float* tot = el + 128;
  const int bid_ = opaque_bid();
  const int t_outer = opaque_tid(smem);
  const int sps = g == 0 ? 16 : 4;
  constexpr bool do_out = (PASS == 3);
  const bf16_t* Xg = p.X;

  for (int item = bid_; item < 512; item += gridDim.x) {
    int t = t_outer;
    asm volatile("" : "+v"(t));
    const int lane = t & 63, w = t >> 6, quad = lane >> 4, l15 = lane & 15;
    const int dir = item & 1;
    const int dvb = (item >> 1) % NDV;
    const int head = ((item >> 1) / NDV) % NH;
    const int seg = item >> 5;
    const int seq = seg / sps;
    const bool first = (seg % sps) == 0;
    const int nsteps = 16 + (first ? 1 : 0);
    int qcol, kcol, vcol;
    bf16_t* Og; int OLD;
    if (MIX == 0) {
      qcol = head * 128; kcol = 1024 + dir * 1024 + head * 128; vcol = 3072 + head * 128 + dvb * 64;
      Og = p.O + dir * 1024 + head * 128 + dvb * 64; OLD = 2048;
    } else {
      qcol = head * 128; kcol = 512 + head * 128; vcol = 1024 + head * 256 + dvb * 64;
      Og = p.X + (size_t)MROWS * 2048 + (size_t)dir * MROWS * 1024 + head * 256 + dvb * 64; OLD = 1024;
    }
    bf16x8 wgf[2]; float bgv[2][4];
    if (MIX == 1) {
#pragma unroll
      for (int ct = 0; ct < 2; ++ct) {
        const int cc = 16 * (2 * w + ct) + l15;
        bf16x8 v = (bf16x8){0, 0, 0, 0, 0, 0, 0, 0};
        if (quad < 2) {
#pragma unroll
          for (int e = 0; e < 8; ++e)
            v[e] = (short)f2bf(p.w_gate[((size_t)(l * 2 + dir) * 16 + quad * 8 + e) * 512 + head * 128 + cc]);
        }
        wgf[ct] = v;
#pragma unroll
        for (int r = 0; r < 4; ++r) bgv[ct][r] = p.b_gate[(l * 2 + dir) * 512 + head * 128 + 16 * (2 * w + ct) + quad * 4 + r];
      }
    }
    f32x4 S[8];
#pragma unroll
    for (int a = 0; a < 8; ++a) S[a] = (f32x4){0.f, 0.f, 0.f, 0.f};
    if (do_out) {
      int s2 = dir == 0 ? seq * sps : seq * sps + sps - 1;
      const int stp = dir == 0 ? 1 : -1;
      for (; s2 != seg; s2 += stp) {
        const int item2 = ((s2 * NH + head) * NDV + dvb) * 2 + dir;
        const bf16_t* L = p.ST + (size_t)item2 * 8192;
        const float* G = p.GD + ((s2 * 8 + head) * 2 + dir) * 128;
#pragma unroll
        for (int a = 0; a < 8; ++a)
#pragma unroll
          for (int r = 0; r < 4; ++r) {
            const int k = 16 * (2 * w + (a >> 2)) + quad * 4 + r;
            S[a][r] = __builtin_amdgcn_exp2f(G[k]) * S[a][r] + bf2f(L[(a * 4 + r) * 256 + t]);
          }
      }
    }
    float gacc0 = 0.f, gacc1 = 0.f;

    u32x4 qr[4], kr[4], vr[2], rr;
    auto step_rows = [&](int s, int& rowbase, int& nv) {
      bool meta;
      if (dir == 0) { meta = first && s == 0; rowbase = (seg * 16 + s - (first ? 1 : 0)) * 64; }
      else { meta = (s == 16); rowbase = (seg * 16 + 15 - s) * 64; }
      if (meta) { rowbase = NTOKG + seq * 16; nv = 16; } else nv = 64;
    };
    const char* Xq = (const char*)(Xg + qcol);
    const char* Xk = (const char*)(Xg + kcol);
    const char* Xv = (const char*)(Xg + vcol);
    const char* Rb = (const char*)(p.R + dir * 16);
    auto gload = [&](int s) {
      int rowbase, nv; step_rows(s, rowbase, nv);
#pragma unroll
      for (int j = 0; j < 4; ++j) {
        const int i = (t >> 4) + 16 * j;
        const int mr = dir ? rowbase + nv - 1 - i : rowbase + i;
        u32x4 z = MK4(0, 0, 0, 0);
        if (i < nv) {
          const uint32_t vo = (uint32_t)(mr * XLD + (t & 15) * 8) * 2u;
          qr[j] = do_out ? *(const u32x4*)(Xq + vo) : z;
          kr[j] = *(const u32x4*)(Xk + vo);
        } else { qr[j] = z; kr[j] = z; }
      }
      {
        const int i = t >> 2;
        const int mr = dir ? rowbase + nv - 1 - i : rowbase + i;
        vr[0] = MK4(0, 0, 0, 0); vr[1] = vr[0];
        if (i < nv) {
          const uint32_t vo = (uint32_t)(mr * XLD + (t & 3) * 16) * 2u;
          vr[0] = *(const u32x4*)(Xv + vo); vr[1] = *(const u32x4*)(Xv + vo + 16);
        }
      }
      if (MIX == 1) {
        rr = MK4(0, 0, 0, 0);
        if (t < 128) {
          const int i = t >> 1;
          const int mr = dir ? rowbase + nv - 1 - i : rowbase + i;
          if (i < nv) rr = *(const u32x4*)(Rb + (uint32_t)(mr * 32 + (t & 1) * 8) * 2u);
        }
      }
    };
    gload(0);

    for (int s = 0; s < nsteps; ++s) {
      int rowbase, nv; step_rows(s, rowbase, nv);
#pragma unroll
      for (int j = 0; j < 4; ++j) {
        const int i = (t >> 4) + 16 * j;
        if (do_out) *(u32x4*)(QS + i * 136 + (t & 15) * 8) = qr[j];
        *(u32x4*)(KS + i * 136 + (t & 15) * 8) = kr[j];
      }
      {
        const int i = t >> 2, piece = t & 3;
        uint32_t vv[8] = {vr[0].x, vr[0].y, vr[0].z, vr[0].w, vr[1].x, vr[1].y, vr[1].z, vr[1].w};
        bf16_t* vtw = VT + piece * 16 * 72 + i;
#pragma unroll
        for (int e = 0; e < 16; ++e) vtw[e * 72] = (bf16_t)((vv[e >> 1] >> ((e & 1) * 16)) & 0xffffu);
      }
      if (MIX == 1 && t < 128) *(u32x4*)(RS + (t >> 1) * 24 + (t & 1) * 8) = rr;
      if (s + 1 < nsteps) gload(s + 1);
      __syncthreads();
      if (MIX == 1) {
        bf16x8 af[4];
#pragma unroll
        for (int it = 0; it < 4; ++it) {
          af[it] = (bf16x8){0, 0, 0, 0, 0, 0, 0, 0};
          if (quad < 2) af[it] = *(const bf16x8*)(RS + (16 * it + l15) * 24 + quad * 8);
        }
#pragma unroll
        for (int ct = 0; ct < 2; ++ct)
#pragma unroll
          for (int it = 0; it < 4; ++it) {
            f32x4 z = __builtin_amdgcn_mfma_f32_16x16x32_bf16(wgf[ct], af[it], (f32x4){0.f, 0.f, 0.f, 0.f}, 0, 0, 0);
            float ls[4];
#pragma unroll
            for (int r = 0; r < 4; ++r) {
              const float zz = fmaxf(z[r] + bgv[ct][r], -80.f);
              ls[r] = __builtin_amdgcn_logf(1.f + __builtin_amdgcn_exp2f(zz * -1.4426950408889634f)) * -0.0625f;
            }
            *(u32x2*)(LG + (16 * it + l15) * 128 + 16 * (2 * w + ct) + quad * 4) = MK2(pack2(ls[0], ls[1]), pack2(ls[2], ls[3]));
          }
        __syncthreads();
      }
      const int cp = t & 63, rg = t >> 6;
      const int nvl = nv - 16 * rg;
      float p0[16], p1[16];
      {
        float run0 = 0.f, run1 = 0.f;
        constexpr int LFS32 = (MIX == 0) ? 68 : 64;
        const uint32_t* lfp = (const uint32_t*)((MIX == 0) ? (KS + 16 * rg * 136) : (LG + 16 * rg * 128)) + cp;
#pragma unroll
        for (int ii = 0; ii < 16; ++ii) {
          if ((ii & 7) == 0) __builtin_amdgcn_sched_barrier(0);
          const uint32_t u = lfp[ii * LFS32];
          float l0 = __uint_as_float(u << 16), l1 = __uint_as_float(u & 0xffff0000u);
          if (ii >= nvl) { l0 = 0.f; l1 = 0.f; }
          run0 += l0; run1 += l1;
          p0[ii] = run0; p1[ii] = run1;
        }
        *(float2*)(tot + rg * 128 + 2 * cp) = make_float2(run0, run1);
      }
      __syncthreads();
      {
        const float2 ta = *(const float2*)(tot + 2 * cp), tb = *(const float2*)(tot + 128 + 2 * cp);
        const float2 tc = *(const float2*)(tot + 256 + 2 * cp), td = *(const float2*)(tot + 384 + 2 * cp);
        const float m0 = ta.x + tb.x, m1 = ta.y + tb.y;
        const float base0 = (rg > 0 ? ta.x : 0.f) + (rg > 1 ? tb.x : 0.f) + (rg > 2 ? tc.x : 0.f);
        const float base1 = (rg > 0 ? ta.y : 0.f) + (rg > 1 ? tb.y : 0.f) + (rg > 2 ? tc.y : 0.f);
        uint32_t* qp = (uint32_t*)(QS + 16 * rg * 136) + cp;
        uint32_t* kp = (uint32_t*)(KS + 16 * rg * 136) + cp;
        float skp0 = __builtin_amdgcn_exp2f(-fminf(fmaxf(base0 - m0, -115.f), 115.f));
        float skp1 = __builtin_amdgcn_exp2f(-fminf(fmaxf(base1 - m1, -115.f), 115.f));
        uint32_t kt0[8], kt1[8], kkprev = 0;
#pragma unroll
        for (int ii = 0; ii < 16; ++ii) {
          if ((ii & 3) == 0) __builtin_amdgcn_sched_barrier(0);
          const float e0 = fminf(fmaxf(base0 + p0[ii] - m0, -115.f), 115.f);
          const float e1 = fminf(fmaxf(base1 + p1[ii] - m1, -115.f), 115.f);
          const float sq0 = __builtin_amdgcn_exp2f(e0), sq1 = __builtin_amdgcn_exp2f(e1);
          const float sk0 = __builtin_amdgcn_rcpf(sq0), sk1 = __builtin_amdgcn_rcpf(sq1);
          if (do_out) {
            const uint32_t uq = qp[ii * 68];
            qp[ii * 68] = pack2(__uint_as_float(uq << 16) * sq0, __uint_as_float(uq & 0xffff0000u) * sq1);
          }
          float k0, k1;
          if (MIX == 0) { k0 = 1.f - sq0 * skp0; k1 = 1.f - sq1 * skp1; skp0 = sk0; skp1 = sk1; }
          else { const uint32_t uk = kp[ii * 68]; k0 = __uint_as_float(uk << 16); k1 = __uint_as_float(uk & 0xffff0000u); }
          const uint32_t kk = pack2(k0 * sk0, k1 * sk1);
          if (do_out) kp[ii * 68] = kk;
          if (ii & 1) {
            kt0[ii >> 1] = __builtin_amdgcn_perm(kk, kkprev, 0x05040100u);
            kt1[ii >> 1] = __builtin_amdgcn_perm(kk, kkprev, 0x07060302u);
          } else kkprev = kk;
        }
        u32x4* kd0 = (u32x4*)(KT + (2 * cp) * 72 + 16 * rg);
        u32x4* kd1 = (u32x4*)(KT + (2 * cp + 1) * 72 + 16 * rg);
        kd0[0] = MK4(kt0[0], kt0[1], kt0[2], kt0[3]); kd0[1] = MK4(kt0[4], kt0[5], kt0[6], kt0[7]);
        kd1[0] = MK4(kt1[0], kt1[1], kt1[2], kt1[3]); kd1[1] = MK4(kt1[4], kt1[5], kt1[6], kt1[7]);
        if (rg == 0) {
          *(float2*)(em + 2 * cp) = make_float2(__builtin_amdgcn_exp2f(m0), __builtin_amdgcn_exp2f(m1));
          *(float2*)(el + 2 * cp) = make_float2(__builtin_amdgcn_exp2f(tc.x + td.x), __builtin_amdgcn_exp2f(tc.y + td.y));
        }
        gacc0 += m0 + tc.x + td.x; gacc1 += m1 + tc.y + td.y;
      }
      __syncthreads();
      if (do_out) {
        bf16x8 qf[4];
#pragma unroll
        for (int ks = 0; ks < 4; ++ks) qf[ks] = *(const bf16x8*)(QS + (16 * w + l15) * 136 + ks * 32 + quad * 8);
        f32x4 pa[4];
#pragma unroll
        for (int jt = 0; jt < 4; ++jt) {
          pa[jt] = (f32x4){0.f, 0.f, 0.f, 0.f};
          if (jt <= w) {
#pragma unroll
            for (int ks = 0; ks < 4; ++ks) {
              bf16x8 kf = *(const bf16x8*)(KS + (16 * jt + l15) * 136 + ks * 32 + quad * 8);
              pa[jt] = __builtin_amdgcn_mfma_f32_16x16x32_bf16(kf, qf[ks], pa[jt], 0, 0, 0);
            }
          }
        }
        __syncthreads();
        {
          const int i = 16 * w + l15;
          bf16_t* pw = Pm + i * 72 + quad * 4;
#pragma unroll
          for (int jt = 0; jt < 4; ++jt) {
            const int j0 = 16 * jt + quad * 4;
            float pv[4];
#pragma unroll
            for (int r = 0; r < 4; ++r) pv[r] = (jt <= w && j0 + r <= i) ? pa[jt][r] : 0.f;
            *(u32x2*)(pw + 16 * jt) = MK2(pack2(pv[0], pv[1]), pack2(pv[2], pv[3]));
          }
        }
#pragma unroll
        for (int a = 0; a < 8; ++a) {
          const int k0 = 16 * (2 * w + (a >> 2)) + quad * 4;
          const int v = 16 * (a & 3) + l15;
          const fl4 e = *(const fl4*)(em + k0);
          S[a][0] *= e.x; S[a][1] *= e.y; S[a][2] *= e.z; S[a][3] *= e.w;
          *(u32x2*)(SmT + v * 136 + k0) = MK2(pack2(S[a][0], S[a][1]), pack2(S[a][2], S[a][3]));
        }
        __syncthreads();
        f32x4 oa[4];
#pragma unroll
        for (int vt = 0; vt < 4; ++vt) {
          oa[vt] = (f32x4){0.f, 0.f, 0.f, 0.f};
#pragma unroll
          for (int ks = 0; ks < 4; ++ks) {
            bf16x8 sf = *(const bf16x8*)(SmT + (16 * vt + l15) * 136 + ks * 32 + quad * 8);
            oa[vt] = __builtin_amdgcn_mfma_f32_16x16x32_bf16(sf, qf[ks], oa[vt], 0, 0, 0);
          }
        }
#pragma unroll
        for (int js = 0; js < 2; ++js) {
          bf16x8 pfr = *(const bf16x8*)(Pm + (16 * w + l15) * 72 + js * 32 + quad * 8);
#pragma unroll
          for (int vt = 0; vt < 4; ++vt) {
            bf16x8 vf = *(const bf16x8*)(VT + (16 * vt + l15) * 72 + js * 32 + quad * 8);
            oa[vt] = __builtin_amdgcn_mfma_f32_16x16x32_bf16(vf, pfr, oa[vt], 0, 0, 0);
          }
        }
        {
          const int i = 16 * w + l15;
          if (i < nv) {
            const int mr = dir ? rowbase + nv - 1 - i : rowbase + i;
            bf16_t* op = (bf16_t*)((char*)Og + (uint32_t)(mr * OLD + quad * 4) * 2u);
#pragma unroll
            for (int vt = 0; vt < 4; ++vt) *(u32x2*)(op + 16 * vt) = MK2(pack2(oa[vt][0], oa[vt][1]), pack2(oa[vt][2], oa[vt][3]));
          }
        }
      } else {
#pragma unroll
        for (int a = 0; a < 8; ++a) {
          const int k0 = 16 * (2 * w + (a >> 2)) + quad * 4;
          const fl4 e = *(const fl4*)(em + k0);
          S[a][0] *= e.x; S[a][1] *= e.y; S[a][2] *= e.z; S[a][3] *= e.w;
        }
      }
#pragma unroll
      for (int js = 0; js < 2; ++js) {
        bf16x8 kf[2];
#pragma unroll
        for (int ktl = 0; ktl < 2; ++ktl) kf[ktl] = *(const bf16x8*)(KT + (16 * (2 * w + ktl) + l15) * 72 + js * 32 + quad * 8);
#pragma unroll
        for (int vt = 0; vt < 4; ++vt) {
          bf16x8 vf = *(const bf16x8*)(VT + (16 * vt + l15) * 72 + js * 32 + quad * 8);
#pragma unroll
          for (int ktl = 0; ktl < 2; ++ktl)
            S[ktl * 4 + vt] = __builtin_amdgcn_mfma_f32_16x16x32_bf16(kf[ktl], vf, S[ktl * 4 + vt], 0, 0, 0);
        }
      }
#pragma unroll
      for (int a = 0; a < 8; ++a) {
        const int k0 = 16 * (2 * w + (a >> 2)) + quad * 4;
        const fl4 e = *(const fl4*)(el + k0);
        S[a][0] *= e.x; S[a][1] *= e.y; S[a][2] *= e.z; S[a][3] *= e.w;
      }
      __syncthreads();
    }
    if (!do_out) {
      bf16_t* L = p.ST + (size_t)item * 8192;
#pragma unroll
      for (int a = 0; a < 8; ++a)
#pragma unroll
        for (int r = 0; r < 4; ++r) L[(a * 4 + r) * 256 + t] = f2bf(S[a][r]);
      if (dvb == 0 && t < 64) *(float2*)(p.GD + ((seg * 8 + head) * 2 + dir) * 128 + 2 * t) = make_float2(gacc0, gacc1);
    }
  }
}

__device__ __forceinline__ void phase_hn(const Params& p, int l, char* smem) {
  const int bid_ = opaque_bid();
  const int t = opaque_tid(smem), lane = t & 63, w = t >> 6;
  const bf16_t* Y1 = p.X + (size_t)MROWS * 2048;
  const bf16_t* Y2 = Y1 + (size_t)MROWS * 1024;
  for (int row = bid_ * 4 + w; row < MROWS; row += gridDim.x * 4) {
    bf16_t* oa = p.O + (size_t)row * 2048 + lane * 16;
    float xa[16], xb[16];
    {
      u32x4 a0 = *(const u32x4*)(oa), a1 = *(const u32x4*)(oa + 8);
      u32x4 b0 = *(const u32x4*)(oa + 1024), b1 = *(const u32x4*)(oa + 1032);
      uint32_t ua[8] = {a0.x, a0.y, a0.z, a0.w, a1.x, a1.y, a1.z, a1.w};
      uint32_t ub[8] = {b0.x, b0.y, b0.z, b0.w, b1.x, b1.y, b1.z, b1.w};
#pragma unroll
      for (int e = 0; e < 8; ++e) {
        xa[2 * e] = __uint_as_float(ua[e] << 16) + __uint_as_float(ub[e] << 16);
        xa[2 * e + 1] = __uint_as_float(ua[e] & 0xffff0000u) + __uint_as_float(ub[e] & 0xffff0000u);
      }
      const bf16_t* y1 = Y1 + (size_t)row * 1024 + lane * 16;
      const bf16_t* y2 = Y2 + (size_t)row * 1024 + lane * 16;
      u32x4 c0 = *(const u32x4*)(y1), c1 = *(const u32x4*)(y1 + 8);
      u32x4 d0 = *(const u32x4*)(y2), d1 = *(const u32x4*)(y2 + 8);
      uint32_t uc[8] = {c0.x, c0.y, c0.z, c0.w, c1.x, c1.y, c1.z, c1.w};
      uint32_t ud[8] = {d0.x, d0.y, d0.z, d0.w, d1.x, d1.y, d1.z, d1.w};
#pragma unroll
      for (int e = 0; e < 8; ++e) {
        xb[2 * e] = __uint_as_float(uc[e] << 16) + __uint_as_float(ud[e] << 16);
        xb[2 * e + 1] = __uint_as_float(uc[e] & 0xffff0000u) + __uint_as_float(ud[e] & 0xffff0000u);
      }
    }
    float sa = 0.f, sb = 0.f;
#pragma unroll
    for (int e = 0; e < 16; ++e) { sa += xa[e] * xa[e]; sb += xb[e] * xb[e]; }
    sa += shx<1>(sa, lane); sa += shx<2>(sa, lane); sa += shx<4>(sa, lane);
    sb += shx<1>(sb, lane); sb += shx<2>(sb, lane); sb += shx<4>(sb, lane); sb += shx<8>(sb, lane);
    const float ra = rsqrtf(sa * (1.f / 128.f) + 1e-6f);
    const float rb = rsqrtf(sb * (1.f / 256.f) + 1e-6f);
    const float* na = p.norm_a + l * 1024 + lane * 16;
    const float* nb = p.norm_b + l * 1024 + lane * 16;
    uint32_t pa[8], pb[8];
#pragma unroll
    for (int e = 0; e < 8; ++e) {
      pa[e] = pack2(xa[2 * e] * ra * na[2 * e], xa[2 * e + 1] * ra * na[2 * e + 1]);
      pb[e] = pack2(xb[2 * e] * rb * nb[2 * e], xb[2 * e + 1] * rb * nb[2 * e + 1]);
    }
    *(u32x4*)(oa) = MK4(pa[0], pa[1], pa[2], pa[3]);
    *(u32x4*)(oa + 8) = MK4(pa[4], pa[5], pa[6], pa[7]);
    *(u32x4*)(oa + 1024) = MK4(pb[0], pb[1], pb[2], pb[3]);
    *(u32x4*)(oa + 1032) = MK4(pb[4], pb[5], pb[6], pb[7]);
  }
}

__device__ __forceinline__ void phase_final(const Params& p, char* smem) {
  const int bid_ = opaque_bid();
  const int t = opaque_tid(smem), lane = t & 63, w = t >> 6;
  for (int row = bid_ * 4 + w; row < 2 * NTOKG; row += gridDim.x * 4) {
    float* hp = p.out + (size_t)row * 1024;
    fl4 v[4];
    float s = 0.f;
#pragma unroll
    for (int j = 0; j < 4; ++j) {
      v[j] = *(const fl4*)(hp + j * 256 + lane * 4);
      s += v[j].x * v[j].x + v[j].y * v[j].y + v[j].z * v[j].z + v[j].w * v[j].w;
    }
    s += shx<1>(s, lane); s += shx<2>(s, lane); s += shx<4>(s, lane);
    s += shx<8>(s, lane); s += shx<16>(s, lane); s += shx<32>(s, lane);
    const float rs = rsqrtf(s * (1.f / 1024.f) + 1e-6f);
#pragma unroll
    for (int j = 0; j < 4; ++j) {
      const fl4 gn = *(const fl4*)(p.final_norm + j * 256 + lane * 4);
      fl4 o = MKF4(v[j].x * rs * gn.x, v[j].y * rs * gn.y, v[j].z * rs * gn.z, v[j].w * rs * gn.w);
      *(fl4*)(hp + j * 256 + lane * 4) = o;
    }
  }
}

__device__ __forceinline__ void phase_xcvt(const Params& p, int g, char* smem) {
  const int bid_ = opaque_bid();
  const int t = opaque_tid(smem), lane = t & 63, w = t >> 6;
  for (int row = bid_ * 4 + w; row < MROWS; row += gridDim.x * 4) {
    const float* src = row < NTOKG ? p.x[g] + (size_t)row * 1024 : p.hmeta + ((size_t)g * 128 + (row - NTOKG)) * 1024;
    float ssq = 0.f;
#pragma unroll
    for (int j = 0; j < 2; ++j) {
      const int c8 = j * 64 + lane;
      const fl4 a = *(const fl4*)(src + c8 * 8), b = *(const fl4*)(src + c8 * 8 + 4);
      ssq += a.x * a.x + a.y * a.y + a.z * a.z + a.w * a.w + b.x * b.x + b.y * b.y + b.z * b.z + b.w * b.w;
      *(u32x4*)(p.HB + tiled_off((size_t)row, c8 * 8, 1024)) = MK4(pack2(a.x, a.y), pack2(a.z, a.w), pack2(b.x, b.y), pack2(b.z, b.w));
    }
    ssq += shx<1>(ssq, lane); ssq += shx<2>(ssq, lane); ssq += shx<4>(ssq, lane);
    ssq += shx<8>(ssq, lane); ssq += shx<16>(ssq, lane); ssq += shx<32>(ssq, lane);
    if (lane == 0) p.RSA[row] = ssq;
  }
}

__device__ __forceinline__ void run_phase(const Params& p, int ph, char* smem) {
  if (ph == 0) { phase_init(p, smem); return; }
  if (ph == NPHASES - 1) { phase_final(p, smem); return; }
  const int q = ph - 1;
  const int g = q / 23, r = q % 23;
  if (r == 0) { phase_xcvt(p, g, smem); return; }
  const int l = (r - 1) / 11, st = (r - 1) % 11;
  switch (st) {
    case 0: gemm_phase<EPI_G1A>(p, l, g, smem); break;
    case 1: scan_phase<0, 1>(p, l, g, smem); break;
    case 2: scan_phase<0, 3>(p, l, g, smem); break;
    case 3: gemm_phase<EPI_G1B>(p, l, g, smem); break;
    case 4: scan_phase<1, 1>(p, l, g, smem); break;
    case 5: scan_phase<1, 3>(p, l, g, smem); break;
    case 6: phase_hn(p, l, smem); break;
    case 7: gemm_phase<EPI_GATES>(p, l, g, smem); break;
    case 8: gemm_phase<EPI_WOUT>(p, l, g, smem); break;
    case 9: gemm_phase<EPI_UP>(p, l, g, smem); break;
    default: gemm_phase<EPI_DOWN>(p, l, g, smem); break;
  }
}

template <int ST>
__global__ void __launch_bounds__(256, 2) pk(Params p, int l, int g) {
  extern __shared__ __attribute__((aligned(16))) char smem[];
  if (ST == 100) phase_init(p, smem);
  else if (ST == 101) phase_final(p, smem);
  else if (ST == 102) phase_xcvt(p, g, smem);
  else if (ST == 0) gemm_phase<EPI_G1A>(p, l, g, smem);
  else if (ST == 1) scan_phase<0, 1>(p, l, g, smem);
  else if (ST == 2) scan_phase<0, 3>(p, l, g, smem);
  else if (ST == 3) gemm_phase<EPI_G1B>(p, l, g, smem);
  else if (ST == 4) scan_phase<1, 1>(p, l, g, smem);
  else if (ST == 5) scan_phase<1, 3>(p, l, g, smem);
  else if (ST == 6) phase_hn(p, l, smem);
  else if (ST == 7) gemm_phase<EPI_GATES>(p, l, g, smem);
  else if (ST == 8) gemm_phase<EPI_WOUT>(p, l, g, smem);
  else if (ST == 9) gemm_phase<EPI_UP>(p, l, g, smem);
  else gemm_phase<EPI_DOWN>(p, l, g, smem);
}


#define XB_TMO      128
#define XB_XCNT(j)  (256  + 64 * (j))
#define XB_XSUB(j)  (1280 + 64 * (j))
#define XB_XGEN(j)  (2304 + 64 * (j))
#define XB_TOP      3328
#define XB_TOPGEN   3392
#define XCD_BAR_WORDS 3456
#define XB_SPIN_CAP (1u << 22)
#define LAS __attribute__((address_space(3)))
__device__ __forceinline__ unsigned xb_ld(unsigned* p)              { return __hip_atomic_load(p, __ATOMIC_RELAXED, __HIP_MEMORY_SCOPE_AGENT); }
__device__ __forceinline__ unsigned xb_add(unsigned* p, unsigned v) { return __hip_atomic_fetch_add(p, v, __ATOMIC_RELAXED, __HIP_MEMORY_SCOPE_AGENT); }
__device__ __forceinline__ unsigned xb_xcc_id() { return (unsigned)__builtin_amdgcn_s_getreg((3 << 11) | 20) & 0xFu; }
#define XB_SPIN(cond, bar) do { unsigned _sp = 0; while (cond) { __builtin_amdgcn_s_sleep(1); \
    if ((++_sp & 255u) == 0u) { if (xb_ld(&(bar)[XB_TMO])) break; if (_sp > XB_SPIN_CAP) { atomicAdd(&(bar)[XB_TMO], 1u); break; } } } } while (0)

__device__ __forceinline__ void xcd_barrier_complete(unsigned* bar, unsigned x, unsigned& nloc, unsigned& nx) {
  const unsigned G = gridDim.x * gridDim.y * gridDim.z;
  unsigned sum, cnt, mine, sp = 0u;
  for (;;) {
    sum = 0u; cnt = 0u; mine = 0u;
#pragma unroll
    for (unsigned j = 0; j < 16; ++j) { const unsigned c = xb_ld(&bar[XB_XCNT(j)]); sum += c; cnt += (c > 0u) ? 1u : 0u; mine = (j == x) ? c : mine; }
    if (sum == G) break;
    __builtin_amdgcn_s_sleep(1);
    if ((++sp & 255u) == 0u) { if (xb_ld(&bar[XB_TMO])) break; if (sp > XB_SPIN_CAP) { atomicAdd(&bar[XB_TMO], 1u); break; } }
  }
  nloc = mine > 0u ? mine : 1u; nx = cnt > 0u ? cnt : 1u;
}

__device__ __forceinline__ void xcd_barrier(unsigned* bar, volatile LAS unsigned* st, bool leader_thread) {
  asm volatile("s_waitcnt vmcnt(0)" ::: "memory");
  __syncthreads();
  if (leader_thread) {
    const unsigned x = xb_xcc_id();
    __builtin_amdgcn_s_waitcnt(0);
    unsigned nloc = st[0], nx = st[1];
    if (nloc == 0u) { xcd_barrier_complete(bar, x, nloc, nx); st[0] = nloc; st[1] = nx; }
    const unsigned old = xb_add(&bar[XB_XSUB(x)], 1u);
    const unsigned gen = old / nloc;
    if (old + 1u == (gen + 1u) * nloc) {
      __builtin_amdgcn_fence(__ATOMIC_RELEASE, "agent");
      asm volatile("s_waitcnt vmcnt(0)" ::: "memory");
      const unsigned og = xb_add(&bar[XB_TOP], 1u);
      const unsigned tg = og / nx;
      if (og + 1u == (tg + 1u) * nx) xb_add(&bar[XB_TOPGEN], 1u);
      else XB_SPIN(xb_ld(&bar[XB_TOPGEN]) == tg, bar);
      __builtin_amdgcn_fence(__ATOMIC_ACQUIRE, "agent");
      xb_add(&bar[XB_XGEN(x)], 1u);
      asm volatile("s_waitcnt vmcnt(0)" ::: "memory");
    } else {
      XB_SPIN(xb_ld(&bar[XB_XGEN(x)]) == gen, bar);
      __builtin_amdgcn_fence(__ATOMIC_ACQUIRE, "agent");
      asm volatile("s_waitcnt vmcnt(0)" ::: "memory");
    }
  }
  __syncthreads();
}

#ifndef MULTI_LAUNCH
__global__ void __launch_bounds__(256, 2) mega(Params p, int plo, int phi, int coop) {
  extern __shared__ __attribute__((aligned(16))) char smem[];
  volatile LAS unsigned* st = (volatile LAS unsigned*)(smem + LDS_BYTES + 16);
  {
    const int t0 = opaque_tid(smem);
    if (t0 == 0) { st[0] = 0u; st[1] = 0u; (void)xb_add(&p.bar[XB_XCNT(xb_xcc_id())], 1u); }
    __syncthreads();
  }
  for (int ph = plo; ph < phi; ++ph) {
    run_phase(p, ph, smem);
    if (coop && ph + 1 < phi) {
      if (ph == 0) cg::this_grid().sync();
      else { const int tb = opaque_tid(smem); xcd_barrier(p.bar, st, tb == 0); }
    }
  }
}

#endif

static inline size_t align_up(size_t x) { return (x + 255) & ~(size_t)255; }

extern "C" void kernel_launch(void* const* d_in, const int* in_sizes, int n_in,
                              void* d_out, int out_size, void* d_ws, size_t ws_size,
                              hipStream_t stream) {
  Params p{};
  p.x[0] = (const float*)d_in[0];
  p.x[1] = (const float*)d_in[1];
  p.meta = (const float*)d_in[2];
  p.attn_norm = (const float*)d_in[3];
  p.w_in = (const float*)d_in[4];
  p.lb_logits = (const float*)d_in[5];
  p.w_gate = (const float*)d_in[6];
  p.b_gate = (const float*)d_in[7];
  p.norm_a = (const float*)d_in[8];
  p.norm_b = (const float*)d_in[9];
  p.w_out = (const float*)d_in[10];
  p.mlp_norm = (const float*)d_in[11];
  p.w_up = (const float*)d_in[12];
  p.w_down = (const float*)d_in[13];
  p.final_norm = (const float*)d_in[14];
  p.out = (float*)d_out;
  char* ws = (char*)d_ws;
  size_t off = 0;
  p.W = (bf16_t*)(ws + off); off = align_up(off + (size_t)2 * LSTRIDE * 2);
  p.X = (bf16_t*)(ws + off); off = align_up(off + (size_t)MROWS * 4096 * 2);
  p.R = (bf16_t*)(ws + off); off = align_up(off + (size_t)MROWS * 32 * 2);
  p.O = (bf16_t*)(ws + off); off = align_up(off + (size_t)MROWS * 2048 * 2);
  p.HB = (bf16_t*)(ws + off); off = align_up(off + (size_t)MROWS * 1024 * 2);
  p.RSA = (float*)(ws + off); off = align_up(off + (size_t)MROWS * 4);
  p.RSB = (float*)(ws + off); off = align_up(off + (size_t)MROWS * 4);
  p.ST = (bf16_t*)(ws + off); off = align_up(off + (size_t)512 * 8192 * 2);
  p.GD = (float*)(ws + off); off = align_up(off + (size_t)16 * 8 * 2 * 128 * 4);
  p.hmeta = (float*)(ws + off); off = align_up(off + (size_t)2 * 128 * 1024 * 4);
  p.bar = (unsigned*)(ws + off); off = align_up(off + (size_t)XCD_BAR_WORDS * 4);
  if (off > ws_size) { fprintf(stderr, "workspace too small: need %zu have %zu\n", off, ws_size); return; }

#ifdef MULTI_LAUNCH
#define LAUNCH_PK(ST, l, g) do { \
    static bool attr_set_##ST = false; \
    if (!attr_set_##ST) { (void)hipFuncSetAttribute((const void*)pk<ST>, hipFuncAttributeMaxDynamicSharedMemorySize, LDS_BYTES + 32); attr_set_##ST = true; } \
    hipLaunchKernelGGL(pk<ST>, dim3(512), dim3(256), LDS_BYTES + 32, stream, p, l, g); } while (0)
  LAUNCH_PK(100, 0, 0);
  for (int g = 0; g < 2; ++g)
    for (int l = 0; l < 2; ++l) {
      if (l == 0) LAUNCH_PK(102, l, g);
      LAUNCH_PK(0, l, g); LAUNCH_PK(1, l, g); LAUNCH_PK(2, l, g); LAUNCH_PK(3, l, g); LAUNCH_PK(4, l, g); LAUNCH_PK(5, l, g);
      LAUNCH_PK(6, l, g); LAUNCH_PK(7, l, g); LAUNCH_PK(8, l, g); LAUNCH_PK(9, l, g); LAUNCH_PK(10, l, g);
    }
  LAUNCH_PK(101, 0, 0);
#else
  static int grid_blocks = 0;
  if (!grid_blocks) {
    (void)hipFuncSetAttribute((const void*)mega, hipFuncAttributeMaxDynamicSharedMemorySize, LDS_BYTES + 32);
    int dev = 0, cus = 0, per_cu = 0;
    (void)hipGetDevice(&dev);
    (void)hipDeviceGetAttribute(&cus, hipDeviceAttributeMultiprocessorCount, dev);
    (void)hipOccupancyMaxActiveBlocksPerMultiprocessor(&per_cu, (const void*)mega, 256, LDS_BYTES + 32);
    if (per_cu < 1) per_cu = 1;
    if (per_cu > 2) per_cu = 2;
    grid_blocks = cus * per_cu;
  }
  (void)hipMemsetAsync(p.bar, 0, (size_t)XCD_BAR_WORDS * 4, stream);
  int plo = 0, phi = NPHASES, coop = 1;
  void* args[] = {&p, &plo, &phi, &coop};
  hipError_t e = hipLaunchCooperativeKernel((const void*)mega, dim3(grid_blocks), dim3(256), args, LDS_BYTES + 32, stream);
  if (e != hipSuccess) fprintf(stderr, "cooperative launch failed: %s (grid %d)\n", hipGetErrorString(e), grid_blocks);
#endif
}
```
